# Optimizing an MI355X kernel written in HIP

```python
import math
import jax, jax.numpy as jnp
from jax import lax
import numpy as np

D_MODEL = 2048
BATCH = 2
SEQ = 4096
DEPTH = 1

N_MEM = 256

NSA_HEADS = 16
NSA_GROUPS = 2
NSA_HPG = NSA_HEADS // NSA_GROUPS
NSA_HEAD_DIM = 128
CMP_BLOCK = 32
CMP_STRIDE = 16
CMP_HIDDEN = 256
SLC_BLOCK = 64
SLC_TOPK = 16
WINDOW = 512
Q_BLOCK = 128
SLC_Q_BLOCK = 64
FORCED_SCORE = 1e4

MLA_HEADS = 16
MLA_NOPE = 128
MLA_ROPE = 64
MLA_V = 128
MLA_KV_RANK = 512
ROPE_THETA = 10000.0

REL_BUCKETS = 32
REL_MAX_EXACT = 16
REL_MAX_DIST = 4096

MEM_HEADS = 4
MEM_HEAD_DIM = 128

PEER_HEADS = 8
PEER_N_KEYS = 128
PEER_N_EXPERTS = PEER_N_KEYS * PEER_N_KEYS
PEER_QUERY_DIM = 256
PEER_HALF = PEER_QUERY_DIM // 2
PEER_TOPK = 16
PEER_CHUNK = 128

N_BRANCHES = 2
ALPHA = (2.0 * DEPTH) ** 0.25
BETA = (8.0 * DEPTH) ** -0.25
NEG_INF = -1e30
LN_EPS = 1e-5
RMS_EPS = 1e-6

NSA_Q_COLS = NSA_HEADS * NSA_HEAD_DIM
NSA_KV_COLS = NSA_GROUPS * NSA_HEAD_DIM
NSA_GATE_COLS = 3 * NSA_HEADS
MLA_Q_COLS = MLA_HEADS * (MLA_NOPE + MLA_ROPE)
MLA_KV_COLS = MLA_KV_RANK + MLA_ROPE
OFF_NSA_KV = NSA_Q_COLS
OFF_NSA_GATE = OFF_NSA_KV + 6 * NSA_KV_COLS
OFF_MLA_Q = OFF_NSA_GATE + NSA_GATE_COLS
OFF_MLA_KV = OFF_MLA_Q + MLA_Q_COLS
OFF_MERGE = OFF_MLA_KV + MLA_KV_COLS
COMBINED_COLS = OFF_MERGE + N_BRANCHES * D_MODEL

kernel_name = 'hybrid_nsa_mla_peer_block'


def layer_norm(x, g, b):
    xf = x.astype(jnp.float32)
    mu = jnp.mean(xf, -1, keepdims=True)
    var = jnp.mean(jnp.square(xf - mu), -1, keepdims=True)
    return ((xf - mu) * lax.rsqrt(var + LN_EPS) * g + b).astype(x.dtype)


def rms_norm(x, g):
    xf = x.astype(jnp.float32)
    return (xf * lax.rsqrt(jnp.mean(xf * xf, -1, keepdims=True) + RMS_EPS) * g).astype(x.dtype)


def masked_softmax(scores, mask):
    s = jnp.where(mask, scores.astype(jnp.float32), NEG_INF)
    return jax.nn.softmax(s, axis=-1) * mask


def t5_bucket(dist):
    dist = jnp.maximum(dist, 0)
    n_log = REL_BUCKETS - REL_MAX_EXACT
    large = REL_MAX_EXACT + (jnp.log(jnp.maximum(dist, 1).astype(jnp.float32) / REL_MAX_EXACT)
                             / math.log(REL_MAX_DIST / REL_MAX_EXACT) * n_log).astype(jnp.int32)
    large = jnp.minimum(large, REL_BUCKETS - 1)
    return jnp.where(dist < REL_MAX_EXACT, dist, large)


def rope_tables(T):
    inv = ROPE_THETA ** (-jnp.arange(0, MLA_ROPE, 2, dtype=jnp.float32) / MLA_ROPE)
    ang = jnp.arange(T, dtype=jnp.float32)[:, None] * inv[None, :]
    return jnp.cos(ang), jnp.sin(ang)


def apply_rope(x, cos, sin):
    x1, x2 = jnp.split(x.astype(jnp.float32), 2, axis=-1)
    return jnp.concatenate([x1 * cos - x2 * sin, x1 * sin + x2 * cos], axis=-1).astype(x.dtype)


def _to_blocks(a, axis, block):
    a = jnp.moveaxis(a, axis, 0)
    a = a.reshape((a.shape[0] // block, block) + a.shape[1:])
    return jnp.moveaxis(a, 1, axis + 1)


def _from_blocks(a, axis):
    a = jnp.moveaxis(a, 0, axis)
    return a.reshape(a.shape[:axis] + (a.shape[axis] * a.shape[axis + 1],) + a.shape[axis + 2:])


def nsa_compress(kv, pe, w1, w2):
    B, T = kv.shape[:2]
    n_cmp = (T - CMP_BLOCK) // CMP_STRIDE + 1
    idx = np.arange(n_cmp)[:, None] * CMP_STRIDE + np.arange(CMP_BLOCK)[None, :]
    blocks = kv[:, idx] + pe[None, None, :, None, :]
    flat = jnp.moveaxis(blocks, 3, 2).reshape(B, n_cmp, NSA_GROUPS, CMP_BLOCK * NSA_HEAD_DIM)
    return jax.nn.gelu(flat @ w1) @ w2


def nsa_attention(q, kv, gate_logits, rel_bias, cmp_k_pe, cmp_k_w1, cmp_k_w2, cmp_v_pe, cmp_v_w1, cmp_v_w2):
    B, T = q.shape[:2]
    G, HPG, d = NSA_GROUPS, NSA_HEADS // NSA_GROUPS, NSA_HEAD_DIM
    qg = q.reshape(B, T, G, HPG, d) * (d ** -0.5)
    kv = kv.reshape(B, T, 6, G, d)
    k_cmp, v_cmp, k_slc, v_slc, k_win, v_win = [kv[:, :, i] for i in range(6)]
    gates = jax.nn.sigmoid(gate_logits).reshape(B, T, 3, G, HPG)
    bias_tab = rel_bias.reshape(REL_BUCKETS, G, HPG)
    t_pos = jnp.arange(T)

    kc = nsa_compress(k_cmp, cmp_k_pe, cmp_k_w1, cmp_k_w2)
    vc = nsa_compress(v_cmp, cmp_v_pe, cmp_v_w1, cmp_v_w2)
    n_cmp = kc.shape[1]
    blk_end = jnp.arange(n_cmp) * CMP_STRIDE + CMP_BLOCK - 1
    dist_c = t_pos[:, None] - blk_end[None, :]
    bias_c = bias_tab[t5_bucket(dist_c)].transpose(2, 3, 0, 1)
    s_c = jnp.einsum('btghd,bngd->bghtn', qg, kc) + bias_c
    p_cmp = masked_softmax(s_c, dist_c >= 0)
    o_cmp = jnp.einsum('bghtn,bngd->btghd', p_cmp.astype(vc.dtype), vc)

    n_slc = T // SLC_BLOCK
    slc_start = np.arange(n_slc) * SLC_BLOCK
    cmp_start = np.arange(n_cmp) * CMP_STRIDE
    overlap = ((cmp_start[:, None] < slc_start[None, :] + SLC_BLOCK)
               & (cmp_start[:, None] + CMP_BLOCK > slc_start[None, :])).astype(np.float32)
    imp = jnp.einsum('bghtn,nj->bgtj', p_cmp, jnp.asarray(overlap))
    j = jnp.arange(n_slc)
    cur = t_pos // SLC_BLOCK
    valid = j[None, :] * SLC_BLOCK <= t_pos[:, None]
    forced = (j[None, :] == 0) | (j[None, :] == cur[:, None]) | (j[None, :] == cur[:, None] - 1)
    score = jnp.where(forced, FORCED_SCORE, jnp.where(valid, imp, NEG_INF))
    k_sel = min(SLC_TOPK, n_slc)
    sel_score, sel_idx = lax.top_k(score, k_sel)
    sel_ok = sel_score > 0.5 * NEG_INF
    k_slc_t = jnp.transpose(k_slc, (0, 2, 1, 3))
    v_slc_t = jnp.transpose(v_slc, (0, 2, 1, 3))
    bias_tab_g = jnp.transpose(bias_tab, (1, 0, 2))
    b_i = jnp.arange(B)[:, None, None, None]
    g_i = jnp.arange(G)[None, :, None, None]

    def slc_block(args):
        q_b, idx_b, ok_b, t_b = args
        tok = (idx_b[..., None] * SLC_BLOCK + jnp.arange(SLC_BLOCK)).reshape(idx_b.shape[:3] + (-1,))
        key_ok = jnp.repeat(ok_b, SLC_BLOCK, axis=-1) & (tok <= t_b[:, None])
        kk = k_slc_t[b_i, g_i, tok]
        vv = v_slc_t[b_i, g_i, tok]
        bias = bias_tab_g[g_i, t5_bucket(t_b[:, None] - tok)].transpose(0, 1, 4, 2, 3)
        s = jnp.einsum('bqghd,bgqkd->bghqk', q_b, kk) + bias
        p = masked_softmax(s, key_ok[:, :, None])
        return jnp.einsum('bghqk,bgqkd->bqghd', p.astype(vv.dtype), vv)

    o_slc = _from_blocks(lax.map(slc_block, (
        _to_blocks(qg, 1, SLC_Q_BLOCK),
        _to_blocks(sel_idx, 2, SLC_Q_BLOCK),
        _to_blocks(sel_ok, 2, SLC_Q_BLOCK),
        t_pos.reshape(T // SLC_Q_BLOCK, SLC_Q_BLOCK))), 1)

    span = WINDOW + Q_BLOCK
    k_pad = jnp.pad(k_win, ((0, 0), (WINDOW, 0), (0, 0), (0, 0)))
    v_pad = jnp.pad(v_win, ((0, 0), (WINDOW, 0), (0, 0), (0, 0)))
    dist_w = WINDOW + jnp.arange(Q_BLOCK)[:, None] - jnp.arange(span)[None, :]
    win_mask = (dist_w >= 0) & (dist_w < WINDOW)
    bias_w = bias_tab[t5_bucket(dist_w)].transpose(2, 3, 0, 1)

    def win_block(args):
        q_b, start = args
        kk = lax.dynamic_slice_in_dim(k_pad, start, span, axis=1)
        vv = lax.dynamic_slice_in_dim(v_pad, start, span, axis=1)
        kpos = start - WINDOW + jnp.arange(span)
        s = jnp.einsum('bqghd,bkgd->bghqk', q_b, kk) + bias_w
        p = masked_softmax(s, win_mask & (kpos >= 0)[None, :])
        return jnp.einsum('bghqk,bkgd->bqghd', p.astype(vv.dtype), vv)

    n_qb = T // Q_BLOCK
    o_win = _from_blocks(lax.map(win_block, (_to_blocks(qg, 1, Q_BLOCK), jnp.arange(n_qb) * Q_BLOCK)), 1)

    o = (gates[:, :, 0, :, :, None] * o_cmp + gates[:, :, 1, :, :, None] * o_slc
         + gates[:, :, 2, :, :, None] * o_win)
    return o.reshape(B, T, NSA_HEADS * NSA_HEAD_DIM)


def mla_attention(q, ckv, kv_norm_g, w_uk, w_uv, cos, sin):
    B, T = q.shape[:2]
    q = q.reshape(B, T, MLA_HEADS, MLA_NOPE + MLA_ROPE)
    scale = (MLA_NOPE + MLA_ROPE) ** -0.5
    q_nope = q[..., :MLA_NOPE] * scale
    q_pe = apply_rope(q[..., MLA_NOPE:], cos[:, None, :], sin[:, None, :]) * scale
    c_kv = rms_norm(ckv[..., :MLA_KV_RANK], kv_norm_g)
    k_pe = apply_rope(ckv[..., MLA_KV_RANK:], cos, sin)
    k_nope = (c_kv @ w_uk).reshape(B, T, MLA_HEADS, MLA_NOPE)
    v = (c_kv @ w_uv).reshape(B, T, MLA_HEADS, MLA_V)
    kpos = jnp.arange(T)

    def blk(args):
        qn_b, qp_b, t_b = args
        s = (jnp.einsum('bqhd,bkhd->bhqk', qn_b, k_nope)
             + jnp.einsum('bqhd,bkd->bhqk', qp_b, k_pe))
        p = masked_softmax(s, t_b[:, None] >= kpos[None, :])
        return jnp.einsum('bhqk,bkhd->bqhd', p.astype(v.dtype), v)

    o = lax.map(blk, (_to_blocks(q_nope, 1, Q_BLOCK), _to_blocks(q_pe, 1, Q_BLOCK),
                      kpos.reshape(T // Q_BLOCK, Q_BLOCK)))
    return _from_blocks(o, 1).reshape(B, T, MLA_HEADS * MLA_V)


def hybrid_mixer(x, w_in, rel_bias, cmp_k_pe, cmp_k_w1, cmp_k_w2, cmp_v_pe, cmp_v_w1, cmp_v_w2,
                 mla_kv_norm, mla_w_uk, mla_w_uv, w_branch_nsa, w_branch_mla, w_mix_out, cos, sin):
    B, T, D = x.shape
    proj = x @ w_in
    y_nsa = nsa_attention(proj[..., :OFF_NSA_KV], proj[..., OFF_NSA_KV:OFF_NSA_GATE],
                          proj[..., OFF_NSA_GATE:OFF_MLA_Q], rel_bias,
                          cmp_k_pe, cmp_k_w1, cmp_k_w2, cmp_v_pe, cmp_v_w1, cmp_v_w2) @ w_branch_nsa
    y_mla = mla_attention(proj[..., OFF_MLA_Q:OFF_MLA_KV], proj[..., OFF_MLA_KV:OFF_MERGE],
                          mla_kv_norm, mla_w_uk, mla_w_uv, cos, sin) @ w_branch_mla
    mg = jax.nn.sigmoid(proj[..., OFF_MERGE:]).reshape(B, T, N_BRANCHES, D)
    return (mg[:, :, 0] * y_nsa + mg[:, :, 1] * y_mla) @ w_mix_out


def memory_attention(x, mem, w_q, w_k, w_v, w_o):
    B, T, _ = x.shape
    M = mem.shape[1]
    q = (x @ w_q).reshape(B, T, MEM_HEADS, MEM_HEAD_DIM) * (MEM_HEAD_DIM ** -0.5)
    k = (mem @ w_k).reshape(B, M, MEM_HEADS, MEM_HEAD_DIM)
    v = (mem @ w_v).reshape(B, M, MEM_HEADS, MEM_HEAD_DIM)
    p = jax.nn.softmax(jnp.einsum('bthd,bmhd->bhtm', q, k).astype(jnp.float32), axis=-1)
    o = jnp.einsum('bhtm,bmhd->bthd', p.astype(v.dtype), v).reshape(B, T, MEM_HEADS * MEM_HEAD_DIM)
    return o @ w_o


def peer_ffn(x, w_query, sub_keys, expert_u, expert_v):
    B, T, D = x.shape
    N = B * T
    xt = x.reshape(N, D)
    q = (xt @ w_query).reshape(N, PEER_HEADS, 2, PEER_HALF)
    s1 = jnp.einsum('nhd,kd->nhk', q[:, :, 0], sub_keys[0])
    s2 = jnp.einsum('nhd,kd->nhk', q[:, :, 1], sub_keys[1])
    v1, i1 = lax.top_k(s1, PEER_TOPK)
    v2, i2 = lax.top_k(s2, PEER_TOPK)
    cand = (v1[..., :, None] + v2[..., None, :]).reshape(N, PEER_HEADS, PEER_TOPK * PEER_TOPK)
    top_s, flat = lax.top_k(cand, PEER_TOPK)
    e1 = jnp.take_along_axis(i1, flat // PEER_TOPK, axis=-1)
    e2 = jnp.take_along_axis(i2, flat % PEER_TOPK, axis=-1)
    experts = e1 * PEER_N_KEYS + e2
    gate = jax.nn.softmax(top_s.astype(jnp.float32), axis=-1).astype(x.dtype)

    def chunk(args):
        x_c, e_c, g_c = args
        act = jax.nn.gelu(jnp.einsum('chkd,cd->chk', expert_u[e_c], x_c))
        return jnp.einsum('chk,chkd->cd', g_c * act, expert_v[e_c])

    n_chunks = N // PEER_CHUNK
    out = lax.map(chunk, (xt.reshape(n_chunks, PEER_CHUNK, D),
                          experts.reshape(n_chunks, PEER_CHUNK, PEER_HEADS, PEER_TOPK),
                          gate.reshape(n_chunks, PEER_CHUNK, PEER_HEADS, PEER_TOPK)))
    return out.reshape(B, T, D)


def setup_inputs(seed: int = 0) -> dict:
    key = jax.random.key(seed)
    ks = iter(jax.random.split(key, 40))
    L = DEPTH

    def dense(shape, fan_in, scale=1.0):
        return jax.random.normal(next(ks), shape, jnp.float32) * (scale * fan_in ** -0.5)

    def gain(shape):
        return 1.0 + 0.1 * jax.random.normal(next(ks), shape, jnp.float32)

    def small(shape, s=0.01):
        return s * jax.random.normal(next(ks), shape, jnp.float32)

    nsa_w = NSA_HEADS * NSA_HEAD_DIM
    mla_w = MLA_HEADS * MLA_V
    mem_w = MEM_HEADS * MEM_HEAD_DIM
    return {
        'x': jax.random.normal(next(ks), (BATCH, SEQ, D_MODEL), jnp.float32),
        'mem': jax.random.normal(next(ks), (BATCH, N_MEM, D_MODEL), jnp.float32),
        'rel_bias': small((REL_BUCKETS, NSA_HEADS), 0.5),
        'w_in': dense((L, D_MODEL, COMBINED_COLS), D_MODEL),
        'cmp_k_pe': small((L, CMP_BLOCK, NSA_HEAD_DIM), 0.5),
        'cmp_k_w1': dense((L, CMP_BLOCK * NSA_HEAD_DIM, CMP_HIDDEN), CMP_BLOCK * NSA_HEAD_DIM),
        'cmp_k_w2': dense((L, CMP_HIDDEN, NSA_HEAD_DIM), CMP_HIDDEN),
        'cmp_v_pe': small((L, CMP_BLOCK, NSA_HEAD_DIM), 0.5),
        'cmp_v_w1': dense((L, CMP_BLOCK * NSA_HEAD_DIM, CMP_HIDDEN), CMP_BLOCK * NSA_HEAD_DIM),
        'cmp_v_w2': dense((L, CMP_HIDDEN, NSA_HEAD_DIM), CMP_HIDDEN),
        'mla_kv_norm': gain((L, MLA_KV_RANK)),
        'mla_w_uk': dense((L, MLA_KV_RANK, MLA_HEADS * MLA_NOPE), MLA_KV_RANK),
        'mla_w_uv': dense((L, MLA_KV_RANK, mla_w), MLA_KV_RANK),
        'w_branch_nsa': dense((L, nsa_w, D_MODEL), nsa_w, BETA),
        'w_branch_mla': dense((L, mla_w, D_MODEL), mla_w, BETA),
        'w_mix_out': dense((L, D_MODEL, D_MODEL), D_MODEL, BETA),
        'ln_mix_g': gain((L, D_MODEL)),
        'ln_mix_b': small((L, D_MODEL)),
        'mem_w_q': dense((L, D_MODEL, mem_w), D_MODEL),
        'mem_w_k': dense((L, D_MODEL, mem_w), D_MODEL),
        'mem_w_v': dense((L, D_MODEL, mem_w), D_MODEL),
        'mem_w_o': dense((L, mem_w, D_MODEL), mem_w, BETA),
        'ln_mem_g': gain((L, D_MODEL)),
        'ln_mem_b': small((L, D_MODEL)),
        'peer_w_query': dense((L, D_MODEL, PEER_HEADS * PEER_QUERY_DIM), D_MODEL),
        'peer_sub_keys': dense((L, 2, PEER_N_KEYS, PEER_HALF), PEER_HALF),
        'peer_u': dense((L, PEER_N_EXPERTS, D_MODEL), D_MODEL),
        'peer_v': dense((L, PEER_N_EXPERTS, D_MODEL), 1.0, BETA),
        'ln_ffn_g': gain((L, D_MODEL)),
        'ln_ffn_b': small((L, D_MODEL)),
    }


def reference(x, mem, rel_bias, w_in, cmp_k_pe, cmp_k_w1, cmp_k_w2, cmp_v_pe, cmp_v_w1, cmp_v_w2,
              mla_kv_norm, mla_w_uk, mla_w_uv, w_branch_nsa, w_branch_mla, w_mix_out, ln_mix_g, ln_mix_b,
              mem_w_q, mem_w_k, mem_w_v, mem_w_o, ln_mem_g, ln_mem_b,
              peer_w_query, peer_sub_keys, peer_u, peer_v, ln_ffn_g, ln_ffn_b):
    cos, sin = rope_tables(x.shape[1])
    for l in range(DEPTH):
        mix = hybrid_mixer(x, w_in[l], rel_bias, cmp_k_pe[l], cmp_k_w1[l], cmp_k_w2[l],
                           cmp_v_pe[l], cmp_v_w1[l], cmp_v_w2[l], mla_kv_norm[l], mla_w_uk[l], mla_w_uv[l],
                           w_branch_nsa[l], w_branch_mla[l], w_mix_out[l], cos, sin)
        x = layer_norm(ALPHA * x + mix, ln_mix_g[l], ln_mix_b[l])
        x = layer_norm(ALPHA * x + memory_attention(x, mem, mem_w_q[l], mem_w_k[l], mem_w_v[l], mem_w_o[l]),
                       ln_mem_g[l], ln_mem_b[l])
        x = layer_norm(ALPHA * x + peer_ffn(x, peer_w_query[l], peer_sub_keys[l], peer_u[l], peer_v[l]),
                       ln_ffn_g[l], ln_ffn_b[l])
    return x
```

```cpp
#include <hip/hip_runtime.h>
#include <cstdio>
#include <cstdint>
#ifndef N_LAUNCHES
#define N_LAUNCHES 1
#endif
namespace pg8 {
#define PG8_LAS __attribute__((address_space(3)))
typedef unsigned short bf16_t;
typedef short bf16x8 __attribute__((ext_vector_type(8)));
typedef float f32x4 __attribute__((ext_vector_type(4)));
typedef unsigned u32x4 __attribute__((ext_vector_type(4)));
constexpr int BM = 256, BK = 64, HALF = 128, HTB = HALF * BK * 2  , STAGE_BYTES = 8 * HTB, NXCD = 8, WGM = 8;

__host__ __device__ __forceinline__ int lds_byte(int r, int c) { const int st = (r >> 4) * 2 + (c >> 5), rr = r & 15, cc = c & 31, ob = rr * 64 + cc * 2; return st * 1024 + (ob ^ (((ob >> 9) & 1) << 5)); }
__host__ __device__ __forceinline__ void stage_rc(int b, int& R, int& C) { const int st = b / 1024, sb = b % 1024, swz = sb ^ (((sb >> 9) & 1) << 5); R = (st >> 1) * 16 + swz / 64; C = (st & 1) * 32 + (swz % 64) / 2; }
__host__ __device__ __forceinline__ int perm32(int rho) { const int n = rho >> 4, i = rho & 15; return 8 * (i >> 2) + 4 * n + (i & 3); }

struct Unit { int pm, pn; };
struct Gemm { const bf16_t* A; const bf16_t* Bt; int M, N, K, lda, ldb; };

struct StaticOrder {
    int nM, nN, nwg, G, c;
    __host__ __device__ void init(int M, int N, int G_, int c_) { nM = M / BM; nN = N / BM; nwg = nM * nN; G = G_; c = c_; }
    __host__ __device__ bool next(int i, Unit& u) const {
        const long L = (long)i * G + c; if (L >= nwg) return false;
        int wgid = (int)L; { const int q = nwg / NXCD, r = nwg % NXCD, xcd = wgid % NXCD, off = wgid / NXCD; wgid = (xcd < r ? xcd * (q + 1) : r * (q + 1) + (xcd - r) * q) + off; }
        const int nig = WGM * nN, gid = wgid / nig, fm = gid * WGM, gsz = (nM - fm) < WGM ? (nM - fm) : WGM;
        u.pm = fm + ((wgid % nig) % gsz); u.pn = (wgid % nig) / gsz; return true;
    }
    __device__ __forceinline__ void a_ready(const Unit&) const {}
    __device__ __forceinline__ void done(const Unit&) const {}
};

__device__ __forceinline__ unsigned cvt_pk_bf16(float lo, float hi) { unsigned r; asm volatile("v_cvt_pk_bf16_f32 %0, %1, %2" : "=v"(r) : "v"(lo), "v"(hi)); return r; }
typedef float f32x2 __attribute__((ext_vector_type(2)));
__device__ __forceinline__ f32x2 gelu_pk(f32x2 v) {
    const f32x2 av = __builtin_elementwise_abs(v), d = av * 0.2316418882f + 1.0f;
    f32x2 t; t.x = __builtin_amdgcn_rcpf(d.x); t.y = __builtin_amdgcn_rcpf(d.y);
    f32x2 q = t * 0.5307027145f + (-0.7265760135f); q = q * t + 0.7107068705f; q = q * t + (-0.142248368f); q = q * t + 0.127414796f; q = q * t;
    const f32x2 s = (v * v) * (-0.72134752044f);
    f32x2 e; e.x = __builtin_amdgcn_exp2f(s.x); e.y = __builtin_amdgcn_exp2f(s.y);
    const f32x2 m = v * (q * e), r = v - m;
    f32x2 o; o.x = v.x < 0.f ? m.x : r.x; o.y = v.y < 0.f ? m.y : r.y; return o;
}

template <int ACT  > struct EpiBf16 {
    static constexpr bool PERM = true, AFTER_DRAIN = false; static_assert(ACT == 0 || ACT == 1, "EpiBf16: ACT is 0 (none) or 1 (gelu_pk)");
    bf16_t* O; int ldc; const float* bias; int split_cols; size_t split_stride; float scale0;
    __device__ __forceinline__ void operator()(const f32x4 (&acc)[2][2][4][2], const Unit& u, int wr, int wc, int fr, int fq) const {
        const int row0 = u.pm * BM + wr * 64 + fr; int colt = u.pn * BM; bf16_t* base = O;
        float sc = 1.f; if (split_cols) { const int t = colt / split_cols; base += (size_t)t * split_stride; colt -= t * split_cols; if (t == 0) sc = scale0; }
        const int col0 = colt + wc * 32 + 8 * fq, bcol0 = u.pn * BM + wc * 32 + 8 * fq;
        f32x4 bv[2][2];
#pragma unroll
        for (int bj = 0; bj < 2; ++bj)
#pragma unroll
            for (int n = 0; n < 2; ++n) bv[bj][n] = bias ? *(const f32x4*)(bias + bcol0 + bj * HALF + 4 * n) : (f32x4){0.f, 0.f, 0.f, 0.f};
#pragma unroll
        for (int ai = 0; ai < 2; ++ai)
#pragma unroll
            for (int m = 0; m < 4; ++m) { bf16_t* rowp = base + (size_t)(row0 + ai * HALF + m * 16) * ldc + col0;
#pragma unroll
                for (int bj = 0; bj < 2; ++bj) { f32x4 v0 = acc[ai][bj][m][0] + bv[bj][0], v1 = acc[ai][bj][m][1] + bv[bj][1];
                    if (ACT == 1) { f32x2 a = gelu_pk((f32x2){v0[0], v0[1]}), b = gelu_pk((f32x2){v0[2], v0[3]}), c = gelu_pk((f32x2){v1[0], v1[1]}), d = gelu_pk((f32x2){v1[2], v1[3]});
                        v0 = (f32x4){a.x, a.y, b.x, b.y}; v1 = (f32x4){c.x, c.y, d.x, d.y}; }
                    v0 = v0 * sc; v1 = v1 * sc; u32x4 w; w.x = cvt_pk_bf16(v0[0], v0[1]); w.y = cvt_pk_bf16(v0[2], v0[3]); w.z = cvt_pk_bf16(v1[0], v1[1]); w.w = cvt_pk_bf16(v1[2], v1[3]);
                    *(u32x4*)(rowp + bj * HALF) = w; } }
    }
};
struct EpiF32 {
    static constexpr bool PERM = false, AFTER_DRAIN = false;
    float* C; int ldc; const float* bias;
    __device__ __forceinline__ void operator()(const f32x4 (&acc)[2][2][4][2], const Unit& u, int wr, int wc, int fr, int fq) const {
        const int row0 = u.pm * BM + wr * 64 + fr, col0 = u.pn * BM + wc * 32 + 4 * fq;
        f32x4 bv[2][2];
#pragma unroll
        for (int bj = 0; bj < 2; ++bj)
#pragma unroll
            for (int n = 0; n < 2; ++n) bv[bj][n] = bias ? *(const f32x4*)(bias + col0 + bj * HALF + n * 16) : (f32x4){0.f, 0.f, 0.f, 0.f};
#pragma unroll
        for (int ai = 0; ai < 2; ++ai)
#pragma unroll
            for (int m = 0; m < 4; ++m) { float* rowp = C + (size_t)(row0 + ai * HALF + m * 16) * ldc + col0;
#pragma unroll
                for (int bj = 0; bj < 2; ++bj)
#pragma unroll
                    for (int n = 0; n < 2; ++n) *(f32x4*)(rowp + bj * HALF + n * 16) = acc[ai][bj][m][n] + bv[bj][n]; }
    }
};
template <class Epi, class Sched, bool ALIGN_EPI = false, bool SP2 = false>
__device__ __forceinline__ void gemm_phase(PG8_LAS unsigned char* lds, const Gemm g, const Sched& S, const Epi& E) {
    const int tid = threadIdx.x, wid = __builtin_amdgcn_readfirstlane(tid >> 6), lane = tid & 63, wr = wid >> 2, wc = wid & 3, fr = lane & 15, fq = lane >> 4;
    const int K = g.K, nt = K / BK;
    unsigned voffA[2], voffB[2];
#pragma unroll
    for (int i = 0; i < 2; ++i) { int R, C; stage_rc(tid * 16 + i * 8192, R, C); const int Rb = Epi::PERM ? ((R & ~31) + perm32(R & 31)) : R;
        voffA[i] = (unsigned)(R * g.lda + C) * 2u; voffB[i] = (unsigned)(Rb * g.ldb + C) * 2u; }
    const size_t kstep = (size_t)(BK * 2);
    const size_t hstepA = (size_t)HALF * g.lda * 2, hstepB = (size_t)HALF * g.ldb * 2;
    const size_t tstepA = 2 * hstepA, tstepB = 2 * hstepB;
    const unsigned ldsw = (unsigned)wid * 1024u;
    const int aoff = lds_byte(wr * 64 + fr, fq * 8), boff = lds_byte(wc * 32 + fr, fq * 8);
#define PG8_SA(b, h) (((b) * 2 + (h)) * HTB)
#define PG8_SB(b, h) ((4 + (b) * 2 + (h)) * HTB)
#define PG8_STAGE(bufoff, gbase, voff) do { _Pragma("unroll") for (int _i = 0; _i < 2; ++_i) \
        __builtin_amdgcn_global_load_lds((const unsigned*)((const char*)(gbase) + (voff)[_i]), (PG8_LAS unsigned*)(lds + (bufoff) + ldsw + _i * 8192), 16, 0, 0); } while (0)
#define PG8_LDA(dst, b, h) do { _Pragma("unroll") for (int m = 0; m < 4; ++m) _Pragma("unroll") for (int k = 0; k < 2; ++k) dst[m][k] = *(const PG8_LAS bf16x8*)(lds + PG8_SA(b, h) + aoff + m * 2048 + k * 1024); } while (0)
#define PG8_LDB(dst, b, h) do { _Pragma("unroll") for (int n = 0; n < 2; ++n) _Pragma("unroll") for (int k = 0; k < 2; ++k) dst[n][k] = *(const PG8_LAS bf16x8*)(lds + PG8_SB(b, h) + boff + n * 2048 + k * 1024); } while (0)
#define PG8_MMA(ai, bj, At, Bt) do { __builtin_amdgcn_s_setprio(1); _Pragma("unroll") for (int m = 0; m < 4; ++m) _Pragma("unroll") for (int n = 0; n < 2; ++n) _Pragma("unroll") for (int k = 0; k < 2; ++k) \
        acc[ai][bj][m][n] = __builtin_amdgcn_mfma_f32_16x16x32_bf16(Bt[n][k], At[m][k], acc[ai][bj][m][n], 0, 0, 0); __builtin_amdgcn_s_setprio(0); } while (0)
#define PG8_WAIT_V(n) asm volatile("s_waitcnt vmcnt(" #n ")" ::: "memory")
#define PG8_WAIT_L(n) asm volatile("s_waitcnt lgkmcnt(" #n ")" ::: "memory")
#define PG8_BAR __builtin_amdgcn_s_barrier()
#define PG8_SCHED __builtin_amdgcn_sched_barrier(0)
    Unit cur, nxt; int ui = 0;
    if (!S.next(0, cur)) return;
    f32x4 acc[2][2][4][2];
#pragma unroll
    for (int a = 0; a < 2; ++a)
#pragma unroll
        for (int b = 0; b < 2; ++b)
#pragma unroll
            for (int m = 0; m < 4; ++m)
#pragma unroll
                for (int n = 0; n < 2; ++n) acc[a][b][m][n] = (f32x4){0.f, 0.f, 0.f, 0.f};
    bf16x8 At[4][2], B0[2][2], B1[2][2];
    const char* cA = (const char*)g.A + (size_t)cur.pm * tstepA; const char* cB = (const char*)g.Bt + (size_t)cur.pn * tstepB;
    S.a_ready(cur);
    if constexpr (SP2) {
        PG8_STAGE(PG8_SB(0, 0), cB, voffB); PG8_STAGE(PG8_SB(0, 1), cB + hstepB, voffB); PG8_STAGE(PG8_SA(0, 0), cA, voffA); PG8_STAGE(PG8_SA(0, 1), cA + hstepA, voffA);
        if (wr == 1) PG8_BAR;
        PG8_WAIT_V(2); PG8_BAR;
        PG8_STAGE(PG8_SB(1, 0), cB + kstep, voffB); PG8_STAGE(PG8_SA(1, 0), cA + kstep, voffA); PG8_STAGE(PG8_SB(1, 1), cB + hstepB + kstep, voffB);
        PG8_WAIT_V(6); PG8_BAR;
    } else {
        PG8_STAGE(PG8_SB(0, 0), cB, voffB); PG8_STAGE(PG8_SA(0, 0), cA, voffA); PG8_STAGE(PG8_SB(0, 1), cB + hstepB, voffB); PG8_STAGE(PG8_SA(0, 1), cA + hstepA, voffA);
        if (wr == 1) PG8_BAR;
        PG8_WAIT_V(4); PG8_BAR;
        PG8_STAGE(PG8_SB(1, 0), cB + kstep, voffB); PG8_STAGE(PG8_SA(1, 0), cA + kstep, voffA); PG8_STAGE(PG8_SB(1, 1), cB + hstepB + kstep, voffB);
        PG8_WAIT_V(6); PG8_BAR;
    }
    for (;;) {
        const bool has_next = S.next(ui + 1, nxt);
        const char* nA = has_next ? (const char*)g.A + (size_t)nxt.pm * tstepA : cA; const char* nB = has_next ? (const char*)g.Bt + (size_t)nxt.pn * tstepB : cB;
        for (int t = 0; t < nt; t += 2) {
            const bool last = (t == nt - 2);
            const char* a1 = cA + (size_t)(t + 1) * kstep;
            const char* a2 = last ? nA : cA + (size_t)(t + 2) * kstep; const char* b2 = last ? nB : cB + (size_t)(t + 2) * kstep;
            const char* a3 = a2 + kstep; const char* b3 = b2 + kstep;
            if (last && has_next) S.a_ready(nxt);
            if constexpr (SP2) {
            PG8_LDB(B0, 0, 0); PG8_LDB(B1, 0, 1); PG8_SCHED; PG8_LDA(At, 0, 0); PG8_STAGE(PG8_SA(1, 1), a1 + hstepA, voffA);
            PG8_WAIT_V(8); PG8_WAIT_L(0); PG8_BAR; PG8_MMA(0, 0, At, B0); PG8_MMA(0, 1, At, B1); PG8_BAR; PG8_SCHED;
            PG8_LDA(At, 0, 1); PG8_STAGE(PG8_SB(0, 0), b2, voffB); PG8_STAGE(PG8_SB(0, 1), b2 + hstepB, voffB); PG8_STAGE(PG8_SA(0, 0), a2, voffA);
            PG8_WAIT_V(8); PG8_WAIT_L(0); PG8_BAR; PG8_MMA(1, 0, At, B0); PG8_MMA(1, 1, At, B1); PG8_BAR; PG8_SCHED;
            PG8_LDB(B0, 1, 0); PG8_LDB(B1, 1, 1); PG8_SCHED; PG8_LDA(At, 1, 0); PG8_STAGE(PG8_SA(0, 1), a2 + hstepA, voffA);
            PG8_WAIT_V(8); PG8_WAIT_L(0); PG8_BAR; PG8_MMA(0, 0, At, B0); PG8_MMA(0, 1, At, B1); PG8_BAR; PG8_SCHED;
            PG8_LDA(At, 1, 1); PG8_STAGE(PG8_SB(1, 0), b3, voffB); PG8_STAGE(PG8_SB(1, 1), b3 + hstepB, voffB); PG8_STAGE(PG8_SA(1, 0), a3, voffA);
            PG8_WAIT_V(8); PG8_WAIT_L(0); PG8_BAR; PG8_MMA(1, 0, At, B0); PG8_MMA(1, 1, At, B1); PG8_BAR; PG8_SCHED;
            } else {
            PG8_LDB(B0, 0, 0); PG8_SCHED; PG8_LDA(At, 0, 0); PG8_STAGE(PG8_SA(1, 1), a1 + hstepA, voffA);
            PG8_WAIT_L(8); PG8_BAR; PG8_WAIT_L(0); PG8_MMA(0, 0, At, B0); PG8_BAR; PG8_SCHED;
            PG8_LDB(B1, 0, 1); PG8_STAGE(PG8_SB(0, 0), b2, voffB);
            PG8_BAR; PG8_WAIT_L(0); PG8_MMA(0, 1, At, B1); PG8_BAR;
            PG8_LDA(At, 0, 1); PG8_STAGE(PG8_SA(0, 0), a2, voffA);
            PG8_BAR; PG8_WAIT_L(0); PG8_MMA(1, 0, At, B0); PG8_BAR; PG8_SCHED;
            PG8_STAGE(PG8_SB(0, 1), b2 + hstepB, voffB);
            PG8_WAIT_V(6); PG8_BAR; PG8_MMA(1, 1, At, B1); PG8_BAR;
            PG8_LDB(B0, 1, 0); PG8_SCHED; PG8_LDA(At, 1, 0); PG8_STAGE(PG8_SA(0, 1), a2 + hstepA, voffA);
            PG8_WAIT_L(8); PG8_BAR; PG8_WAIT_L(0); PG8_MMA(0, 0, At, B0); PG8_BAR; PG8_SCHED;
            PG8_LDB(B1, 1, 1); PG8_STAGE(PG8_SB(1, 0), b3, voffB);
            PG8_BAR; PG8_WAIT_L(0); PG8_MMA(0, 1, At, B1); PG8_BAR;
            PG8_LDA(At, 1, 1); PG8_STAGE(PG8_SA(1, 0), a3, voffA);
            PG8_BAR; PG8_WAIT_L(0); PG8_MMA(1, 0, At, B0); PG8_BAR; PG8_SCHED;
            PG8_STAGE(PG8_SB(1, 1), b3 + hstepB, voffB);
            PG8_WAIT_V(6); PG8_BAR; PG8_MMA(1, 1, At, B1); PG8_BAR;
            }
        }
        if constexpr (ALIGN_EPI) { if (wr == 0) PG8_BAR; }
        if constexpr (!Epi::AFTER_DRAIN) { E(acc, cur, wr, wc, fr, fq); S.done(cur); }
        if (!has_next) break;
#pragma unroll
        for (int a = 0; a < 2; ++a)
#pragma unroll
            for (int b = 0; b < 2; ++b)
#pragma unroll
                for (int m = 0; m < 4; ++m)
#pragma unroll
                    for (int n = 0; n < 2; ++n) acc[a][b][m][n] = (f32x4){0.f, 0.f, 0.f, 0.f};
        cur = nxt; cA = nA; cB = nB; ++ui;
        if constexpr (ALIGN_EPI) { if (wr == 1) PG8_BAR; }
    }
    PG8_WAIT_V(0);
    if constexpr (!ALIGN_EPI) { if (wr == 0) PG8_BAR; }
    PG8_BAR;
    if constexpr (Epi::AFTER_DRAIN) { E.fused(acc, cur, wr, wc, fr, fq, lds, wid, lane); S.done(cur); }
#undef PG8_SA
#undef PG8_SB
#undef PG8_STAGE
#undef PG8_LDA
#undef PG8_LDB
#undef PG8_MMA
#undef PG8_WAIT_V
#undef PG8_WAIT_L
#undef PG8_BAR
#undef PG8_SCHED
}
}

constexpr int BATCH = 2, T = 4096, D = 2048, NTOK = BATCH * T, NMEM = 256;
constexpr int NCOMB = 11376, NCOMBP = 11520;
constexpr int OFF_NSA_KV = 2048, OFF_NSA_GATE = 3584, OFF_MLA_Q = 3632, OFF_MLA_KV = 6704, OFF_MERGE = 7280;
constexpr float ALPHA = 1.189207115002721f;
constexpr float NSA_SCALE = 0.08838834764831845f, MLA_SCALE = 0.07216878364870323f, MEM_SCALE = 0.08838834764831845f;
enum { I_X = 0, I_MEM, I_RELB, I_WIN, I_CKPE, I_CKW1, I_CKW2, I_CVPE, I_CVW1, I_CVW2, I_KVNORM, I_WUK, I_WUV, I_WBN, I_WBM, I_WMO, I_LN1G, I_LN1B,
       I_MWQ, I_MWK, I_MWV, I_MWO, I_LN2G, I_LN2B, I_PWQ, I_PKEYS, I_PU, I_PV, I_LN3G, I_LN3B, N_IN };

constexpr size_t MiB = 1u << 20;
constexpr size_t WS_CTL = 0, CTL_ZERO_BYTES = 1 * MiB;
constexpr size_t WS_W_IN = 1 * MiB, WS_W_UKV = 46 * MiB, WS_W_BN = 50 * MiB, WS_W_BM = 58 * MiB, WS_W_MO = 66 * MiB, WS_W_MQ = 74 * MiB, WS_W_MKV = 76 * MiB, WS_W_MO2 = 80 * MiB,
                 WS_W_PQ = 82 * MiB, WS_W_C1K = 90 * MiB, WS_W_C1V = 92 * MiB;
constexpr size_t WS_CVEC = 94 * MiB, WS_KCVC = 95 * MiB, WS_H1 = 96 * MiB, WS_SEL = 98 * MiB, WS_KVMEM = 99 * MiB, WS_MEMB = 100 * MiB, WS_KPE = 102 * MiB;
constexpr size_t WS_PROJ = 106 * MiB;
constexpr size_t WS_X1 = 106 * MiB, WS_X2 = 170 * MiB, WS_X1B = 234 * MiB, WS_QMEM = 266 * MiB, WS_OMEM = 274 * MiB;
constexpr size_t WS_KVUP = 286 * MiB, WS_Z = 286 * MiB;
constexpr size_t WS_XB = 350 * MiB, WS_ONSA = 350 * MiB, WS_X2B = 350 * MiB;
constexpr size_t WS_OMLA = 382 * MiB, WS_PQ = 382 * MiB;
constexpr size_t WS_CKVN = 414 * MiB, WS_CMPA_K = 422 * MiB, WS_CMPA_V = 422 * MiB + 4 * MiB + 65536, WS_YN = 414 * MiB;
constexpr size_t WS_YM = 446 * MiB, WS_PIDX = 446 * MiB, WS_PGATE = 450 * MiB;
constexpr size_t WS_MERGED = 478 * MiB, WS_END = 512 * MiB;
constexpr int CW_BAR = 4096;

constexpr int RING_BYTES = 131072, LDSCTL_OFF = RING_BYTES, MISC_OFF = LDSCTL_OFF + 320, LDS_BYTES = 147456;
constexpr int NWAVES = 8, NTHREADS = 512;

#define LAS __attribute__((address_space(3)))
typedef unsigned short bf16;
typedef unsigned v4u __attribute__((ext_vector_type(4)));
typedef float f32x4 __attribute__((ext_vector_type(4)));
#define LDS_WAIT() asm volatile("s_waitcnt lgkmcnt(0)" ::: "memory")

__device__ __forceinline__ unsigned f2bf(float f) { unsigned u = __builtin_bit_cast(unsigned, f); return (u + 0x7fffu + ((u >> 16) & 1u)) >> 16; }
__device__ __forceinline__ unsigned pk2(float lo, float hi) { return f2bf(lo) | (f2bf(hi) << 16); }
__device__ __forceinline__ float bf2f(bf16 h) { return __builtin_bit_cast(float, (unsigned)h << 16); }
__device__ __forceinline__ float lo_bf(unsigned w) { return __builtin_bit_cast(float, w << 16); }
__device__ __forceinline__ float hi_bf(unsigned w) { return __builtin_bit_cast(float, w & 0xffff0000u); }
__device__ __forceinline__ float wave_sum(float v) {
#pragma unroll
    for (int o = 1; o < 64; o <<= 1) v += __shfl_xor(v, o);
    return v;
}
__device__ __forceinline__ float wave_max(float v) {
#pragma unroll
    for (int o = 1; o < 64; o <<= 1) v = fmaxf(v, __shfl_xor(v, o));
    return v;
}
__device__ __forceinline__ int wave_min_i(int v) {
#pragma unroll
    for (int o = 1; o < 64; o <<= 1) { const int w = __shfl_xor(v, o); v = w < v ? w : v; }
    return v;
}
__device__ __forceinline__ float sigmoidf_(float x) { return 1.f / (1.f + expf(-x)); }
__device__ __forceinline__ float gelu_tanh(float x) { return 0.5f * x * (1.f + tanhf(0.7978845608028654f * (x + 0.044715f * x * x * x))); }
__device__ __forceinline__ int t5_bucket(int dist) {
    if (dist < 16) return dist;
    const int b = 8 + (31 - __clz(dist * dist));
    return b < 31 ? b : 31;
}

#define XB_TMO      128
#define XB_XCNT(j)  (256  + 64 * (j))
#define XB_XSUB(j)  (1280 + 64 * (j))
#define XB_XGEN(j)  (2304 + 64 * (j))
#define XB_TOP      3328
#define XB_TOPGEN   3392
#define XCD_BAR_WORDS 3456
#define XB_SPIN_CAP (1u << 18)

__device__ __forceinline__ unsigned xb_ld(unsigned* p)              { return __hip_atomic_load(p, __ATOMIC_RELAXED, __HIP_MEMORY_SCOPE_AGENT); }
__device__ __forceinline__ unsigned xb_add(unsigned* p, unsigned v) { return __hip_atomic_fetch_add(p, v, __ATOMIC_RELAXED, __HIP_MEMORY_SCOPE_AGENT); }
__device__ __forceinline__ unsigned xb_xcc_id() { return (unsigned)__builtin_amdgcn_s_getreg((3 << 11) | 20) & 0xFu; }
#define XB_SPIN(cond, bar) do { unsigned _sp = 0; while (cond) { __builtin_amdgcn_s_sleep(1); \
    if ((++_sp & 255u) == 0u) { if (xb_ld(&(bar)[XB_TMO])) break; if (_sp > XB_SPIN_CAP) { atomicAdd(&(bar)[XB_TMO], 1u); break; } } } } while (0)

struct XcdBarrier {
    unsigned* bar; unsigned x;
    volatile LAS unsigned* st;
};

__device__ __forceinline__ XcdBarrier xcd_barrier_post(unsigned* bar, volatile LAS unsigned* st) {
    XcdBarrier b; b.bar = bar; b.x = xb_xcc_id(); b.st = st;
    if (threadIdx.x == 0) (void)xb_add(&bar[XB_XCNT(b.x)], 1u);
    return b;
}
__device__ __forceinline__ void xcd_barrier_complete(unsigned* bar, unsigned x, unsigned& nloc, unsigned& nx) {
    const unsigned G = gridDim.x * gridDim.y * gridDim.z;
    unsigned sum, cnt, mine, sp = 0u;
    for (;;) {
        sum = 0u; cnt = 0u; mine = 0u;
#pragma unroll
        for (unsigned j = 0; j < 16; ++j) { const unsigned c = xb_ld(&bar[XB_XCNT(j)]); sum += c; cnt += (c > 0u) ? 1u : 0u; mine = (j == x) ? c : mine; }
        if (sum == G) break;
        __builtin_amdgcn_s_sleep(1);
        if ((++sp & 255u) == 0u) { if (xb_ld(&bar[XB_TMO])) break; if (sp > XB_SPIN_CAP) { atomicAdd(&bar[XB_TMO], 1u); break; } }
    }
    nloc = mine > 0u ? mine : 1u; nx = cnt > 0u ? cnt : 1u;
}

__device__ __forceinline__ void xcd_barrier(const XcdBarrier& b) {
    asm volatile("s_waitcnt vmcnt(0)" ::: "memory");
    __syncthreads();
    if (threadIdx.x == 0) {
        unsigned* bar = b.bar;
        __builtin_amdgcn_s_waitcnt(0);
        unsigned nloc = b.st[0], nx = b.st[1];
        if (nloc == 0u) { xcd_barrier_complete(bar, b.x, nloc, nx); b.st[0] = nloc; b.st[1] = nx; }
        const unsigned old = xb_add(&bar[XB_XSUB(b.x)], 1u);
        const unsigned gen = old / nloc;
        if (old + 1u == (gen + 1u) * nloc) {
            __builtin_amdgcn_fence(__ATOMIC_RELEASE, "agent");
            asm volatile("s_waitcnt vmcnt(0)" ::: "memory");
            const unsigned og = xb_add(&bar[XB_TOP], 1u);
            const unsigned tg = og / nx;
            if (og + 1u == (tg + 1u) * nx) xb_add(&bar[XB_TOPGEN], 1u);
            else XB_SPIN(xb_ld(&bar[XB_TOPGEN]) == tg, bar);
            __builtin_amdgcn_fence(__ATOMIC_ACQUIRE, "agent");
            xb_add(&bar[XB_XGEN(b.x)], 1u);
            asm volatile("s_waitcnt vmcnt(0)" ::: "memory");
        } else {
            XB_SPIN(xb_ld(&bar[XB_XGEN(b.x)]) == gen, bar);
            __builtin_amdgcn_fence(__ATOMIC_ACQUIRE, "agent");
            asm volatile("s_waitcnt vmcnt(0)" ::: "memory");
        }
    }
    __syncthreads();
}

struct Args { const float* in[N_IN]; float* out; unsigned char* ws; int ph_lo, ph_hi; };
struct Ctx { LAS unsigned char* lds; int tid, lane, wave, gw, ngw, G; };

template <int DIM> __device__ __forceinline__ float dot_bf(const LAS float* q, const bf16* k) {
    float s = 0.f;
#pragma unroll 4
    for (int d = 0; d < DIM; d += 8) { const v4u w = *(const v4u*)(k + d); const f32x4 q0 = *(const LAS f32x4*)(q + d), q1 = *(const LAS f32x4*)(q + d + 4);
        s += q0.x * lo_bf(w.x) + q0.y * hi_bf(w.x) + q0.z * lo_bf(w.y) + q0.w * hi_bf(w.y) + q1.x * lo_bf(w.z) + q1.y * hi_bf(w.z) + q1.z * lo_bf(w.w) + q1.w * hi_bf(w.w); }
    return s;
}
template <int DIM> __device__ __forceinline__ float dot_f32(const LAS float* q, const float* k) {
    float s = 0.f;
#pragma unroll 4
    for (int d = 0; d < DIM; d += 4) { const f32x4 w = *(const f32x4*)(k + d); const f32x4 q0 = *(const LAS f32x4*)(q + d); s += q0.x * w.x + q0.y * w.y + q0.z * w.z + q0.w * w.w; }
    return s;
}
struct Soft { float m, l, o0, o1; };
__device__ __forceinline__ void soft_init(Soft& S) { S.m = -1e30f; S.l = 0.f; S.o0 = 0.f; S.o1 = 0.f; }
__device__ __forceinline__ void load2(const bf16* p, float& a, float& b) { const unsigned w = *(const unsigned*)p; a = lo_bf(w); b = hi_bf(w); }
__device__ __forceinline__ void load2(const float* p, float& a, float& b) { a = p[0]; b = p[1]; }
template <class VT> __device__ __forceinline__ void soft_chunk(Soft& S, float s, bool valid, int lane, const VT* vbase, long vstride) {
    const unsigned long long vm = __ballot(valid);
    if (vm == 0ull) return;
    const float cm = wave_max(valid ? s : -1e30f), mn = fmaxf(S.m, cm), sc = expf(S.m - mn), p = valid ? expf(s - mn) : 0.f;
    S.l = S.l * sc + wave_sum(p); S.o0 *= sc; S.o1 *= sc; S.m = mn;
    for (int k = 0; k < 64; ++k) if ((vm >> k) & 1ull) {
        const float pk = __shfl(p, k); float a, b; load2(vbase + (long)k * vstride + 2 * lane, a, b);
        S.o0 += pk * a; S.o1 += pk * b; }
}

__device__ __forceinline__ void transpose_item(const float* W, int K, int N, bf16* WT, int row_off, LAS float* scr, int item, int nblk, int lane) {
    const int kb = item / nblk, nb = item % nblk, k0 = 64 * kb, n0 = 32 * nb, nn = n0 + (lane & 31);
#pragma unroll 8
    for (int i = 0; i < 32; ++i) { const int kk = 2 * i + (lane >> 5); scr[kk * 33 + (lane & 31)] = nn < N ? W[(size_t)(k0 + kk) * N + nn] : 0.f; }
    LDS_WAIT(); asm volatile("" ::: "memory");
    const int c = lane & 7;
#pragma unroll
    for (int j = 0; j < 4; ++j) { const int n = (lane >> 3) + 8 * j; const LAS float* s = scr + (8 * c) * 33 + n;
        v4u o; o.x = pk2(s[0 * 33], s[1 * 33]); o.y = pk2(s[2 * 33], s[3 * 33]); o.z = pk2(s[4 * 33], s[5 * 33]); o.w = pk2(s[6 * 33], s[7 * 33]);
        *(v4u*)(WT + (size_t)(row_off + n0 + n) * K + k0 + 8 * c) = o; }
    LDS_WAIT(); asm volatile("" ::: "memory");
}
__device__ __forceinline__ void cvt_rows(const float* src, bf16* dst, size_t n8, size_t gt, size_t nt) {
    for (size_t i = gt; i < n8; i += nt) { const f32x4 a = *(const f32x4*)(src + 8 * i), b = *(const f32x4*)(src + 8 * i + 4);
        v4u o; o.x = pk2(a.x, a.y); o.y = pk2(a.z, a.w); o.z = pk2(b.x, b.y); o.w = pk2(b.z, b.w); *(v4u*)(dst + 8 * i) = o; }
}
__device__ __forceinline__ void ph_prologue(const Args& a, const Ctx& c) {
    LAS float* scr = (LAS float*)(c.lds + c.wave * 16384);
    unsigned char* ws = a.ws;
    constexpr int I0 = 32 * 360, I1 = 8 * 64, I2 = 32 * 64, I3 = 32 * 16, I4 = 64 * 8;
    constexpr int NITEMS = I0 + 2 * I1 + 3 * I2 + 3 * I3 + I1 + I2 + 2 * I4;
    for (int it = c.gw; it < NITEMS; it += c.ngw) {
        int r = it;
        if (r < I0) { transpose_item(a.in[I_WIN], D, NCOMB, (bf16*)(ws + WS_W_IN), 0, scr, r, 360, c.lane); continue; } r -= I0;
        if (r < I1) { transpose_item(a.in[I_WUK], 512, 2048, (bf16*)(ws + WS_W_UKV), 0, scr, r, 64, c.lane); continue; } r -= I1;
        if (r < I1) { transpose_item(a.in[I_WUV], 512, 2048, (bf16*)(ws + WS_W_UKV), 2048, scr, r, 64, c.lane); continue; } r -= I1;
        if (r < I2) { transpose_item(a.in[I_WBN], D, D, (bf16*)(ws + WS_W_BN), 0, scr, r, 64, c.lane); continue; } r -= I2;
        if (r < I2) { transpose_item(a.in[I_WBM], D, D, (bf16*)(ws + WS_W_BM), 0, scr, r, 64, c.lane); continue; } r -= I2;
        if (r < I2) { transpose_item(a.in[I_WMO], D, D, (bf16*)(ws + WS_W_MO), 0, scr, r, 64, c.lane); continue; } r -= I2;
        if (r < I3) { transpose_item(a.in[I_MWQ], D, 512, (bf16*)(ws + WS_W_MQ), 0, scr, r, 16, c.lane); continue; } r -= I3;
        if (r < I3) { transpose_item(a.in[I_MWK], D, 512, (bf16*)(ws + WS_W_MKV), 0, scr, r, 16, c.lane); continue; } r -= I3;
        if (r < I3) { transpose_item(a.in[I_MWV], D, 512, (bf16*)(ws + WS_W_MKV), 512, scr, r, 16, c.lane); continue; } r -= I3;
        if (r < I1) { transpose_item(a.in[I_MWO], 512, D, (bf16*)(ws + WS_W_MO2), 0, scr, r, 64, c.lane); continue; } r -= I1;
        if (r < I2) { transpose_item(a.in[I_PWQ], D, D, (bf16*)(ws + WS_W_PQ), 0, scr, r, 64, c.lane); continue; } r -= I2;
        if (r < I4) { transpose_item(a.in[I_CKW1], 4096, 256, (bf16*)(ws + WS_W_C1K), 0, scr, r, 8, c.lane); continue; } r -= I4;
        transpose_item(a.in[I_CVW1], 4096, 256, (bf16*)(ws + WS_W_C1V), 0, scr, r, 8, c.lane);
    }
    const size_t gt = (size_t)blockIdx.x * NTHREADS + c.tid, nt = (size_t)c.G * NTHREADS;
    cvt_rows(a.in[I_X], (bf16*)(ws + WS_XB), (size_t)NTOK * D / 8, gt, nt);
    cvt_rows(a.in[I_MEM], (bf16*)(ws + WS_MEMB), (size_t)BATCH * NMEM * D / 8, gt, nt);
    for (int o = c.gw; o < 512; o += c.ngw) { const int kv = o >> 8, j = o & 255; const float* pe = a.in[kv ? I_CVPE : I_CKPE]; const float* w1 = a.in[kv ? I_CVW1 : I_CKW1];
        float s = 0.f; for (int r = c.lane; r < 4096; r += 64) s += pe[r] * w1[(size_t)r * 256 + j];
        s = wave_sum(s); if (c.lane == 0) ((float*)(ws + WS_CVEC))[o] = s; }
    for (size_t i = gt; i < 8192; i += nt) { ((bf16*)(ws + WS_CMPA_K))[(size_t)4 * 4096 * 128 + i] = 0; ((bf16*)(ws + WS_CMPA_V))[(size_t)4 * 4096 * 128 + i] = 0; }
}

__device__ __forceinline__ void ph_rowprep(const Args& a, const Ctx& c) {
    unsigned char* ws = a.ws; bf16* PROJ = (bf16*)(ws + WS_PROJ); const int lane = c.lane;
    const float inv = exp2f(-(float)(lane & 31) * (13.287712379549449f / 32.f));
    const float* gk = a.in[I_KVNORM];
    for (int row = c.gw; row < NTOK; row += c.ngw) {
        const int b = row / T, t = row % T; bf16* prow = PROJ + (size_t)row * NCOMBP;
        const float ang = (float)t * inv, cs = cosf(ang), sn = sinf(ang);
        { const v4u w = *(const v4u*)(prow + OFF_MLA_KV + 8 * lane);
          float v[8] = {lo_bf(w.x), hi_bf(w.x), lo_bf(w.y), hi_bf(w.y), lo_bf(w.z), hi_bf(w.z), lo_bf(w.w), hi_bf(w.w)};
          float ss = 0.f;
#pragma unroll
          for (int i = 0; i < 8; ++i) ss += v[i] * v[i];
          const float r = rsqrtf(wave_sum(ss) * (1.f / 512.f) + 1e-6f);
          v4u o; o.x = pk2(v[0] * r * gk[8 * lane], v[1] * r * gk[8 * lane + 1]); o.y = pk2(v[2] * r * gk[8 * lane + 2], v[3] * r * gk[8 * lane + 3]);
          o.z = pk2(v[4] * r * gk[8 * lane + 4], v[5] * r * gk[8 * lane + 5]); o.w = pk2(v[6] * r * gk[8 * lane + 6], v[7] * r * gk[8 * lane + 7]);
          *(v4u*)((bf16*)(ws + WS_CKVN) + (size_t)row * 512 + 8 * lane) = o; }
        if (lane < 32) { const float x1 = bf2f(prow[OFF_MLA_KV + 512 + lane]), x2 = bf2f(prow[OFF_MLA_KV + 512 + 32 + lane]);
          bf16* kp = (bf16*)(ws + WS_KPE) + (size_t)row * 64; kp[lane] = (bf16)f2bf(x1 * cs - x2 * sn); kp[32 + lane] = (bf16)f2bf(x1 * sn + x2 * cs); }
#pragma unroll
        for (int j = 0; j < 8; ++j) { const int p = lane + 64 * j, h = p >> 5, i = p & 31; bf16* q = prow + OFF_MLA_Q + h * 192;
          const float x1 = bf2f(q[128 + i]), x2 = bf2f(q[160 + i]);
          q[128 + i] = (bf16)f2bf((x1 * cs - x2 * sn) * MLA_SCALE); q[160 + i] = (bf16)f2bf((x1 * sn + x2 * cs) * MLA_SCALE); }
#pragma unroll
        for (int j = 0; j < 4; ++j) { const int e = 8 * (lane + 64 * j), h = e >> 7, d = e & 127; bf16* q = prow + OFF_MLA_Q + h * 192 + d;
          const v4u w = *(const v4u*)q; v4u o; o.x = pk2(lo_bf(w.x) * MLA_SCALE, hi_bf(w.x) * MLA_SCALE); o.y = pk2(lo_bf(w.y) * MLA_SCALE, hi_bf(w.y) * MLA_SCALE);
          o.z = pk2(lo_bf(w.z) * MLA_SCALE, hi_bf(w.z) * MLA_SCALE); o.w = pk2(lo_bf(w.w) * MLA_SCALE, hi_bf(w.w) * MLA_SCALE); *(v4u*)q = o; }
        { const int i = lane >> 5, g = (lane >> 4) & 1, ch = lane & 15;
          const v4u w = *(const v4u*)(prow + OFF_NSA_KV + i * 256 + g * 128 + 8 * ch);
          bf16* dst = (bf16*)(ws + (i ? WS_CMPA_V : WS_CMPA_K)) + ((size_t)(b * 2 + g) * T + t) * 128 + 8 * ch; *(v4u*)dst = w; }
    }
}

__device__ __forceinline__ void ph_cmp2(const Args& a, const Ctx& c) {
    unsigned char* ws = a.ws; const float* H1 = (const float*)(ws + WS_H1); const float* cvec = (const float*)(ws + WS_CVEC); float* KCVC = (float*)(ws + WS_KCVC);
    const int gt = blockIdx.x * NTHREADS + c.tid, nt = c.G * NTHREADS;
    for (int o = gt; o < 2 * 1024 * 128; o += nt) { const int kv = o >> 17, m = (o >> 7) & 1023, ch = o & 127;
        const float* h = H1 + ((size_t)kv * 1024 + m) * 256; const float* cv = cvec + kv * 256; const float* w2 = a.in[kv ? I_CVW2 : I_CKW2];
        float s = 0.f; for (int j = 0; j < 256; ++j) s += gelu_tanh(h[j] + cv[j]) * w2[j * 128 + ch];
        KCVC[o] = s; }
}

__device__ __forceinline__ void ph_nsa(const Args& a, const Ctx& c) {
    unsigned char* ws = a.ws; const bf16* PROJ = (const bf16*)(ws + WS_PROJ); const float* KC = (const float*)(ws + WS_KCVC); const float* VC = KC + 1024 * 128;
    const float* relb = a.in[I_RELB]; bf16* ONSA = (bf16*)(ws + WS_ONSA); const int lane = c.lane;
    LAS float* qs = (LAS float*)(c.lds + c.wave * 8192); LAS float* pl = qs + 256;
    for (int task = c.gw; task < NTOK * 2; task += c.ngw) {
        const int g = task & 1, row = task >> 1, b = row / T, t = row % T; const bf16* prow = PROJ + (size_t)row * NCOMBP;
        const int ncv = t >= 31 ? (t - 31) / 16 + 1 : 0;
        const float* kcb = KC + (size_t)(b * 2 + g) * 256 * 128; const float* vcb = VC + (size_t)(b * 2 + g) * 256 * 128;
        float imp = 0.f;
        for (int hh = 0; hh < 8; ++hh) { const int h = g * 8 + hh;
            qs[lane] = bf2f(prow[h * 128 + lane]) * NSA_SCALE; qs[lane + 64] = bf2f(prow[h * 128 + 64 + lane]) * NSA_SCALE; LDS_WAIT();
            float s[4]; bool v[4]; float mx = -1e30f;
#pragma unroll
            for (int i = 0; i < 4; ++i) { const int n = lane + 64 * i; v[i] = n < ncv; s[i] = -1e30f;
                if (v[i]) s[i] = dot_f32<128>(qs, kcb + (size_t)n * 128) + relb[t5_bucket(t - 16 * n - 31) * 16 + h];
                mx = fmaxf(mx, s[i]); }
            mx = wave_max(mx); float p[4], l = 0.f;
#pragma unroll
            for (int i = 0; i < 4; ++i) { p[i] = v[i] ? expf(s[i] - mx) : 0.f; l += p[i]; }
            l = wave_sum(l); const float il = l > 0.f ? 1.f / l : 0.f;
#pragma unroll
            for (int i = 0; i < 4; ++i) pl[lane + 64 * i] = p[i] * il;
            LDS_WAIT();
#pragma unroll
            for (int n = 4 * lane - 1; n <= 4 * lane + 3; ++n) if (n >= 0 && n < 255) imp += pl[n];
            LDS_WAIT(); }
        const int cur = t >> 6; unsigned long long selmask = 0ull;
        { const bool forced = (lane == 0) | (lane == cur) | (lane == cur - 1), validb = lane <= cur;
          float sc = forced ? 1e4f : (validb ? imp : -1e30f);
          for (int r = 0; r < 16; ++r) { const float m = wave_max(sc); if (!(m > -5e29f)) break;
              const int idx = wave_min_i(sc == m ? lane : 64); selmask |= 1ull << idx; if (lane == idx) sc = -3e30f; } }
        if (lane == 0) ((unsigned long long*)(ws + WS_SEL))[task] = selmask;
        for (int hh = 0; hh < 8; ++hh) { const int h = g * 8 + hh;
            qs[lane] = bf2f(prow[h * 128 + lane]) * NSA_SCALE; qs[lane + 64] = bf2f(prow[h * 128 + 64 + lane]) * NSA_SCALE; LDS_WAIT();
            Soft Sc, Ss, Sw; soft_init(Sc); soft_init(Ss); soft_init(Sw);
            for (int i = 0; i < 4; ++i) { const int n = lane + 64 * i; const bool v = n < ncv; float s = 0.f;
                if (v) s = dot_f32<128>(qs, kcb + (size_t)n * 128) + relb[t5_bucket(t - 16 * n - 31) * 16 + h];
                soft_chunk<float>(Sc, s, v, lane, vcb + (size_t)(64 * i) * 128, 128); }
            for (unsigned long long mm = selmask; mm; mm &= mm - 1) { const int j = __ffsll((long long)mm) - 1, sp = 64 * j + lane; const bool v = sp <= t; float s = 0.f;
                const bf16* kb = PROJ + (size_t)(b * T + 64 * j) * NCOMBP + OFF_NSA_KV + 2 * 256 + g * 128;
                if (v) s = dot_bf<128>(qs, kb + (size_t)lane * NCOMBP) + relb[t5_bucket(t - sp) * 16 + h];
                soft_chunk<bf16>(Ss, s, v, lane, kb + 256, NCOMBP); }
            for (int cc = 0; cc < 8; ++cc) { const int s0 = t - 511 + 64 * cc, sp = s0 + lane; const bool v = sp >= 0; float s = 0.f;
                const bf16* kb = PROJ + ((long)(b * T) + s0) * NCOMBP + OFF_NSA_KV + 4 * 256 + g * 128;
                if (v) s = dot_bf<128>(qs, kb + (long)lane * NCOMBP) + relb[t5_bucket(t - sp) * 16 + h];
                soft_chunk<bf16>(Sw, s, v, lane, kb + 256, NCOMBP); }
            const float g0 = sigmoidf_(bf2f(prow[OFF_NSA_GATE + h])), g1 = sigmoidf_(bf2f(prow[OFF_NSA_GATE + 16 + h])), g2 = sigmoidf_(bf2f(prow[OFF_NSA_GATE + 32 + h]));
            const float ic = Sc.l > 0.f ? g0 / Sc.l : 0.f, is = Ss.l > 0.f ? g1 / Ss.l : 0.f, iw = Sw.l > 0.f ? g2 / Sw.l : 0.f;
            *(unsigned*)(ONSA + (size_t)row * D + h * 128 + 2 * lane) = pk2(Sc.o0 * ic + Ss.o0 * is + Sw.o0 * iw, Sc.o1 * ic + Ss.o1 * is + Sw.o1 * iw);
            LDS_WAIT(); }
    }
}

__device__ __forceinline__ void ph_mla(const Args& a, const Ctx& c) {
    unsigned char* ws = a.ws; const bf16* PROJ = (const bf16*)(ws + WS_PROJ); const bf16* KVUP = (const bf16*)(ws + WS_KVUP); const bf16* KPE = (const bf16*)(ws + WS_KPE);
    bf16* OMLA = (bf16*)(ws + WS_OMLA); const int lane = c.lane; LAS float* qs = (LAS float*)(c.lds + c.wave * 8192);
    for (int task = c.gw; task < NTOK * 16; task += c.ngw) {
        const int h = task & 15, row = task >> 4, b = row / T, t = row % T; const bf16* q = PROJ + (size_t)row * NCOMBP + OFF_MLA_Q + h * 192;
        qs[lane] = bf2f(q[lane]); qs[lane + 64] = bf2f(q[lane + 64]); qs[lane + 128] = bf2f(q[lane + 128]); LDS_WAIT();
        Soft S; soft_init(S);
        for (int cc = 0; cc <= (t >> 6); ++cc) { const int sp = 64 * cc + lane; const bool v = sp <= t; float s = 0.f;
            const bf16* kb = KVUP + (size_t)(b * T + 64 * cc) * 4096 + h * 128;
            if (v) s = dot_bf<128>(qs, kb + (size_t)lane * 4096) + dot_bf<64>(qs + 128, KPE + (size_t)(b * T + sp) * 64);
            soft_chunk<bf16>(S, s, v, lane, kb + 2048, 4096); }
        const float il = S.l > 0.f ? 1.f / S.l : 0.f;
        *(unsigned*)(OMLA + (size_t)row * D + h * 128 + 2 * lane) = pk2(S.o0 * il, S.o1 * il);
        LDS_WAIT();
    }
}

__device__ __forceinline__ void ph_merge(const Args& a, const Ctx& c) {
    unsigned char* ws = a.ws; const bf16* PROJ = (const bf16*)(ws + WS_PROJ); const bf16* YN = (const bf16*)(ws + WS_YN); const bf16* YM = (const bf16*)(ws + WS_YM); bf16* MG = (bf16*)(ws + WS_MERGED);
    const size_t gt = (size_t)blockIdx.x * NTHREADS + c.tid, nt = (size_t)c.G * NTHREADS;
    for (size_t i = gt; i < (size_t)NTOK * D / 8; i += nt) { const size_t row = i / (D / 8); const int col = (int)(i % (D / 8)) * 8;
        const v4u g0 = *(const v4u*)(PROJ + row * NCOMBP + OFF_MERGE + col), g1 = *(const v4u*)(PROJ + row * NCOMBP + OFF_MERGE + D + col), yn = *(const v4u*)(YN + row * D + col), ym = *(const v4u*)(YM + row * D + col);
        v4u o;
#define MRG(f) pk2(sigmoidf_(lo_bf(g0.f)) * lo_bf(yn.f) + sigmoidf_(lo_bf(g1.f)) * lo_bf(ym.f), sigmoidf_(hi_bf(g0.f)) * hi_bf(yn.f) + sigmoidf_(hi_bf(g1.f)) * hi_bf(ym.f))
        o.x = MRG(x); o.y = MRG(y); o.z = MRG(z); o.w = MRG(w);
#undef MRG
        *(v4u*)(MG + row * D + col) = o; }
}

__device__ __forceinline__ void ln_rows_store(f32x4 (&v)[8], const float* gam, const float* bet, float* outf, bf16* outb, int lane) {
    float s = 0.f;
#pragma unroll
    for (int j = 0; j < 8; ++j) s += (v[j].x + v[j].y) + (v[j].z + v[j].w);
    const float mean = wave_sum(s) * (1.f / D); float s2 = 0.f;
#pragma unroll
    for (int j = 0; j < 8; ++j) { v[j] = v[j] - mean; s2 += (v[j].x * v[j].x + v[j].y * v[j].y) + (v[j].z * v[j].z + v[j].w * v[j].w); }
    const float rstd = rsqrtf(wave_sum(s2) * (1.f / D) + 1e-5f);
#pragma unroll
    for (int j = 0; j < 8; ++j) { const int e = 4 * lane + 256 * j; const f32x4 gg = *(const f32x4*)(gam + e), bb = *(const f32x4*)(bet + e); const f32x4 o = v[j] * rstd * gg + bb;
        *(f32x4*)(outf + e) = o;
        if (outb) { uint2 w; w.x = pk2(o.x, o.y); w.y = pk2(o.z, o.w); *(uint2*)(outb + e) = w; } }
}
__device__ __forceinline__ void ph_ln(const Ctx& c, const float* xin, const float* z, const float* gam, const float* bet, float* outf, bf16* outb) {
    for (int row = c.gw; row < NTOK; row += c.ngw) { f32x4 v[8];
#pragma unroll
        for (int j = 0; j < 8; ++j) { const size_t e = (size_t)row * D + 4 * c.lane + 256 * j; v[j] = *(const f32x4*)(xin + e) * ALPHA + *(const f32x4*)(z + e); }
        ln_rows_store(v, gam, bet, outf + (size_t)row * D, outb + (size_t)row * D, c.lane); }
}

__device__ __forceinline__ void ph_memattn(const Args& a, const Ctx& c) {
    unsigned char* ws = a.ws; const bf16* QM = (const bf16*)(ws + WS_QMEM); const bf16* KV = (const bf16*)(ws + WS_KVMEM); bf16* OM = (bf16*)(ws + WS_OMEM);
    const int lane = c.lane; LAS float* qs = (LAS float*)(c.lds + c.wave * 8192);
    for (int task = c.gw; task < NTOK * 4; task += c.ngw) { const int h = task & 3, row = task >> 2, b = row / T; const bf16* q = QM + (size_t)row * 512 + h * 128;
        qs[lane] = bf2f(q[lane]) * MEM_SCALE; qs[lane + 64] = bf2f(q[lane + 64]) * MEM_SCALE; LDS_WAIT();
        Soft S; soft_init(S);
        for (int cc = 0; cc < 4; ++cc) { const bf16* kb = KV + (size_t)(b * NMEM + 64 * cc) * 1024 + h * 128;
            const float s = dot_bf<128>(qs, kb + (size_t)lane * 1024); soft_chunk<bf16>(S, s, true, lane, kb + 512, 1024); }
        const float il = 1.f / S.l;
        *(unsigned*)(OM + (size_t)row * 512 + h * 128 + 2 * lane) = pk2(S.o0 * il, S.o1 * il);
        LDS_WAIT(); }
}

__device__ __forceinline__ void top16_of128(float x0, float x1, LAS float* vs, LAS int* is, int lane) {
    for (int r = 0; r < 16; ++r) { const float m = wave_max(fmaxf(x0, x1));
        const int idx = wave_min_i(x0 == m ? lane : (x1 == m ? lane + 64 : 1 << 20));
        if (lane == 0) { vs[r] = m; is[r] = idx; }
        if (idx == lane) x0 = -__builtin_inff(); if (idx == lane + 64) x1 = -__builtin_inff(); }
}
__device__ __forceinline__ void ph_peer_select(const Args& a, const Ctx& c) {
    unsigned char* ws = a.ws; const float* PQ = (const float*)(ws + WS_PQ); const float* keys = a.in[I_PKEYS]; int* PIDX = (int*)(ws + WS_PIDX); float* PGATE = (float*)(ws + WS_PGATE);
    const int lane = c.lane; LAS float* qs = (LAS float*)(c.lds + c.wave * 8192); LAS float* v1 = qs + 256; LAS int* i1 = (LAS int*)(qs + 272); LAS float* v2 = qs + 288; LAS int* i2 = (LAS int*)(qs + 304);
    for (int task = c.gw; task < NTOK * 8; task += c.ngw) { const int hh = task & 7, tok = task >> 3; const float* q = PQ + (size_t)tok * D + hh * 256;
#pragma unroll
        for (int i = 0; i < 4; ++i) qs[lane + 64 * i] = q[lane + 64 * i];
        LDS_WAIT();
        const float a0 = dot_f32<128>(qs, keys + (size_t)lane * 128), a1 = dot_f32<128>(qs, keys + (size_t)(lane + 64) * 128);
        const float b0 = dot_f32<128>(qs + 128, keys + (size_t)(128 + lane) * 128), b1 = dot_f32<128>(qs + 128, keys + (size_t)(128 + lane + 64) * 128);
        top16_of128(a0, a1, v1, i1, lane); top16_of128(b0, b1, v2, i2, lane); LDS_WAIT();
        float cv[4];
#pragma unroll
        for (int k = 0; k < 4; ++k) { const int f = 4 * lane + k; cv[k] = v1[f >> 4] + v2[f & 15]; }
        float top_s = 0.f; int flat = 0;
        for (int r = 0; r < 16; ++r) { const float m = wave_max(fmaxf(fmaxf(cv[0], cv[1]), fmaxf(cv[2], cv[3])));
            int cand = 1 << 20;
#pragma unroll
            for (int k = 3; k >= 0; --k) if (cv[k] == m) cand = 4 * lane + k;
            const int idx = wave_min_i(cand);
            if (lane == r) { top_s = m; flat = idx; }
#pragma unroll
            for (int k = 0; k < 4; ++k) if (idx == 4 * lane + k) cv[k] = -__builtin_inff(); }
        const float mx = __shfl(top_s, 0); const float e = lane < 16 ? expf(top_s - mx) : 0.f; const float l = wave_sum(e);
        if (lane < 16) { PIDX[(size_t)tok * 128 + hh * 16 + lane] = i1[flat >> 4] * 128 + i2[flat & 15]; PGATE[(size_t)tok * 128 + hh * 16 + lane] = e / l; }
        LDS_WAIT(); }
}

__device__ __forceinline__ void ph_peer_ffn(const Args& a, const Ctx& c) {
    unsigned char* ws = a.ws; const float* X2 = (const float*)(ws + WS_X2); const int* PIDX = (const int*)(ws + WS_PIDX); const float* PGATE = (const float*)(ws + WS_PGATE);
    const float* U = a.in[I_PU]; const float* V = a.in[I_PV]; const int lane = c.lane;
    for (int tok = c.gw; tok < NTOK; tok += c.ngw) { f32x4 xv[8], acc[8];
#pragma unroll
        for (int j = 0; j < 8; ++j) { xv[j] = *(const f32x4*)(X2 + (size_t)tok * D + 4 * lane + 256 * j); acc[j] = (f32x4){0.f, 0.f, 0.f, 0.f}; }
        for (int k = 0; k < 128; k += 2) { const int e0 = PIDX[(size_t)tok * 128 + k], e1 = PIDX[(size_t)tok * 128 + k + 1]; const float g0 = PGATE[(size_t)tok * 128 + k], g1 = PGATE[(size_t)tok * 128 + k + 1];
            const float* u0 = U + (size_t)e0 * D + 4 * lane; const float* u1 = U + (size_t)e1 * D + 4 * lane; float d0 = 0.f, d1 = 0.f;
#pragma unroll
            for (int j = 0; j < 8; ++j) { const f32x4 w0 = *(const f32x4*)(u0 + 256 * j), w1 = *(const f32x4*)(u1 + 256 * j);
                d0 += (w0.x * xv[j].x + w0.y * xv[j].y) + (w0.z * xv[j].z + w0.w * xv[j].w); d1 += (w1.x * xv[j].x + w1.y * xv[j].y) + (w1.z * xv[j].z + w1.w * xv[j].w); }
            d0 = wave_sum(d0); d1 = wave_sum(d1); const float c0 = g0 * gelu_tanh(d0), c1 = g1 * gelu_tanh(d1);
            const float* p0 = V + (size_t)e0 * D + 4 * lane; const float* p1 = V + (size_t)e1 * D + 4 * lane;
#pragma unroll
            for (int j = 0; j < 8; ++j) acc[j] += *(const f32x4*)(p0 + 256 * j) * c0 + *(const f32x4*)(p1 + 256 * j) * c1; }
#pragma unroll
        for (int j = 0; j < 8; ++j) acc[j] += xv[j] * ALPHA;
        ln_rows_store(acc, a.in[I_LN3G], a.in[I_LN3B], a.out + (size_t)tok * D, nullptr, lane); }
}

struct OneUnit { int pm, pn; bool has;
    __device__ bool next(int i, pg8::Unit& u) const { if (i != 0 || !has) return false; u.pm = pm; u.pn = pn; return true; }
    __device__ __forceinline__ void a_ready(const pg8::Unit&) const {}
    __device__ __forceinline__ void done(const pg8::Unit&) const {} };

constexpr int N_PHASES = 18;
__global__ void __launch_bounds__(NTHREADS, 2) fwd(Args args) {
    extern __shared__ __attribute__((aligned(16))) unsigned char lds_raw[];
    Ctx c; c.lds = (LAS unsigned char*)lds_raw; c.tid = threadIdx.x; c.lane = c.tid & 63; c.wave = __builtin_amdgcn_readfirstlane(c.tid >> 6);
    c.G = gridDim.x; c.gw = blockIdx.x * NWAVES + c.wave; c.ngw = c.G * NWAVES;
    volatile LAS unsigned* MISC = (volatile LAS unsigned*)(c.lds + MISC_OFF);
    unsigned char* ws = args.ws; unsigned* ctl = (unsigned*)(ws + WS_CTL);
    for (int u = c.tid; u < (LDS_BYTES - LDSCTL_OFF) / 4; u += NTHREADS) ((LAS unsigned*)(c.lds + LDSCTL_OFF))[u] = 0u;
    __syncthreads();
    XcdBarrier bar; bar.bar = ctl + CW_BAR; bar.x = 0; bar.st = nullptr;
    if (N_LAUNCHES == 1) bar = xcd_barrier_post(ctl + CW_BAR, MISC + 8);
    const int lo = args.ph_lo, hi = args.ph_hi;
#define IN(k) (lo <= (k) && (k) < hi)
#define SEAM(k) do { if (N_LAUNCHES == 1 && IN(k) && IN((k) + 1)) xcd_barrier(bar); } while (0)
    LAS unsigned char* ring = c.lds;
    const int bx = (int)blockIdx.x;

    if (IN(0)) { ph_prologue(args, c); } SEAM(0);
    if (IN(1)) {
        { pg8::Gemm g{(const bf16*)(ws + WS_XB), (const bf16*)(ws + WS_W_IN), NTOK, NCOMBP, D, D, D}; pg8::StaticOrder S; S.init(NTOK, NCOMBP, c.G, bx);
          pg8::EpiBf16<0> E{(bf16*)(ws + WS_PROJ), NCOMBP, nullptr, 0, 0, 1.f}; pg8::gemm_phase<pg8::EpiBf16<0>, pg8::StaticOrder, true, true>(ring, g, S, E); }
        { pg8::Gemm g{(const bf16*)(ws + WS_MEMB), (const bf16*)(ws + WS_W_MKV), BATCH * NMEM, 1024, D, D, D}; pg8::StaticOrder S; S.init(BATCH * NMEM, 1024, c.G, bx);
          pg8::EpiBf16<0> E{(bf16*)(ws + WS_KVMEM), 1024, nullptr, 0, 0, 1.f}; pg8::gemm_phase<pg8::EpiBf16<0>, pg8::StaticOrder, true, true>(ring, g, S, E); }
    } SEAM(1);
    if (IN(2)) { ph_rowprep(args, c); } SEAM(2);
    if (IN(3)) {
        { pg8::Gemm g{(const bf16*)(ws + WS_CKVN), (const bf16*)(ws + WS_W_UKV), NTOK, 4096, 512, 512, 512}; pg8::StaticOrder S; S.init(NTOK, 4096, c.G, bx);
          pg8::EpiBf16<0> E{(bf16*)(ws + WS_KVUP), 4096, nullptr, 0, 0, 1.f}; pg8::gemm_phase<pg8::EpiBf16<0>, pg8::StaticOrder, true, true>(ring, g, S, E); }
        { const int kv = (bx >> 2) & 1; OneUnit S{bx & 3, 0, bx < 8};
          pg8::Gemm g{(const bf16*)(ws + (kv ? WS_CMPA_V : WS_CMPA_K)), (const bf16*)(ws + (kv ? WS_W_C1V : WS_W_C1K)), 1024, 256, 4096, 2048, 4096};
          pg8::EpiF32 E{(float*)(ws + WS_H1) + (size_t)kv * 1024 * 256, 256, nullptr}; pg8::gemm_phase<pg8::EpiF32, OneUnit, false, true>(ring, g, S, E); }
    } SEAM(3);
    if (IN(4)) { ph_cmp2(args, c); } SEAM(4);
    if (IN(5)) { ph_nsa(args, c); } SEAM(5);
    if (IN(6)) { ph_mla(args, c); } SEAM(6);
    if (IN(7)) {
        { pg8::Gemm g{(const bf16*)(ws + WS_ONSA), (const bf16*)(ws + WS_W_BN), NTOK, D, D, D, D}; pg8::StaticOrder S; S.init(NTOK, D, c.G, bx);
          pg8::EpiBf16<0> E{(bf16*)(ws + WS_YN), D, nullptr, 0, 0, 1.f}; pg8::gemm_phase<pg8::EpiBf16<0>, pg8::StaticOrder, true, true>(ring, g, S, E); }
        { pg8::Gemm g{(const bf16*)(ws + WS_OMLA), (const bf16*)(ws + WS_W_BM), NTOK, D, D, D, D}; pg8::StaticOrder S; S.init(NTOK, D, c.G, bx);
          pg8::EpiBf16<0> E{(bf16*)(ws + WS_YM), D, nullptr, 0, 0, 1.f}; pg8::gemm_phase<pg8::EpiBf16<0>, pg8::StaticOrder, true, true>(ring, g, S, E); }
    } SEAM(7);
    if (IN(8)) { ph_merge(args, c); } SEAM(8);
    if (IN(9)) { pg8::Gemm g{(const bf16*)(ws + WS_MERGED), (const bf16*)(ws + WS_W_MO), NTOK, D, D, D, D}; pg8::StaticOrder S; S.init(NTOK, D, c.G, bx);
        pg8::EpiF32 E{(float*)(ws + WS_Z), D, nullptr}; pg8::gemm_phase<pg8::EpiF32, pg8::StaticOrder, true, true>(ring, g, S, E); } SEAM(9);
    if (IN(10)) { ph_ln(c, args.in[I_X], (const float*)(ws + WS_Z), args.in[I_LN1G], args.in[I_LN1B], (float*)(ws + WS_X1), (bf16*)(ws + WS_X1B)); } SEAM(10);
    if (IN(11)) { pg8::Gemm g{(const bf16*)(ws + WS_X1B), (const bf16*)(ws + WS_W_MQ), NTOK, 512, D, D, D}; pg8::StaticOrder S; S.init(NTOK, 512, c.G, bx);
        pg8::EpiBf16<0> E{(bf16*)(ws + WS_QMEM), 512, nullptr, 0, 0, 1.f}; pg8::gemm_phase<pg8::EpiBf16<0>, pg8::StaticOrder, true, true>(ring, g, S, E); } SEAM(11);
    if (IN(12)) { ph_memattn(args, c); } SEAM(12);
    if (IN(13)) { pg8::Gemm g{(const bf16*)(ws + WS_OMEM), (const bf16*)(ws + WS_W_MO2), NTOK, D, 512, 512, 512}; pg8::StaticOrder S; S.init(NTOK, D, c.G, bx);
        pg8::EpiF32 E{(float*)(ws + WS_Z), D, nullptr}; pg8::gemm_phase<pg8::EpiF32, pg8::StaticOrder, true, true>(ring, g, S, E); } SEAM(13);
    if (IN(14)) { ph_ln(c, (const float*)(ws + WS_X1), (const float*)(ws + WS_Z), args.in[I_LN2G], args.in[I_LN2B], (float*)(ws + WS_X2), (bf16*)(ws + WS_X2B)); } SEAM(14);
    if (IN(15)) { pg8::Gemm g{(const bf16*)(ws + WS_X2B), (const bf16*)(ws + WS_W_PQ), NTOK, D, D, D, D}; pg8::StaticOrder S; S.init(NTOK, D, c.G, bx);
        pg8::EpiF32 E{(float*)(ws + WS_PQ), D, nullptr}; pg8::gemm_phase<pg8::EpiF32, pg8::StaticOrder, true, true>(ring, g, S, E); } SEAM(15);
    if (IN(16)) { ph_peer_select(args, c); } SEAM(16);
    if (IN(17)) { ph_peer_ffn(args, c); }
#undef IN
#undef SEAM
}

extern "C" void kernel_launch(void* const* d_in, const int* in_sizes, int n_in, void* d_out, int out_size, void* d_ws, size_t ws_size, hipStream_t stream) {
    static int grid = 0;
    if (grid == 0) {
        if (n_in != N_IN || in_sizes[0] != NTOK * D || out_size != NTOK * D || ws_size < WS_END) { fprintf(stderr, "kernel_launch: unexpected shapes (n_in %d, in0 %d, out %d, ws %zu)\n", n_in, n_in > 0 ? in_sizes[0] : -1, out_size, ws_size); grid = -1; return; }
        int dev = 0, cus = 0, per_cu = 0;
        if (hipGetDevice(&dev) != hipSuccess || hipDeviceGetAttribute(&cus, hipDeviceAttributeMultiprocessorCount, dev) != hipSuccess) { grid = -1; return; }
        if (hipFuncSetAttribute((const void*)fwd, hipFuncAttributeMaxDynamicSharedMemorySize, LDS_BYTES) != hipSuccess) { fprintf(stderr, "kernel_launch: hipFuncSetAttribute failed\n"); grid = -1; return; }
        if (hipOccupancyMaxActiveBlocksPerMultiprocessor(&per_cu, (const void*)fwd, NTHREADS, LDS_BYTES) != hipSuccess || per_cu < 1) fprintf(stderr, "kernel_launch: occupancy query reports %d\n", per_cu);
        (void)hipGetLastError();
        grid = cus;
    }
    if (grid < 0) return;
    (void)hipMemsetAsync((char*)d_ws + WS_CTL, 0, CTL_ZERO_BYTES, stream);
    Args a{};
    for (int i = 0; i < N_IN; ++i) a.in[i] = (const float*)d_in[i];
    a.out = (float*)d_out; a.ws = (unsigned char*)d_ws;
    if (N_LAUNCHES == 1) { a.ph_lo = 0; a.ph_hi = N_PHASES; hipLaunchKernelGGL(fwd, dim3(grid), dim3(NTHREADS), LDS_BYTES, stream, a); }
    else for (int p = 0; p < N_PHASES; ++p) { a.ph_lo = p; a.ph_hi = p + 1; hipLaunchKernelGGL(fwd, dim3(grid), dim3(NTHREADS), LDS_BYTES, stream, a); }
    const hipError_t le = hipPeekAtLastError();
    if (le != hipSuccess) fprintf(stderr, "kernel_launch: launch failed: %s\n", hipGetErrorName(le));
}
```

```cpp
#include <hip/hip_runtime.h>
#include <cstdio>
#include <cstdint>
#ifndef N_LAUNCHES
#define N_LAUNCHES 1
#endif
namespace pg8 {
#define PG8_LAS __attribute__((address_space(3)))
typedef unsigned short bf16_t;
typedef short bf16x8 __attribute__((ext_vector_type(8)));
typedef float f32x4 __attribute__((ext_vector_type(4)));
typedef unsigned u32x4 __attribute__((ext_vector_type(4)));
constexpr int BM = 256, BK = 64, HALF = 128, HTB = HALF * BK * 2  , STAGE_BYTES = 8 * HTB, NXCD = 8, WGM = 8;

__host__ __device__ __forceinline__ int lds_byte(int r, int c) { const int st = (r >> 4) * 2 + (c >> 5), rr = r & 15, cc = c & 31, ob = rr * 64 + cc * 2; return st * 1024 + (ob ^ (((ob >> 9) & 1) << 5)); }
__host__ __device__ __forceinline__ void stage_rc(int b, int& R, int& C) { const int st = b / 1024, sb = b % 1024, swz = sb ^ (((sb >> 9) & 1) << 5); R = (st >> 1) * 16 + swz / 64; C = (st & 1) * 32 + (swz % 64) / 2; }
__host__ __device__ __forceinline__ int perm32(int rho) { const int n = rho >> 4, i = rho & 15; return 8 * (i >> 2) + 4 * n + (i & 3); }

struct Unit { int pm, pn; };
struct Gemm { const bf16_t* A; const bf16_t* Bt; int M, N, K, lda, ldb; };

struct StaticOrder {
    int nM, nN, nwg, G, c;
    __host__ __device__ void init(int M, int N, int G_, int c_) { nM = M / BM; nN = N / BM; nwg = nM * nN; G = G_; c = c_; }
    __host__ __device__ bool next(int i, Unit& u) const {
        const long L = (long)i * G + c; if (L >= nwg) return false;
        int wgid = (int)L; { const int q = nwg / NXCD, r = nwg % NXCD, xcd = wgid % NXCD, off = wgid / NXCD; wgid = (xcd < r ? xcd * (q + 1) : r * (q + 1) + (xcd - r) * q) + off; }
        const int nig = WGM * nN, gid = wgid / nig, fm = gid * WGM, gsz = (nM - fm) < WGM ? (nM - fm) : WGM;
        u.pm = fm + ((wgid % nig) % gsz); u.pn = (wgid % nig) / gsz; return true;
    }
    __device__ __forceinline__ void a_ready(const Unit&) const {}
    __device__ __forceinline__ void done(const Unit&) const {}
};

__device__ __forceinline__ unsigned cvt_pk_bf16(float lo, float hi) { unsigned r; asm volatile("v_cvt_pk_bf16_f32 %0, %1, %2" : "=v"(r) : "v"(lo), "v"(hi)); return r; }
typedef float f32x2 __attribute__((ext_vector_type(2)));
__device__ __forceinline__ f32x2 gelu_pk(f32x2 v) {
    const f32x2 av = __builtin_elementwise_abs(v), d = av * 0.2316418882f + 1.0f;
    f32x2 t; t.x = __builtin_amdgcn_rcpf(d.x); t.y = __builtin_amdgcn_rcpf(d.y);
    f32x2 q = t * 0.5307027145f + (-0.7265760135f); q = q * t + 0.7107068705f; q = q * t + (-0.142248368f); q = q * t + 0.127414796f; q = q * t;
    const f32x2 s = (v * v) * (-0.72134752044f);
    f32x2 e; e.x = __builtin_amdgcn_exp2f(s.x); e.y = __builtin_amdgcn_exp2f(s.y);
    const f32x2 m = v * (q * e), r = v - m;
    f32x2 o; o.x = v.x < 0.f ? m.x : r.x; o.y = v.y < 0.f ? m.y : r.y; return o;
}

template <int ACT  > struct EpiBf16 {
    static constexpr bool PERM = true, AFTER_DRAIN = false; static_assert(ACT == 0 || ACT == 1, "EpiBf16: ACT is 0 (none) or 1 (gelu_pk)");
    bf16_t* O; int ldc; const float* bias; int split_cols; size_t split_stride; float scale0;
    __device__ __forceinline__ void operator()(const f32x4 (&acc)[2][2][4][2], const Unit& u, int wr, int wc, int fr, int fq) const {
        const int row0 = u.pm * BM + wr * 64 + fr; int colt = u.pn * BM; bf16_t* base = O;
        float sc = 1.f; if (split_cols) { const int t = colt / split_cols; base += (size_t)t * split_stride; colt -= t * split_cols; if (t == 0) sc = scale0; }
        const int col0 = colt + wc * 32 + 8 * fq, bcol0 = u.pn * BM + wc * 32 + 8 * fq;
        f32x4 bv[2][2];
#pragma unroll
        for (int bj = 0; bj < 2; ++bj)
#pragma unroll
            for (int n = 0; n < 2; ++n) bv[bj][n] = bias ? *(const f32x4*)(bias + bcol0 + bj * HALF + 4 * n) : (f32x4){0.f, 0.f, 0.f, 0.f};
#pragma unroll
        for (int ai = 0; ai < 2; ++ai)
#pragma unroll
            for (int m = 0; m < 4; ++m) { bf16_t* rowp = base + (size_t)(row0 + ai * HALF + m * 16) * ldc + col0;
#pragma unroll
                for (int bj = 0; bj < 2; ++bj) { f32x4 v0 = acc[ai][bj][m][0] + bv[bj][0], v1 = acc[ai][bj][m][1] + bv[bj][1];
                    if (ACT == 1) { f32x2 a = gelu_pk((f32x2){v0[0], v0[1]}), b = gelu_pk((f32x2){v0[2], v0[3]}), c = gelu_pk((f32x2){v1[0], v1[1]}), d = gelu_pk((f32x2){v1[2], v1[3]});
                        v0 = (f32x4){a.x, a.y, b.x, b.y}; v1 = (f32x4){c.x, c.y, d.x, d.y}; }
                    v0 = v0 * sc; v1 = v1 * sc; u32x4 w; w.x = cvt_pk_bf16(v0[0], v0[1]); w.y = cvt_pk_bf16(v0[2], v0[3]); w.z = cvt_pk_bf16(v1[0], v1[1]); w.w = cvt_pk_bf16(v1[2], v1[3]);
                    *(u32x4*)(rowp + bj * HALF) = w; } }
    }
};
struct EpiF32 {
    static constexpr bool PERM = false, AFTER_DRAIN = false;
    float* C; int ldc; const float* bias;
    __device__ __forceinline__ void operator()(const f32x4 (&acc)[2][2][4][2], const Unit& u, int wr, int wc, int fr, int fq) const {
        const int row0 = u.pm * BM + wr * 64 + fr, col0 = u.pn * BM + wc * 32 + 4 * fq;
        f32x4 bv[2][2];
#pragma unroll
        for (int bj = 0; bj < 2; ++bj)
#pragma unroll
            for (int n = 0; n < 2; ++n) bv[bj][n] = bias ? *(const f32x4*)(bias + col0 + bj * HALF + n * 16) : (f32x4){0.f, 0.f, 0.f, 0.f};
#pragma unroll
        for (int ai = 0; ai < 2; ++ai)
#pragma unroll
            for (int m = 0; m < 4; ++m) { float* rowp = C + (size_t)(row0 + ai * HALF + m * 16) * ldc + col0;
#pragma unroll
                for (int bj = 0; bj < 2; ++bj)
#pragma unroll
                    for (int n = 0; n < 2; ++n) *(f32x4*)(rowp + bj * HALF + n * 16) = acc[ai][bj][m][n] + bv[bj][n]; }
    }
};
template <class Epi, class Sched, bool ALIGN_EPI = false, bool SP2 = false>
__device__ __forceinline__ void gemm_phase(PG8_LAS unsigned char* lds, const Gemm g, const Sched& S, const Epi& E) {
    const int tid = threadIdx.x, wid = __builtin_amdgcn_readfirstlane(tid >> 6), lane = tid & 63, wr = wid >> 2, wc = wid & 3, fr = lane & 15, fq = lane >> 4;
    const int K = g.K, nt = K / BK;
    unsigned voffA[2], voffB[2];
#pragma unroll
    for (int i = 0; i < 2; ++i) { int R, C; stage_rc(tid * 16 + i * 8192, R, C); const int Rb = Epi::PERM ? ((R & ~31) + perm32(R & 31)) : R;
        voffA[i] = (unsigned)(R * g.lda + C) * 2u; voffB[i] = (unsigned)(Rb * g.ldb + C) * 2u; }
    const size_t kstep = (size_t)(BK * 2);
    const size_t hstepA = (size_t)HALF * g.lda * 2, hstepB = (size_t)HALF * g.ldb * 2;
    const size_t tstepA = 2 * hstepA, tstepB = 2 * hstepB;
    const unsigned ldsw = (unsigned)wid * 1024u;
    const int aoff = lds_byte(wr * 64 + fr, fq * 8), boff = lds_byte(wc * 32 + fr, fq * 8);
#define PG8_SA(b, h) (((b) * 2 + (h)) * HTB)
#define PG8_SB(b, h) ((4 + (b) * 2 + (h)) * HTB)
#define PG8_STAGE(bufoff, gbase, voff) do { _Pragma("unroll") for (int _i = 0; _i < 2; ++_i) \
        __builtin_amdgcn_global_load_lds((const unsigned*)((const char*)(gbase) + (voff)[_i]), (PG8_LAS unsigned*)(lds + (bufoff) + ldsw + _i * 8192), 16, 0, 0); } while (0)
#define PG8_LDA(dst, b, h) do { _Pragma("unroll") for (int m = 0; m < 4; ++m) _Pragma("unroll") for (int k = 0; k < 2; ++k) dst[m][k] = *(const PG8_LAS bf16x8*)(lds + PG8_SA(b, h) + aoff + m * 2048 + k * 1024); } while (0)
#define PG8_LDB(dst, b, h) do { _Pragma("unroll") for (int n = 0; n < 2; ++n) _Pragma("unroll") for (int k = 0; k < 2; ++k) dst[n][k] = *(const PG8_LAS bf16x8*)(lds + PG8_SB(b, h) + boff + n * 2048 + k * 1024); } while (0)
#define PG8_MMA(ai, bj, At, Bt) do { __builtin_amdgcn_s_setprio(1); _Pragma("unroll") for (int m = 0; m < 4; ++m) _Pragma("unroll") for (int n = 0; n < 2; ++n) _Pragma("unroll") for (int k = 0; k < 2; ++k) \
        acc[ai][bj][m][n] = __builtin_amdgcn_mfma_f32_16x16x32_bf16(Bt[n][k], At[m][k], acc[ai][bj][m][n], 0, 0, 0); __builtin_amdgcn_s_setprio(0); } while (0)
#define PG8_WAIT_V(n) asm volatile("s_waitcnt vmcnt(" #n ")" ::: "memory")
#define PG8_WAIT_L(n) asm volatile("s_waitcnt lgkmcnt(" #n ")" ::: "memory")
#define PG8_BAR __builtin_amdgcn_s_barrier()
#define PG8_SCHED __builtin_amdgcn_sched_barrier(0)
    Unit cur, nxt; int ui = 0;
    if (!S.next(0, cur)) return;
    f32x4 acc[2][2][4][2];
#pragma unroll
    for (int a = 0; a < 2; ++a)
#pragma unroll
        for (int b = 0; b < 2; ++b)
#pragma unroll
            for (int m = 0; m < 4; ++m)
#pragma unroll
                for (int n = 0; n < 2; ++n) acc[a][b][m][n] = (f32x4){0.f, 0.f, 0.f, 0.f};
    bf16x8 At[4][2], B0[2][2], B1[2][2];
    const char* cA = (const char*)g.A + (size_t)cur.pm * tstepA; const char* cB = (const char*)g.Bt + (size_t)cur.pn * tstepB;
    S.a_ready(cur);
    if constexpr (SP2) {
        PG8_STAGE(PG8_SB(0, 0), cB, voffB); PG8_STAGE(PG8_SB(0, 1), cB + hstepB, voffB); PG8_STAGE(PG8_SA(0, 0), cA, voffA); PG8_STAGE(PG8_SA(0, 1), cA + hstepA, voffA);
        if (wr == 1) PG8_BAR;
        PG8_WAIT_V(2); PG8_BAR;
        PG8_STAGE(PG8_SB(1, 0), cB + kstep, voffB); PG8_STAGE(PG8_SA(1, 0), cA + kstep, voffA); PG8_STAGE(PG8_SB(1, 1), cB + hstepB + kstep, voffB);
        PG8_WAIT_V(6); PG8_BAR;
    } else {
        PG8_STAGE(PG8_SB(0, 0), cB, voffB); PG8_STAGE(PG8_SA(0, 0), cA, voffA); PG8_STAGE(PG8_SB(0, 1), cB + hstepB, voffB); PG8_STAGE(PG8_SA(0, 1), cA + hstepA, voffA);
        if (wr == 1) PG8_BAR;
        PG8_WAIT_V(4); PG8_BAR;
        PG8_STAGE(PG8_SB(1, 0), cB + kstep, voffB); PG8_STAGE(PG8_SA(1, 0), cA + kstep, voffA); PG8_STAGE(PG8_SB(1, 1), cB + hstepB + kstep, voffB);
        PG8_WAIT_V(6); PG8_BAR;
    }
    for (;;) {
        const bool has_next = S.next(ui + 1, nxt);
        const char* nA = has_next ? (const char*)g.A + (size_t)nxt.pm * tstepA : cA; const char* nB = has_next ? (const char*)g.Bt + (size_t)nxt.pn * tstepB : cB;
        for (int t = 0; t < nt; t += 2) {
            const bool last = (t == nt - 2);
            const char* a1 = cA + (size_t)(t + 1) * kstep;
            const char* a2 = last ? nA : cA + (size_t)(t + 2) * kstep; const char* b2 = last ? nB : cB + (size_t)(t + 2) * kstep;
            const char* a3 = a2 + kstep; const char* b3 = b2 + kstep;
            if (last && has_next) S.a_ready(nxt);
            if constexpr (SP2) {
            PG8_LDB(B0, 0, 0); PG8_LDB(B1, 0, 1); PG8_SCHED; PG8_LDA(At, 0, 0); PG8_STAGE(PG8_SA(1, 1), a1 + hstepA, voffA);
            PG8_WAIT_V(8); PG8_WAIT_L(0); PG8_BAR; PG8_MMA(0, 0, At, B0); PG8_MMA(0, 1, At, B1); PG8_BAR; PG8_SCHED;
            PG8_LDA(At, 0, 1); PG8_STAGE(PG8_SB(0, 0), b2, voffB); PG8_STAGE(PG8_SB(0, 1), b2 + hstepB, voffB); PG8_STAGE(PG8_SA(0, 0), a2, voffA);
            PG8_WAIT_V(8); PG8_WAIT_L(0); PG8_BAR; PG8_MMA(1, 0, At, B0); PG8_MMA(1, 1, At, B1); PG8_BAR; PG8_SCHED;
            PG8_LDB(B0, 1, 0); PG8_LDB(B1, 1, 1); PG8_SCHED; PG8_LDA(At, 1, 0); PG8_STAGE(PG8_SA(0, 1), a2 + hstepA, voffA);
            PG8_WAIT_V(8); PG8_WAIT_L(0); PG8_BAR; PG8_MMA(0, 0, At, B0); PG8_MMA(0, 1, At, B1); PG8_BAR; PG8_SCHED;
            PG8_LDA(At, 1, 1); PG8_STAGE(PG8_SB(1, 0), b3, voffB); PG8_STAGE(PG8_SB(1, 1), b3 + hstepB, voffB); PG8_STAGE(PG8_SA(1, 0), a3, voffA);
            PG8_WAIT_V(8); PG8_WAIT_L(0); PG8_BAR; PG8_MMA(1, 0, At, B0); PG8_MMA(1, 1, At, B1); PG8_BAR; PG8_SCHED;
            } else {
            PG8_LDB(B0, 0, 0); PG8_SCHED; PG8_LDA(At, 0, 0); PG8_STAGE(PG8_SA(1, 1), a1 + hstepA, voffA);
            PG8_WAIT_L(8); PG8_BAR; PG8_WAIT_L(0); PG8_MMA(0, 0, At, B0); PG8_BAR; PG8_SCHED;
            PG8_LDB(B1, 0, 1); PG8_STAGE(PG8_SB(0, 0), b2, voffB);
            PG8_BAR; PG8_WAIT_L(0); PG8_MMA(0, 1, At, B1); PG8_BAR;
            PG8_LDA(At, 0, 1); PG8_STAGE(PG8_SA(0, 0), a2, voffA);
            PG8_BAR; PG8_WAIT_L(0); PG8_MMA(1, 0, At, B0); PG8_BAR; PG8_SCHED;
            PG8_STAGE(PG8_SB(0, 1), b2 + hstepB, voffB);
            PG8_WAIT_V(6); PG8_BAR; PG8_MMA(1, 1, At, B1); PG8_BAR;
            PG8_LDB(B0, 1, 0); PG8_SCHED; PG8_LDA(At, 1, 0); PG8_STAGE(PG8_SA(0, 1), a2 + hstepA, voffA);
            PG8_WAIT_L(8); PG8_BAR; PG8_WAIT_L(0); PG8_MMA(0, 0, At, B0); PG8_BAR; PG8_SCHED;
            PG8_LDB(B1, 1, 1); PG8_STAGE(PG8_SB(1, 0), b3, voffB);
            PG8_BAR; PG8_WAIT_L(0); PG8_MMA(0, 1, At, B1); PG8_BAR;
            PG8_LDA(At, 1, 1); PG8_STAGE(PG8_SA(1, 0), a3, voffA);
            PG8_BAR; PG8_WAIT_L(0); PG8_MMA(1, 0, At, B0); PG8_BAR; PG8_SCHED;
            PG8_STAGE(PG8_SB(1, 1), b3 + hstepB, voffB);
            PG8_WAIT_V(6); PG8_BAR; PG8_MMA(1, 1, At, B1); PG8_BAR;
            }
        }
        if constexpr (ALIGN_EPI) { if (wr == 0) PG8_BAR; }
        if constexpr (!Epi::AFTER_DRAIN) { E(acc, cur, wr, wc, fr, fq); S.done(cur); }
        if (!has_next) break;
#pragma unroll
        for (int a = 0; a < 2; ++a)
#pragma unroll
            for (int b = 0; b < 2; ++b)
#pragma unroll
                for (int m = 0; m < 4; ++m)
#pragma unroll
                    for (int n = 0; n < 2; ++n) acc[a][b][m][n] = (f32x4){0.f, 0.f, 0.f, 0.f};
        cur = nxt; cA = nA; cB = nB; ++ui;
        if constexpr (ALIGN_EPI) { if (wr == 1) PG8_BAR; }
    }
    PG8_WAIT_V(0);
    if constexpr (!ALIGN_EPI) { if (wr == 0) PG8_BAR; }
    PG8_BAR;
    if constexpr (Epi::AFTER_DRAIN) { E.fused(acc, cur, wr, wc, fr, fq, lds, wid, lane); S.done(cur); }
#undef PG8_SA
#undef PG8_SB
#undef PG8_STAGE
#undef PG8_LDA
#undef PG8_LDB
#undef PG8_MMA
#undef PG8_WAIT_V
#undef PG8_WAIT_L
#undef PG8_BAR
#undef PG8_SCHED
}
}

constexpr int BATCH = 2, T = 4096, D = 2048, NTOK = BATCH * T, NMEM = 256;
constexpr int NCOMB = 11376, NCOMBP = 11520;
constexpr int OFF_NSA_KV = 2048, OFF_NSA_GATE = 3584, OFF_MLA_Q = 3632, OFF_MLA_KV = 6704, OFF_MERGE = 7280;
constexpr float ALPHA = 1.189207115002721f;
constexpr float NSA_SCALE = 0.08838834764831845f, MLA_SCALE = 0.07216878364870323f, MEM_SCALE = 0.08838834764831845f;
enum { I_X = 0, I_MEM, I_RELB, I_WIN, I_CKPE, I_CKW1, I_CKW2, I_CVPE, I_CVW1, I_CVW2, I_KVNORM, I_WUK, I_WUV, I_WBN, I_WBM, I_WMO, I_LN1G, I_LN1B,
       I_MWQ, I_MWK, I_MWV, I_MWO, I_LN2G, I_LN2B, I_PWQ, I_PKEYS, I_PU, I_PV, I_LN3G, I_LN3B, N_IN };

constexpr size_t MiB = 1u << 20;
constexpr size_t WS_CTL = 0, CTL_ZERO_BYTES = 1 * MiB;
constexpr size_t WS_W_IN = 1 * MiB, WS_W_UKV = 46 * MiB, WS_W_BN = 50 * MiB, WS_W_BM = 58 * MiB, WS_W_MO = 66 * MiB, WS_W_MQ = 74 * MiB, WS_W_MKV = 76 * MiB, WS_W_MO2 = 80 * MiB,
                 WS_W_PQ = 82 * MiB, WS_W_C1K = 90 * MiB, WS_W_C1V = 92 * MiB;
constexpr size_t WS_CVEC = 94 * MiB, WS_KCVC = 95 * MiB, WS_H1 = 96 * MiB, WS_SEL = 98 * MiB, WS_KVMEM = 99 * MiB, WS_MEMB = 100 * MiB, WS_KPE = 102 * MiB;
constexpr size_t WS_PROJ = 106 * MiB;
constexpr size_t WS_X1 = 106 * MiB, WS_X2 = 170 * MiB, WS_X1B = 234 * MiB, WS_QMEM = 266 * MiB, WS_OMEM = 274 * MiB;
constexpr size_t WS_KVUP = 286 * MiB, WS_Z = 286 * MiB;
constexpr size_t WS_XB = 350 * MiB, WS_ONSA = 350 * MiB, WS_X2B = 350 * MiB;
constexpr size_t WS_OMLA = 382 * MiB, WS_PQ = 382 * MiB;
constexpr size_t WS_CKVN = 414 * MiB, WS_CMPA_K = 422 * MiB, WS_CMPA_V = 422 * MiB + 4 * MiB + 65536, WS_YN = 414 * MiB;
constexpr size_t WS_YM = 446 * MiB, WS_PIDX = 446 * MiB, WS_PGATE = 450 * MiB;
constexpr size_t WS_MERGED = 478 * MiB, WS_END = 512 * MiB;
constexpr int CW_BAR = 4096;

constexpr int RING_BYTES = 131072, LDSCTL_OFF = RING_BYTES, MISC_OFF = LDSCTL_OFF + 320, LDS_BYTES = 147456;
constexpr int NWAVES = 8, NTHREADS = 512;

#define LAS __attribute__((address_space(3)))
typedef unsigned short bf16;
typedef unsigned v4u __attribute__((ext_vector_type(4)));
typedef float f32x4 __attribute__((ext_vector_type(4)));
#define LDS_WAIT() asm volatile("s_waitcnt lgkmcnt(0)" ::: "memory")

__device__ __forceinline__ unsigned f2bf(float f) { unsigned u = __builtin_bit_cast(unsigned, f); return (u + 0x7fffu + ((u >> 16) & 1u)) >> 16; }
__device__ __forceinline__ unsigned pk2(float lo, float hi) { return f2bf(lo) | (f2bf(hi) << 16); }
__device__ __forceinline__ float bf2f(bf16 h) { return __builtin_bit_cast(float, (unsigned)h << 16); }
__device__ __forceinline__ float lo_bf(unsigned w) { return __builtin_bit_cast(float, w << 16); }
__device__ __forceinline__ float hi_bf(unsigned w) { return __builtin_bit_cast(float, w & 0xffff0000u); }
__device__ __forceinline__ float wave_sum(float v) {
#pragma unroll
    for (int o = 1; o < 64; o <<= 1) v += __shfl_xor(v, o);
    return v;
}
__device__ __forceinline__ float wave_max(float v) {
#pragma unroll
    for (int o = 1; o < 64; o <<= 1) v = fmaxf(v, __shfl_xor(v, o));
    return v;
}
__device__ __forceinline__ int wave_min_i(int v) {
#pragma unroll
    for (int o = 1; o < 64; o <<= 1) { const int w = __shfl_xor(v, o); v = w < v ? w : v; }
    return v;
}
__device__ __forceinline__ float sigmoidf_(float x) { return 1.f / (1.f + expf(-x)); }
__device__ __forceinline__ float gelu_tanh(float x) { return 0.5f * x * (1.f + tanhf(0.7978845608028654f * (x + 0.044715f * x * x * x))); }
__device__ __forceinline__ int t5_bucket(int dist) {
    if (dist < 16) return dist;
    const int b = 8 + (31 - __clz(dist * dist));
    return b < 31 ? b : 31;
}

#define XB_TMO      128
#define XB_XCNT(j)  (256  + 64 * (j))
#define XB_XSUB(j)  (1280 + 64 * (j))
#define XB_XGEN(j)  (2304 + 64 * (j))
#define XB_TOP      3328
#define XB_TOPGEN   3392
#define XCD_BAR_WORDS 3456
#define XB_SPIN_CAP (1u << 18)

__device__ __forceinline__ unsigned xb_ld(unsigned* p)              { return __hip_atomic_load(p, __ATOMIC_RELAXED, __HIP_MEMORY_SCOPE_AGENT); }
__device__ __forceinline__ unsigned xb_add(unsigned* p, unsigned v) { return __hip_atomic_fetch_add(p, v, __ATOMIC_RELAXED, __HIP_MEMORY_SCOPE_AGENT); }
__device__ __forceinline__ unsigned xb_xcc_id() { return (unsigned)__builtin_amdgcn_s_getreg((3 << 11) | 20) & 0xFu; }
#define XB_SPIN(cond, bar) do { unsigned _sp = 0; while (cond) { __builtin_amdgcn_s_sleep(1); \
    if ((++_sp & 255u) == 0u) { if (xb_ld(&(bar)[XB_TMO])) break; if (_sp > XB_SPIN_CAP) { atomicAdd(&(bar)[XB_TMO], 1u); break; } } } } while (0)

struct XcdBarrier {
    unsigned* bar; unsigned x;
    volatile LAS unsigned* st;
};

__device__ __forceinline__ XcdBarrier xcd_barrier_post(unsigned* bar, volatile LAS unsigned* st) {
    XcdBarrier b; b.bar = bar; b.x = xb_xcc_id(); b.st = st;
    if (threadIdx.x == 0) (void)xb_add(&bar[XB_XCNT(b.x)], 1u);
    return b;
}
__device__ __forceinline__ void xcd_barrier_complete(unsigned* bar, unsigned x, unsigned& nloc, unsigned& nx) {
    const unsigned G = gridDim.x * gridDim.y * gridDim.z;
    unsigned sum, cnt, mine, sp = 0u;
    for (;;) {
        sum = 0u; cnt = 0u; mine = 0u;
#pragma unroll
        for (unsigned j = 0; j < 16; ++j) { const unsigned c = xb_ld(&bar[XB_XCNT(j)]); sum += c; cnt += (c > 0u) ? 1u : 0u; mine = (j == x) ? c : mine; }
        if (sum == G) break;
        __builtin_amdgcn_s_sleep(1);
        if ((++sp & 255u) == 0u) { if (xb_ld(&bar[XB_TMO])) break; if (sp > XB_SPIN_CAP) { atomicAdd(&bar[XB_TMO], 1u); break; } }
    }
    nloc = mine > 0u ? mine : 1u; nx = cnt > 0u ? cnt : 1u;
}

__device__ __forceinline__ void xcd_barrier(const XcdBarrier& b) {
    asm volatile("s_waitcnt vmcnt(0)" ::: "memory");
    __syncthreads();
    if (threadIdx.x == 0) {
        unsigned* bar = b.bar;
        __builtin_amdgcn_s_waitcnt(0);
        unsigned nloc = b.st[0], nx = b.st[1];
        if (nloc == 0u) { xcd_barrier_complete(bar, b.x, nloc, nx); b.st[0] = nloc; b.st[1] = nx; }
        const unsigned old = xb_add(&bar[XB_XSUB(b.x)], 1u);
        const unsigned gen = old / nloc;
        if (old + 1u == (gen + 1u) * nloc) {
            __builtin_amdgcn_fence(__ATOMIC_RELEASE, "agent");
            asm volatile("s_waitcnt vmcnt(0)" ::: "memory");
            const unsigned og = xb_add(&bar[XB_TOP], 1u);
            const unsigned tg = og / nx;
            if (og + 1u == (tg + 1u) * nx) xb_add(&bar[XB_TOPGEN], 1u);
            else XB_SPIN(xb_ld(&bar[XB_TOPGEN]) == tg, bar);
            __builtin_amdgcn_fence(__ATOMIC_ACQUIRE, "agent");
            xb_add(&bar[XB_XGEN(b.x)], 1u);
            asm volatile("s_waitcnt vmcnt(0)" ::: "memory");
        } else {
            XB_SPIN(xb_ld(&bar[XB_XGEN(b.x)]) == gen, bar);
            __builtin_amdgcn_fence(__ATOMIC_ACQUIRE, "agent");
            asm volatile("s_waitcnt vmcnt(0)" ::: "memory");
        }
    }
    __syncthreads();
}

struct Args { const float* in[N_IN]; float* out; unsigned char* ws; int ph_lo, ph_hi; };
struct Ctx { LAS unsigned char* lds; int tid, lane, wave, gw, ngw, G; };


namespace fa {
typedef short bf16x8 __attribute__((ext_vector_type(8)));
typedef short s16x4 __attribute__((ext_vector_type(4)));
typedef float f32x16 __attribute__((ext_vector_type(16)));
#define FA_SBAR() __builtin_amdgcn_sched_barrier(0)
#define FA_VMW() asm volatile("s_waitcnt vmcnt(0)" ::: "memory")
constexpr int SHM_V = 16384, OFF_V = 0, OFF_K = 2 * SHM_V, OFF_AL = OFF_K + 2 * 24576, OFF_IMP = OFF_AL + 2048, OFF_SEL = OFF_IMP + 8448, LDS_END = OFF_SEL + 256;
static_assert(LDS_END <= RING_BYTES, "attention LDS map");
constexpr float LOG2E = 1.4426950408889634f, THR = 8.f;

__device__ __forceinline__ int v_st(int k, int c) { const int kk = (k & ~0xC) | ((k & 4) << 1) | ((k & 8) >> 1); return ((kk >> 3) * 4 + (c >> 5)) * 512 + ((kk & 7) * 32 + (c & 31)) * 2; }
__device__ __forceinline__ int v_rd_base(int lane) { return ((lane & 3) << 3) | (((lane >> 2) & 3) << 6) | (((lane >> 4) & 1) << 5) | (((lane >> 5) & 1) << 8); }
constexpr int v_rd_off(int d0, int ks, int half) { return d0 * 512 + ks * 4096 + half * 2048; }
__device__ __forceinline__ int crow(int r, int hi) { return (r & 3) + 8 * (r >> 2) + 4 * hi; }
__device__ __forceinline__ unsigned cvtpk(float lo, float hi) { unsigned r; asm volatile("v_cvt_pk_bf16_f32 %0, %1, %2" : "=v"(r) : "v"(lo), "v"(hi)); return r; }

template <int DQK> struct Geo {
    static constexpr int CPR = DQK / 8, ROWB = DQK * 2, SHM_K = 64 * ROWB, NPASS = SHM_K / 8192, NKS = DQK / 16;
    __device__ static __forceinline__ int swz(int row) { return DQK == 128 ? (row & 7) : ((row >> 1) & 7); }
    __device__ static __forceinline__ int off(int row, int chunk) { return row * ROWB + ((chunk ^ swz(row)) << 4); }
};

__device__ __forceinline__ void mask_tile(f32x16& p0, f32x16& p1, int dq, unsigned W) {
    const float NEG = -__builtin_inff();
#pragma unroll
    for (int r = 0; r < 16; ++r) { const int c = (r & 3) + 8 * (r >> 2);
        if ((unsigned)(dq - c) >= W) p0[r] = NEG;
        if ((unsigned)(dq - c - 32) >= W) p1[r] = NEG; }
}
__device__ __forceinline__ float half_max(float v) { auto rr = __builtin_amdgcn_permlane32_swap(__float_as_uint(v), __float_as_uint(v), false, false); return fmaxf(__uint_as_float(rr[0]), __uint_as_float(rr[1])); }
__device__ __forceinline__ float half_sum(float v) { auto rr = __builtin_amdgcn_permlane32_swap(__float_as_uint(v), __float_as_uint(v), false, false); return __uint_as_float(rr[0]) + __uint_as_float(rr[1]); }
__device__ __forceinline__ float row_max32(const f32x16& p0, const f32x16& p1) {
    float pmax = p0[0];
#pragma unroll
    for (int r = 1; r < 16; ++r) pmax = fmaxf(pmax, p0[r]);
#pragma unroll
    for (int r = 0; r < 16; ++r) pmax = fmaxf(pmax, p1[r]);
    return half_max(pmax);
}
__device__ __forceinline__ void partialSM(f32x16& p0, f32x16& p1, float& m_reg, float& mn, float& alpha) {
    const float pmax = row_max32(p0, p1);
    if (__builtin_expect(__all((pmax - m_reg) <= THR), 1)) { mn = m_reg; alpha = 1.f; }
    else { mn = fmaxf(m_reg, pmax); alpha = __builtin_amdgcn_exp2f((m_reg - mn) * LOG2E); m_reg = mn; }
    const float mnL = -mn * LOG2E;
#pragma unroll
    for (int r = 0; r < 16; ++r) p0[r] = fmaf(p0[r], LOG2E, mnL);
#pragma unroll
    for (int r = 0; r < 16; ++r) p1[r] = fmaf(p1[r], LOG2E, mnL);
#pragma unroll
    for (int r = 0; r < 16; ++r) p0[r] = __builtin_amdgcn_exp2f(p0[r]);
}
#define FA_PK4(P, B_, OUT) do { unsigned a0 = cvtpk(P[B_+0], P[B_+1]), a1 = cvtpk(P[B_+2], P[B_+3]);                          \
        unsigned b0 = cvtpk(P[B_+4], P[B_+5]), b1 = cvtpk(P[B_+6], P[B_+7]);                                             \
        auto r0 = __builtin_amdgcn_permlane32_swap(a0, b0, false, false); auto r1 = __builtin_amdgcn_permlane32_swap(a1, b1, false, false); \
        v4u w = {r0[0], r1[0], r0[1], r1[1]}; OUT = __builtin_bit_cast(bf16x8, w); } while (0)
__device__ __forceinline__ void finishSM(f32x16& p0, f32x16& p1, float alpha, float& l_reg, bf16x8& pa0, bf16x8& pa1, bf16x8& pa2, bf16x8& pa3) {
#pragma unroll
    for (int r = 0; r < 16; ++r) p1[r] = __builtin_amdgcn_exp2f(p1[r]);
    float ps = 0;
#pragma unroll
    for (int r = 0; r < 16; ++r) ps += p0[r];
#pragma unroll
    for (int r = 0; r < 16; ++r) ps += p1[r];
    ps = half_sum(ps);
    l_reg = l_reg * alpha + ps;
    FA_PK4(p0, 0, pa0); FA_PK4(p0, 8, pa1); FA_PK4(p1, 0, pa2); FA_PK4(p1, 8, pa3);
}
template <int DQK, int KB>
__device__ __forceinline__ void qkt(f32x16& p0, f32x16& p1, LAS const char* lds, int r32, int hi, const bf16x8 (&qr)[DQK / 16]) {
    using G = Geo<DQK>;
    p0 = f32x16{}; p1 = f32x16{};
    LAS const char* kb[4];
#pragma unroll
    for (int dd = 0; dd < 4; ++dd) kb[dd] = lds + OFF_K + KB * G::SHM_K + r32 * G::ROWB + (((2 * dd + hi) ^ G::swz(r32)) << 4);
    bf16x8 b0 = *(LAS const bf16x8*)kb[0], b1 = *(LAS const bf16x8*)(kb[0] + 32 * G::ROWB);
#pragma unroll
    for (int d0 = 0; d0 < G::NKS; ++d0) { bf16x8 n0 = b0, n1 = b1;
        if (d0 + 1 < G::NKS) { LAS const char* a = kb[(d0 + 1) & 3] + ((d0 + 1) >> 2) * 128; n0 = *(LAS const bf16x8*)a; n1 = *(LAS const bf16x8*)(a + 32 * G::ROWB); }
        p0 = __builtin_amdgcn_mfma_f32_32x32x16_bf16(b0, qr[d0], p0, 0, 0, 0);
        p1 = __builtin_amdgcn_mfma_f32_32x32x16_bf16(b1, qr[d0], p1, 0, 0, 0);
        FA_SBAR(); b0 = n0; b1 = n1; }
}
template <int VB>
__device__ __forceinline__ void pv_tile(f32x16 (&o)[4], int vb0, bf16x8 pa0, bf16x8 pa1, bf16x8 pa2, bf16x8 pa3) {
#define FA_TRRD(dst, off) asm volatile("ds_read_b64_tr_b16 %0, %1 offset:%2" : "=&v"(dst) : "v"(vb0), "i"(off) : "memory")
#define FA_PV_D0(d0) do { s16x4 l0, l1, l2, l3, h0, h1, h2, h3; constexpr int b_ = OFF_V + VB * SHM_V + v_rd_off(d0, 0, 0); \
        FA_TRRD(l0, b_); FA_TRRD(h0, b_ + 2048); FA_TRRD(l1, b_ + 4096); FA_TRRD(h1, b_ + 6144); FA_TRRD(l2, b_ + 8192); FA_TRRD(h2, b_ + 10240); FA_TRRD(l3, b_ + 12288); FA_TRRD(h3, b_ + 14336); \
        asm volatile("s_waitcnt lgkmcnt(0)" ::: "memory"); FA_SBAR(); \
        o[d0] = __builtin_amdgcn_mfma_f32_32x32x16_bf16(pa0, (bf16x8){l0[0], l0[1], l0[2], l0[3], h0[0], h0[1], h0[2], h0[3]}, o[d0], 0, 0, 0);   \
        o[d0] = __builtin_amdgcn_mfma_f32_32x32x16_bf16(pa1, (bf16x8){l1[0], l1[1], l1[2], l1[3], h1[0], h1[1], h1[2], h1[3]}, o[d0], 0, 0, 0);   \
        o[d0] = __builtin_amdgcn_mfma_f32_32x32x16_bf16(pa2, (bf16x8){l2[0], l2[1], l2[2], l2[3], h2[0], h2[1], h2[2], h2[3]}, o[d0], 0, 0, 0);   \
        o[d0] = __builtin_amdgcn_mfma_f32_32x32x16_bf16(pa3, (bf16x8){l3[0], l3[1], l3[2], l3[3], h3[0], h3[1], h3[2], h3[3]}, o[d0], 0, 0, 0); } while (0)
    FA_PV_D0(0); FA_PV_D0(1); FA_PV_D0(2); FA_PV_D0(3);
#undef FA_PV_D0
#undef FA_TRRD
}

template <int DQK, int MODE, class Pol>
__device__ __forceinline__ void attend(const Pol& P, LAS char* lds, const bf16x8 (&qr)[DQK / 16], unsigned long long tiles, f32x16 (&o)[4], float& m_reg, float& l_reg, const float il_fin, int tid, int wid, int lane) {
    using G = Geo<DQK>;
    if (tiles == 0ull) return;
    asm volatile("" : "+v"(tid), "+v"(lane));
    const int r32 = lane & 31, hi = lane >> 5;
    int koff[G::NPASS];
#pragma unroll
    for (int p = 0; p < G::NPASS; ++p) { const int L = tid + 512 * p; koff[p] = G::off(L / G::CPR, L % G::CPR); }
    const int sr = tid >> 4, sc = (tid & 15) * 8, vst0 = v_st(sr, sc), vst1 = v_st(32 + sr, sc);
    const int vb0 = (int)(unsigned)(uintptr_t)(lds) + v_rd_base(lane);
    LAS float* al_l = (LAS float*)(lds + OFF_AL) + wid * 64 + 32;
    bf16x8 sk[G::NPASS], sv0, sv1;
#define FA_ISSUE(j) do { _Pragma("unroll") for (int p_ = 0; p_ < G::NPASS; ++p_) sk[p_] = *(const bf16x8*)P.kptr(p_, (j)); \
        if (MODE != 1) { sv0 = *(const bf16x8*)P.vptr(0, (j)); sv1 = *(const bf16x8*)P.vptr(1, (j)); } } while (0)
#define FA_WRITE(bf) do { _Pragma("unroll") for (int p_ = 0; p_ < G::NPASS; ++p_) *(LAS bf16x8*)(lds + OFF_K + (bf) * G::SHM_K + koff[p_]) = sk[p_]; \
        if (MODE != 1) { *(LAS bf16x8*)(lds + OFF_V + (bf) * SHM_V + vst0) = sv0; *(LAS bf16x8*)(lds + OFF_V + (bf) * SHM_V + vst1) = sv1; } } while (0)
    int j = __builtin_ctzll(tiles); tiles &= tiles - 1;
    FA_ISSUE(j); FA_VMW(); FA_WRITE(0); __syncthreads();
#define FA_STEP(BF) do { \
        const int jn = tiles ? __builtin_ctzll(tiles) : -1; tiles &= tiles - 1; \
        if (jn >= 0) FA_ISSUE(jn); \
        FA_SBAR(); \
        if (P.act(j)) { f32x16 p0, p1; bf16x8 pa0, pa1, pa2, pa3; \
            qkt<DQK, BF>(p0, p1, lds, r32, hi, qr); \
            P.mod(p0, p1, j); \
            if (MODE == 0) { float mn, alpha; partialSM(p0, p1, m_reg, mn, alpha); \
                if (__any(alpha < 1.f)) { if (hi == 0) al_l[r32] = alpha; LDS_WAIT(); \
                    _Pragma("unroll") for (int d_ = 0; d_ < 4; ++d_) _Pragma("unroll") for (int r = 0; r < 16; ++r) o[d_][r] *= al_l[crow(r, hi)]; } \
                finishSM(p0, p1, alpha, l_reg, pa0, pa1, pa2, pa3); FA_SBAR(); \
                pv_tile<BF>(o, vb0, pa0, pa1, pa2, pa3); } \
            else if (MODE == 1) { const float pmax = row_max32(p0, p1), mn = fmaxf(m_reg, pmax), mnL = -mn * LOG2E; float ps = 0.f; \
                _Pragma("unroll") for (int r = 0; r < 16; ++r) ps += __builtin_amdgcn_exp2f(fmaf(p0[r], LOG2E, mnL)) + __builtin_amdgcn_exp2f(fmaf(p1[r], LOG2E, mnL)); \
                l_reg = l_reg * __builtin_amdgcn_exp2f((m_reg - mn) * LOG2E) + half_sum(ps); m_reg = mn; } \
            else { const float mnL = -m_reg * LOG2E; \
                _Pragma("unroll") for (int r = 0; r < 16; ++r) { p0[r] = __builtin_amdgcn_exp2f(fmaf(p0[r], LOG2E, mnL)) * il_fin; p1[r] = __builtin_amdgcn_exp2f(fmaf(p1[r], LOG2E, mnL)) * il_fin; } \
                P.post(p0, p1, j); \
                FA_PK4(p0, 0, pa0); FA_PK4(p0, 8, pa1); FA_PK4(p1, 0, pa2); FA_PK4(p1, 8, pa3); FA_SBAR(); \
                pv_tile<BF>(o, vb0, pa0, pa1, pa2, pa3); } } \
        FA_SBAR(); \
        if (jn >= 0) { FA_VMW(); FA_WRITE((BF) ^ 1); } \
        __syncthreads(); j = jn; } while (0)
    for (;;) { FA_STEP(0); if (j < 0) break; FA_STEP(1); if (j < 0) break; }
#undef FA_STEP
#undef FA_ISSUE
#undef FA_WRITE
}

__device__ __forceinline__ void scale_rows(f32x16 (&o)[4], float fac, LAS char* lds, int wid, int r32, int hi) {
    LAS float* li_l = (LAS float*)(lds + OFF_AL) + wid * 64;
    if (hi == 0) li_l[r32] = fac;
    LDS_WAIT();
#pragma unroll
    for (int r = 0; r < 16; ++r) { const float f = li_l[crow(r, hi)];
#pragma unroll
        for (int d0 = 0; d0 < 4; ++d0) o[d0][r] *= f; }
    LDS_WAIT();
}
__device__ __forceinline__ void store_bf16(const f32x16 (&o)[4], bf16* O, size_t ldo, int r32, int hi) {
#pragma unroll
    for (int r = 0; r < 16; ++r) { const int orow = crow(r, hi);
#pragma unroll
        for (int d0 = 0; d0 < 4; ++d0) { const float v = o[d0][r]; const float vn = __shfl_xor(v, 1);
            if ((r32 & 1) == 0) *(unsigned*)(O + (size_t)orow * ldo + d0 * 32 + r32) = cvtpk(v, vn); } }
}
}

struct MlaPol {
    const bf16* kp[3]; long kst[3]; const bf16* vp[2]; int qlo, qm;
    __device__ __forceinline__ const bf16* kptr(int p, int j) const { return kp[p] + (long)j * kst[p]; }
    __device__ __forceinline__ const bf16* vptr(int i, int j) const { return vp[i] + (long)j * (64 * 4096); }
    __device__ __forceinline__ bool act(int j) const { return 64 * j <= qlo + 31; }
    __device__ __forceinline__ void mod(fa::f32x16& p0, fa::f32x16& p1, int j) const { if (64 * j + 63 > qlo) fa::mask_tile(p0, p1, qm - 64 * j, 0x7fffffffu); }
    __device__ __forceinline__ void post(fa::f32x16&, fa::f32x16&, int) const {}
};
__device__ __forceinline__ void ph_mla_fa(const Args& a, const Ctx& c) {
    unsigned char* ws = a.ws; const bf16* PROJ = (const bf16*)(ws + WS_PROJ); const bf16* KVUP = (const bf16*)(ws + WS_KVUP); const bf16* KPE = (const bf16*)(ws + WS_KPE);
    bf16* OMLA = (bf16*)(ws + WS_OMLA); const int tid = c.tid, lane = c.lane, wid = c.wave, r32 = lane & 31, hi = lane >> 5;
    for (int item = blockIdx.x; item < BATCH * 16 * 8; item += c.G) {
        const int pr = item & 7, h = (item >> 3) & 15, b = item >> 7;
        for (int pass = 0; pass < 2; ++pass) { const int qb = pass ? 15 - pr : pr, q0 = 256 * qb;
            MlaPol P;
#pragma unroll
            for (int p = 0; p < 3; ++p) { const int L = tid + 512 * p, row = L / 24, ch = L % 24;
                if (ch < 16) { P.kp[p] = KVUP + (size_t)(b * T + row) * 4096 + h * 128 + ch * 8; P.kst[p] = 64 * 4096; }
                else { P.kp[p] = KPE + (size_t)(b * T + row) * 64 + (ch - 16) * 8; P.kst[p] = 64 * 64; } }
            { const int sr = tid >> 4, sc = (tid & 15) * 8; P.vp[0] = KVUP + (size_t)(b * T + sr) * 4096 + 2048 + h * 128 + sc; P.vp[1] = P.vp[0] + (size_t)32 * 4096; }
            P.qlo = q0 + 32 * wid; P.qm = P.qlo + r32 - 4 * hi;
            fa::bf16x8 qr[12]; const bf16* q = PROJ + (size_t)(b * T + P.qlo + r32) * NCOMBP + OFF_MLA_Q + h * 192 + hi * 8;
#pragma unroll
            for (int d0 = 0; d0 < 12; ++d0) qr[d0] = *(const fa::bf16x8*)(q + d0 * 16);
            fa::f32x16 o[4] = {}; float m_reg = -1e30f, l_reg = 0.f;
            const unsigned long long tiles = (2ull << (4 * qb + 3)) - 1ull;
            fa::attend<192, 0>(P, (LAS char*)c.lds, qr, tiles, o, m_reg, l_reg, 0.f, tid, wid, lane);
            fa::scale_rows(o, l_reg > 0.f ? 1.f / l_reg : 0.f, (LAS char*)c.lds, wid, r32, hi);
            fa::store_bf16(o, OMLA + (size_t)(b * T + P.qlo) * D + h * 128, D, r32, hi);
        }
    }
}

constexpr size_t WS_KCB = WS_SEL + 512 * 1024;
constexpr size_t WS_OACC = 446 * MiB;
constexpr int IMP_LD = 65;
__device__ __forceinline__ float t5_bias(float tab, int dist) {
    const int sq = dist * dist, lg = 39 - __clz(sq), b = dist < 16 ? dist : (lg < 31 ? lg : 31);
    return __builtin_bit_cast(float, __builtin_amdgcn_ds_bpermute(b << 2, __builtin_bit_cast(int, tab)));
}
struct NsaSrc { const bf16* kp[2]; const bf16* vp[2]; long kst, vst; };
struct CmpPol { NsaSrc s; int dq0; float tab; LAS float* imp;
    __device__ __forceinline__ const bf16* kptr(int p, int j) const { return s.kp[p] + (long)j * s.kst; }
    __device__ __forceinline__ const bf16* vptr(int i, int j) const { return s.vp[i] + (long)j * s.vst; }
    __device__ __forceinline__ bool act(int) const { return true; }
    __device__ __forceinline__ void mod(fa::f32x16& p0, fa::f32x16& p1, int j) const { const float NEG = -__builtin_inff(); const int d0 = dq0 - 1024 * j;
#pragma unroll
        for (int r = 0; r < 16; ++r) { const int c = (r & 3) + 8 * (r >> 2), da = d0 - 16 * c, db = da - 512;
            p0[r] = da >= 0 ? p0[r] + t5_bias(tab, da) : NEG; p1[r] = db >= 0 ? p1[r] + t5_bias(tab, db) : NEG; if ((r & 3) == 3) FA_SBAR(); } }
    __device__ __forceinline__ void post(fa::f32x16& p0, fa::f32x16& p1, int j) const {
#pragma unroll
        for (int q4 = 0; q4 < 4; ++q4) { LAS float* a = imp + 16 * j + 2 * q4;
            __hip_atomic_fetch_add(a, (p0[4 * q4] + p0[4 * q4 + 1]) + (p0[4 * q4 + 2] + p0[4 * q4 + 3]), __ATOMIC_RELAXED, __HIP_MEMORY_SCOPE_WORKGROUP);
            __hip_atomic_fetch_add(a + 1, p0[4 * q4 + 3], __ATOMIC_RELAXED, __HIP_MEMORY_SCOPE_WORKGROUP);
            __hip_atomic_fetch_add(a + 8, (p1[4 * q4] + p1[4 * q4 + 1]) + (p1[4 * q4 + 2] + p1[4 * q4 + 3]), __ATOMIC_RELAXED, __HIP_MEMORY_SCOPE_WORKGROUP);
            __hip_atomic_fetch_add(a + 9, p1[4 * q4 + 3], __ATOMIC_RELAXED, __HIP_MEMORY_SCOPE_WORKGROUP); } }
};
struct SlcPol { NsaSrc s; int dq0; float tab; unsigned long long sel;
    __device__ __forceinline__ const bf16* kptr(int p, int j) const { return s.kp[p] + (long)j * s.kst; }
    __device__ __forceinline__ const bf16* vptr(int i, int j) const { return s.vp[i] + (long)j * s.vst; }
    __device__ __forceinline__ bool act(int) const { return true; }
    __device__ __forceinline__ void mod(fa::f32x16& p0, fa::f32x16& p1, int j) const { const float NEG = -__builtin_inff(); const int d0 = dq0 - 64 * j; const bool on = (sel >> j) & 1ull;
#pragma unroll
        for (int r = 0; r < 16; ++r) { const int c = (r & 3) + 8 * (r >> 2), da = d0 - c, db = da - 32;
            p0[r] = (on && da >= 0) ? p0[r] + t5_bias(tab, da) : NEG; p1[r] = (on && db >= 0) ? p1[r] + t5_bias(tab, db) : NEG; if ((r & 3) == 3) FA_SBAR(); } }
    __device__ __forceinline__ void post(fa::f32x16&, fa::f32x16&, int) const {}
};
struct WinPol { NsaSrc s; int dq0; float tab;
    __device__ __forceinline__ const bf16* kptr(int p, int j) const { return s.kp[p] + (long)j * s.kst; }
    __device__ __forceinline__ const bf16* vptr(int i, int j) const { return s.vp[i] + (long)j * s.vst; }
    __device__ __forceinline__ bool act(int) const { return true; }
    __device__ __forceinline__ void mod(fa::f32x16& p0, fa::f32x16& p1, int j) const { const float NEG = -__builtin_inff(); const int d0 = dq0 - 64 * j;
#pragma unroll
        for (int r = 0; r < 16; ++r) { const int c = (r & 3) + 8 * (r >> 2), da = d0 - c, db = da - 32;
            p0[r] = (unsigned)da < 512u ? p0[r] + t5_bias(tab, da) : NEG; p1[r] = (unsigned)db < 512u ? p1[r] + t5_bias(tab, db) : NEG; if ((r & 3) == 3) FA_SBAR(); } }
    __device__ __forceinline__ void post(fa::f32x16&, fa::f32x16&, int) const {}
};
template <int MODE> __device__ __forceinline__ void oacc_rw(const fa::f32x16 (&o)[4], float* A, bf16* Bo, int r32, int hi) {
    asm volatile("" : "+v"(A), "+v"(Bo), "+v"(r32), "+v"(hi));
#pragma unroll
    for (int r = 0; r < 16; ++r) { const int orow = fa::crow(r, hi);
#pragma unroll
        for (int d0 = 0; d0 < 4; ++d0) { float* p = A + (size_t)orow * D + d0 * 32 + r32; float v = o[d0][r];
            if (MODE == 0) *p = v;
            else if (MODE == 1) *p = *p + v;
            else { v += *p; const float vn = __shfl_xor(v, 1); if ((r32 & 1) == 0) *(unsigned*)(Bo + (size_t)orow * D + d0 * 32 + r32) = fa::cvtpk(v, vn); } } }
}
__device__ __forceinline__ int opaque_i(int x) { asm volatile("" : "+v"(x)); return x; }
__device__ __forceinline__ void nsa_load_q(fa::bf16x8 (&qr)[8], const bf16* prow, int h, int hi) {
#pragma unroll
    for (int d0 = 0; d0 < 8; ++d0) { const v4u w = *(const v4u*)(prow + h * 128 + d0 * 16 + hi * 8); v4u o;
        o.x = fa::cvtpk(lo_bf(w.x) * NSA_SCALE, hi_bf(w.x) * NSA_SCALE); o.y = fa::cvtpk(lo_bf(w.y) * NSA_SCALE, hi_bf(w.y) * NSA_SCALE);
        o.z = fa::cvtpk(lo_bf(w.z) * NSA_SCALE, hi_bf(w.z) * NSA_SCALE); o.w = fa::cvtpk(lo_bf(w.w) * NSA_SCALE, hi_bf(w.w) * NSA_SCALE); qr[d0] = __builtin_bit_cast(fa::bf16x8, o); }
}
__device__ __forceinline__ void ph_nsa_fa(const Args& a, const Ctx& c) {
    unsigned char* ws = a.ws; const bf16* PROJ = (const bf16*)(ws + WS_PROJ); const bf16* KCB = (const bf16*)(ws + WS_KCB); const bf16* VCB = KCB + 1024 * 128;
    const float* relb = a.in[I_RELB]; bf16* ONSA = (bf16*)(ws + WS_ONSA); float* OACC = (float*)(ws + WS_OACC);
    const int wid = c.wave; LAS char* lds = (LAS char*)c.lds;
    LAS float* impT = (LAS float*)(lds + fa::OFF_IMP); LAS unsigned long long* selT = (LAS unsigned long long*)(lds + fa::OFF_SEL);
    for (int k = 0; ; ++k) { int u;
        if (c.G == 256) { if (k >= 2) break; u = k == 0 ? (int)blockIdx.x : 511 - (int)blockIdx.x; } else { u = (int)blockIdx.x + k * c.G; if (u >= 512) break; }
        const int tb = u >> 2, bg = u & 3, b = bg >> 1, g = bg & 1, h = g * 8 + wid, t0 = 32 * tb;
#define NSA_LANE() const int tid = opaque_i(c.tid), lane = tid & 63, r32 = lane & 31, hi = lane >> 5, sr = tid >> 4, sc = (tid & 15) * 8, tq = t0 + r32; \
        const bf16* prow = PROJ + (size_t)(b * T + tq) * NCOMBP; float* orow0 = OACC + (size_t)(b * T + t0) * D + h * 128; (void)sr; (void)sc; (void)orow0; (void)prow
        { NSA_LANE(); for (int i = tid; i < 32 * IMP_LD; i += NTHREADS) impT[i] = 0.f; }
        __syncthreads();
        { NSA_LANE(); fa::bf16x8 qr[8]; nsa_load_q(qr, prow, h, hi);
          CmpPol P; const bf16* kb = KCB + (size_t)(bg * 256) * 128; const bf16* vb = VCB + (size_t)(bg * 256) * 128;
          P.s.kp[0] = kb + sr * 128 + sc; P.s.kp[1] = P.s.kp[0] + 32 * 128; P.s.vp[0] = vb + sr * 128 + sc; P.s.vp[1] = P.s.vp[0] + 32 * 128; P.s.kst = 64 * 128; P.s.vst = 64 * 128;
          P.dq0 = tq - 31 - 64 * hi; P.tab = relb[r32 * 16 + h]; P.imp = impT + r32 * IMP_LD + hi;
          const unsigned long long tiles = (2ull << (t0 >> 10)) - 1ull;
          fa::f32x16 o[4] = {}; float m_c = -1e30f, l_c = 0.f;
          fa::attend<128, 1>(P, lds, qr, tiles, o, m_c, l_c, 0.f, tid, wid, lane);
          const float il = l_c > 0.f ? 1.f / l_c : 0.f;
          fa::attend<128, 2>(P, lds, qr, tiles, o, m_c, l_c, il, tid, wid, lane);
          { NSA_LANE(); fa::scale_rows(o, sigmoidf_(bf2f(prow[OFF_NSA_GATE + h])), lds, wid, r32, hi);
            oacc_rw<0>(o, orow0, nullptr, r32, hi); } }
        __syncthreads();
        { const int lane = opaque_i(c.lane);
          for (int i = 0; i < 4; ++i) { const int tk = 4 * wid + i, t = t0 + tk, cur = t >> 6; const float impv = impT[tk * IMP_LD + lane];
            const bool forced = (lane == 0) | (lane == cur) | (lane == cur - 1), validb = lane <= cur; float scv = forced ? 1e4f : (validb ? impv : -1e30f);
            unsigned long long selmask = 0ull;
            for (int r = 0; r < 16; ++r) { const float m = wave_max(scv); if (!(m > -5e29f)) break;
                const int sidx = wave_min_i(scv == m ? lane : 64); selmask |= 1ull << sidx; if (lane == sidx) scv = -3e30f; }
            if (lane == 0) selT[tk] = selmask; } }
        __syncthreads();
        { NSA_LANE(); fa::bf16x8 qr[8]; nsa_load_q(qr, prow, h, hi);
          SlcPol P; const bf16* kb = PROJ + (size_t)(b * T) * NCOMBP + OFF_NSA_KV + 2 * 256 + g * 128;
          P.s.kp[0] = kb + (size_t)sr * NCOMBP + sc; P.s.kp[1] = P.s.kp[0] + (size_t)32 * NCOMBP; P.s.vp[0] = P.s.kp[0] + 256; P.s.vp[1] = P.s.kp[1] + 256; P.s.kst = 64 * NCOMBP; P.s.vst = 64 * NCOMBP;
          P.dq0 = tq - 4 * hi; P.tab = relb[r32 * 16 + h]; P.sel = selT[r32];
          unsigned lo = (unsigned)P.sel, hi32 = (unsigned)(P.sel >> 32);
#pragma unroll
          for (int o_ = 1; o_ < 32; o_ <<= 1) { lo |= __shfl_xor(lo, o_); hi32 |= __shfl_xor(hi32, o_); }
          const unsigned long long tiles = ((unsigned long long)(unsigned)__builtin_amdgcn_readfirstlane((int)hi32) << 32) | (unsigned)__builtin_amdgcn_readfirstlane((int)lo);
          fa::f32x16 o[4] = {}; float m_s = -1e30f, l_s = 0.f;
          fa::attend<128, 0>(P, lds, qr, tiles, o, m_s, l_s, 0.f, tid, wid, lane);
          { NSA_LANE(); const float g1 = sigmoidf_(bf2f(prow[OFF_NSA_GATE + 16 + h]));
            fa::scale_rows(o, l_s > 0.f ? g1 / l_s : 0.f, lds, wid, r32, hi);
            oacc_rw<1>(o, orow0, nullptr, r32, hi); } }
        { NSA_LANE(); fa::bf16x8 qr[8]; nsa_load_q(qr, prow, h, hi);
          WinPol P; const bf16* kb = PROJ + (size_t)(b * T) * NCOMBP + OFF_NSA_KV + 4 * 256 + g * 128;
          P.s.kp[0] = kb + (size_t)sr * NCOMBP + sc; P.s.kp[1] = P.s.kp[0] + (size_t)32 * NCOMBP; P.s.vp[0] = P.s.kp[0] + 256; P.s.vp[1] = P.s.kp[1] + 256; P.s.kst = 64 * NCOMBP; P.s.vst = 64 * NCOMBP;
          P.dq0 = tq - 4 * hi; P.tab = relb[r32 * 16 + h];
          const int jlo = t0 >= 511 ? (t0 - 511) >> 6 : 0, jhi = (t0 + 31) >> 6;
          const unsigned long long tiles = ((2ull << jhi) - 1ull) & ~((1ull << jlo) - 1ull);
          fa::f32x16 o[4] = {}; float m_w = -1e30f, l_w = 0.f;
          fa::attend<128, 0>(P, lds, qr, tiles, o, m_w, l_w, 0.f, tid, wid, lane);
          { NSA_LANE(); const float g2 = sigmoidf_(bf2f(prow[OFF_NSA_GATE + 32 + h]));
            fa::scale_rows(o, l_w > 0.f ? g2 / l_w : 0.f, lds, wid, r32, hi);
            oacc_rw<2>(o, orow0, ONSA + (size_t)(b * T + t0) * D + h * 128, r32, hi); } }
        __syncthreads();
#undef NSA_LANE
    }
}
template <int DIM> __device__ __forceinline__ float dot_bf(const LAS float* q, const bf16* k) {
    float s = 0.f;
#pragma unroll 4
    for (int d = 0; d < DIM; d += 8) { const v4u w = *(const v4u*)(k + d); const f32x4 q0 = *(const LAS f32x4*)(q + d), q1 = *(const LAS f32x4*)(q + d + 4);
        s += q0.x * lo_bf(w.x) + q0.y * hi_bf(w.x) + q0.z * lo_bf(w.y) + q0.w * hi_bf(w.y) + q1.x * lo_bf(w.z) + q1.y * hi_bf(w.z) + q1.z * lo_bf(w.w) + q1.w * hi_bf(w.w); }
    return s;
}
template <int DIM> __device__ __forceinline__ float dot_f32(const LAS float* q, const float* k) {
    float s = 0.f;
#pragma unroll 4
    for (int d = 0; d < DIM; d += 4) { const f32x4 w = *(const f32x4*)(k + d); const f32x4 q0 = *(const LAS f32x4*)(q + d); s += q0.x * w.x + q0.y * w.y + q0.z * w.z + q0.w * w.w; }
    return s;
}
struct Soft { float m, l, o0, o1; };
__device__ __forceinline__ void soft_init(Soft& S) { S.m = -1e30f; S.l = 0.f; S.o0 = 0.f; S.o1 = 0.f; }
__device__ __forceinline__ void load2(const bf16* p, float& a, float& b) { const unsigned w = *(const unsigned*)p; a = lo_bf(w); b = hi_bf(w); }
__device__ __forceinline__ void load2(const float* p, float& a, float& b) { a = p[0]; b = p[1]; }
template <class VT> __device__ __forceinline__ void soft_chunk(Soft& S, float s, bool valid, int lane, const VT* vbase, long vstride) {
    const unsigned long long vm = __ballot(valid);
    if (vm == 0ull) return;
    const float cm = wave_max(valid ? s : -1e30f), mn = fmaxf(S.m, cm), sc = expf(S.m - mn), p = valid ? expf(s - mn) : 0.f;
    S.l = S.l * sc + wave_sum(p); S.o0 *= sc; S.o1 *= sc; S.m = mn;
    for (int k = 0; k < 64; ++k) if ((vm >> k) & 1ull) {
        const float pk = __shfl(p, k); float a, b; load2(vbase + (long)k * vstride + 2 * lane, a, b);
        S.o0 += pk * a; S.o1 += pk * b; }
}

__device__ __forceinline__ void transpose_item(const float* W, int K, int N, bf16* WT, int row_off, LAS float* scr, int item, int nblk, int lane) {
    const int kb = item / nblk, nb = item % nblk, k0 = 64 * kb, n0 = 32 * nb, nn = n0 + (lane & 31);
#pragma unroll 8
    for (int i = 0; i < 32; ++i) { const int kk = 2 * i + (lane >> 5); scr[kk * 33 + (lane & 31)] = nn < N ? W[(size_t)(k0 + kk) * N + nn] : 0.f; }
    LDS_WAIT(); asm volatile("" ::: "memory");
    const int c = lane & 7;
#pragma unroll
    for (int j = 0; j < 4; ++j) { const int n = (lane >> 3) + 8 * j; const LAS float* s = scr + (8 * c) * 33 + n;
        v4u o; o.x = pk2(s[0 * 33], s[1 * 33]); o.y = pk2(s[2 * 33], s[3 * 33]); o.z = pk2(s[4 * 33], s[5 * 33]); o.w = pk2(s[6 * 33], s[7 * 33]);
        *(v4u*)(WT + (size_t)(row_off + n0 + n) * K + k0 + 8 * c) = o; }
    LDS_WAIT(); asm volatile("" ::: "memory");
}
__device__ __forceinline__ void cvt_rows(const float* src, bf16* dst, size_t n8, size_t gt, size_t nt) {
    for (size_t i = gt; i < n8; i += nt) { const f32x4 a = *(const f32x4*)(src + 8 * i), b = *(const f32x4*)(src + 8 * i + 4);
        v4u o; o.x = pk2(a.x, a.y); o.y = pk2(a.z, a.w); o.z = pk2(b.x, b.y); o.w = pk2(b.z, b.w); *(v4u*)(dst + 8 * i) = o; }
}
__device__ __forceinline__ void ph_prologue(const Args& a, const Ctx& c) {
    LAS float* scr = (LAS float*)(c.lds + c.wave * 16384);
    unsigned char* ws = a.ws;
    constexpr int I0 = 32 * 360, I1 = 8 * 64, I2 = 32 * 64, I3 = 32 * 16, I4 = 64 * 8;
    constexpr int NITEMS = I0 + 2 * I1 + 3 * I2 + 3 * I3 + I1 + I2 + 2 * I4;
    for (int it = c.gw; it < NITEMS; it += c.ngw) {
        int r = it;
        if (r < I0) { transpose_item(a.in[I_WIN], D, NCOMB, (bf16*)(ws + WS_W_IN), 0, scr, r, 360, c.lane); continue; } r -= I0;
        if (r < I1) { transpose_item(a.in[I_WUK], 512, 2048, (bf16*)(ws + WS_W_UKV), 0, scr, r, 64, c.lane); continue; } r -= I1;
        if (r < I1) { transpose_item(a.in[I_WUV], 512, 2048, (bf16*)(ws + WS_W_UKV), 2048, scr, r, 64, c.lane); continue; } r -= I1;
        if (r < I2) { transpose_item(a.in[I_WBN], D, D, (bf16*)(ws + WS_W_BN), 0, scr, r, 64, c.lane); continue; } r -= I2;
        if (r < I2) { transpose_item(a.in[I_WBM], D, D, (bf16*)(ws + WS_W_BM), 0, scr, r, 64, c.lane); continue; } r -= I2;
        if (r < I2) { transpose_item(a.in[I_WMO], D, D, (bf16*)(ws + WS_W_MO), 0, scr, r, 64, c.lane); continue; } r -= I2;
        if (r < I3) { transpose_item(a.in[I_MWQ], D, 512, (bf16*)(ws + WS_W_MQ), 0, scr, r, 16, c.lane); continue; } r -= I3;
        if (r < I3) { transpose_item(a.in[I_MWK], D, 512, (bf16*)(ws + WS_W_MKV), 0, scr, r, 16, c.lane); continue; } r -= I3;
        if (r < I3) { transpose_item(a.in[I_MWV], D, 512, (bf16*)(ws + WS_W_MKV), 512, scr, r, 16, c.lane); continue; } r -= I3;
        if (r < I1) { transpose_item(a.in[I_MWO], 512, D, (bf16*)(ws + WS_W_MO2), 0, scr, r, 64, c.lane); continue; } r -= I1;
        if (r < I2) { transpose_item(a.in[I_PWQ], D, D, (bf16*)(ws + WS_W_PQ), 0, scr, r, 64, c.lane); continue; } r -= I2;
        if (r < I4) { transpose_item(a.in[I_CKW1], 4096, 256, (bf16*)(ws + WS_W_C1K), 0, scr, r, 8, c.lane); continue; } r -= I4;
        transpose_item(a.in[I_CVW1], 4096, 256, (bf16*)(ws + WS_W_C1V), 0, scr, r, 8, c.lane);
    }
    const size_t gt = (size_t)blockIdx.x * NTHREADS + c.tid, nt = (size_t)c.G * NTHREADS;
    cvt_rows(a.in[I_X], (bf16*)(ws + WS_XB), (size_t)NTOK * D / 8, gt, nt);
    cvt_rows(a.in[I_MEM], (bf16*)(ws + WS_MEMB), (size_t)BATCH * NMEM * D / 8, gt, nt);
    for (int o = c.gw; o < 512; o += c.ngw) { const int kv = o >> 8, j = o & 255; const float* pe = a.in[kv ? I_CVPE : I_CKPE]; const float* w1 = a.in[kv ? I_CVW1 : I_CKW1];
        float s = 0.f; for (int r = c.lane; r < 4096; r += 64) s += pe[r] * w1[(size_t)r * 256 + j];
        s = wave_sum(s); if (c.lane == 0) ((float*)(ws + WS_CVEC))[o] = s; }
    for (size_t i = gt; i < 8192; i += nt) { ((bf16*)(ws + WS_CMPA_K))[(size_t)4 * 4096 * 128 + i] = 0; ((bf16*)(ws + WS_CMPA_V))[(size_t)4 * 4096 * 128 + i] = 0; }
}

__device__ __forceinline__ void ph_rowprep(const Args& a, const Ctx& c) {
    unsigned char* ws = a.ws; bf16* PROJ = (bf16*)(ws + WS_PROJ); const int lane = c.lane;
    const float inv = exp2f(-(float)(lane & 31) * (13.287712379549449f / 32.f));
    const float* gk = a.in[I_KVNORM];
    for (int row = c.gw; row < NTOK; row += c.ngw) {
        const int b = row / T, t = row % T; bf16* prow = PROJ + (size_t)row * NCOMBP;
        const float ang = (float)t * inv, cs = cosf(ang), sn = sinf(ang);
        { const v4u w = *(const v4u*)(prow + OFF_MLA_KV + 8 * lane);
          float v[8] = {lo_bf(w.x), hi_bf(w.x), lo_bf(w.y), hi_bf(w.y), lo_bf(w.z), hi_bf(w.z), lo_bf(w.w), hi_bf(w.w)};
          float ss = 0.f;
#pragma unroll
          for (int i = 0; i < 8; ++i) ss += v[i] * v[i];
          const float r = rsqrtf(wave_sum(ss) * (1.f / 512.f) + 1e-6f);
          v4u o; o.x = pk2(v[0] * r * gk[8 * lane], v[1] * r * gk[8 * lane + 1]); o.y = pk2(v[2] * r * gk[8 * lane + 2], v[3] * r * gk[8 * lane + 3]);
          o.z = pk2(v[4] * r * gk[8 * lane + 4], v[5] * r * gk[8 * lane + 5]); o.w = pk2(v[6] * r * gk[8 * lane + 6], v[7] * r * gk[8 * lane + 7]);
          *(v4u*)((bf16*)(ws + WS_CKVN) + (size_t)row * 512 + 8 * lane) = o; }
        if (lane < 32) { const float x1 = bf2f(prow[OFF_MLA_KV + 512 + lane]), x2 = bf2f(prow[OFF_MLA_KV + 512 + 32 + lane]);
          bf16* kp = (bf16*)(ws + WS_KPE) + (size_t)row * 64; kp[lane] = (bf16)f2bf(x1 * cs - x2 * sn); kp[32 + lane] = (bf16)f2bf(x1 * sn + x2 * cs); }
#pragma unroll
        for (int j = 0; j < 8; ++j) { const int p = lane + 64 * j, h = p >> 5, i = p & 31; bf16* q = prow + OFF_MLA_Q + h * 192;
          const float x1 = bf2f(q[128 + i]), x2 = bf2f(q[160 + i]);
          q[128 + i] = (bf16)f2bf((x1 * cs - x2 * sn) * MLA_SCALE); q[160 + i] = (bf16)f2bf((x1 * sn + x2 * cs) * MLA_SCALE); }
#pragma unroll
        for (int j = 0; j < 4; ++j) { const int e = 8 * (lane + 64 * j), h = e >> 7, d = e & 127; bf16* q = prow + OFF_MLA_Q + h * 192 + d;
          const v4u w = *(const v4u*)q; v4u o; o.x = pk2(lo_bf(w.x) * MLA_SCALE, hi_bf(w.x) * MLA_SCALE); o.y = pk2(lo_bf(w.y) * MLA_SCALE, hi_bf(w.y) * MLA_SCALE);
          o.z = pk2(lo_bf(w.z) * MLA_SCALE, hi_bf(w.z) * MLA_SCALE); o.w = pk2(lo_bf(w.w) * MLA_SCALE, hi_bf(w.w) * MLA_SCALE); *(v4u*)q = o; }
        { const int i = lane >> 5, g = (lane >> 4) & 1, ch = lane & 15;
          const v4u w = *(const v4u*)(prow + OFF_NSA_KV + i * 256 + g * 128 + 8 * ch);
          bf16* dst = (bf16*)(ws + (i ? WS_CMPA_V : WS_CMPA_K)) + ((size_t)(b * 2 + g) * T + t) * 128 + 8 * ch; *(v4u*)dst = w; }
    }
}

__device__ __forceinline__ void ph_cmp2(const Args& a, const Ctx& c) {
    unsigned char* ws = a.ws; const float* H1 = (const float*)(ws + WS_H1); const float* cvec = (const float*)(ws + WS_CVEC); float* KCVC = (float*)(ws + WS_KCVC);
    const int gt = blockIdx.x * NTHREADS + c.tid, nt = c.G * NTHREADS;
    for (int o = gt; o < 2 * 1024 * 128; o += nt) { const int kv = o >> 17, m = (o >> 7) & 1023, ch = o & 127;
        const float* h = H1 + ((size_t)kv * 1024 + m) * 256; const float* cv = cvec + kv * 256; const float* w2 = a.in[kv ? I_CVW2 : I_CKW2];
        float s = 0.f; for (int j = 0; j < 256; ++j) s += gelu_tanh(h[j] + cv[j]) * w2[j * 128 + ch];
        KCVC[o] = s; ((bf16*)(ws + WS_KCB))[o] = (bf16)f2bf(s); }
}

__device__ __forceinline__ void ph_nsa(const Args& a, const Ctx& c) {
    unsigned char* ws = a.ws; const bf16* PROJ = (const bf16*)(ws + WS_PROJ); const float* KC = (const float*)(ws + WS_KCVC); const float* VC = KC + 1024 * 128;
    const float* relb = a.in[I_RELB]; bf16* ONSA = (bf16*)(ws + WS_ONSA); const int lane = c.lane;
    LAS float* qs = (LAS float*)(c.lds + c.wave * 8192); LAS float* pl = qs + 256;
    for (int task = c.gw; task < NTOK * 2; task += c.ngw) {
        const int g = task & 1, row = task >> 1, b = row / T, t = row % T; const bf16* prow = PROJ + (size_t)row * NCOMBP;
        const int ncv = t >= 31 ? (t - 31) / 16 + 1 : 0;
        const float* kcb = KC + (size_t)(b * 2 + g) * 256 * 128; const float* vcb = VC + (size_t)(b * 2 + g) * 256 * 128;
        float imp = 0.f;
        for (int hh = 0; hh < 8; ++hh) { const int h = g * 8 + hh;
            qs[lane] = bf2f(prow[h * 128 + lane]) * NSA_SCALE; qs[lane + 64] = bf2f(prow[h * 128 + 64 + lane]) * NSA_SCALE; LDS_WAIT();
            float s[4]; bool v[4]; float mx = -1e30f;
#pragma unroll
            for (int i = 0; i < 4; ++i) { const int n = lane + 64 * i; v[i] = n < ncv; s[i] = -1e30f;
                if (v[i]) s[i] = dot_f32<128>(qs, kcb + (size_t)n * 128) + relb[t5_bucket(t - 16 * n - 31) * 16 + h];
                mx = fmaxf(mx, s[i]); }
            mx = wave_max(mx); float p[4], l = 0.f;
#pragma unroll
            for (int i = 0; i < 4; ++i) { p[i] = v[i] ? expf(s[i] - mx) : 0.f; l += p[i]; }
            l = wave_sum(l); const float il = l > 0.f ? 1.f / l : 0.f;
#pragma unroll
            for (int i = 0; i < 4; ++i) pl[lane + 64 * i] = p[i] * il;
            LDS_WAIT();
#pragma unroll
            for (int n = 4 * lane - 1; n <= 4 * lane + 3; ++n) if (n >= 0 && n < 255) imp += pl[n];
            LDS_WAIT(); }
        const int cur = t >> 6; unsigned long long selmask = 0ull;
        { const bool forced = (lane == 0) | (lane == cur) | (lane == cur - 1), validb = lane <= cur;
          float sc = forced ? 1e4f : (validb ? imp : -1e30f);
          for (int r = 0; r < 16; ++r) { const float m = wave_max(sc); if (!(m > -5e29f)) break;
              const int idx = wave_min_i(sc == m ? lane : 64); selmask |= 1ull << idx; if (lane == idx) sc = -3e30f; } }
        if (lane == 0) ((unsigned long long*)(ws + WS_SEL))[task] = selmask;
        for (int hh = 0; hh < 8; ++hh) { const int h = g * 8 + hh;
            qs[lane] = bf2f(prow[h * 128 + lane]) * NSA_SCALE; qs[lane + 64] = bf2f(prow[h * 128 + 64 + lane]) * NSA_SCALE; LDS_WAIT();
            Soft Sc, Ss, Sw; soft_init(Sc); soft_init(Ss); soft_init(Sw);
            for (int i = 0; i < 4; ++i) { const int n = lane + 64 * i; const bool v = n < ncv; float s = 0.f;
                if (v) s = dot_f32<128>(qs, kcb + (size_t)n * 128) + relb[t5_bucket(t - 16 * n - 31) * 16 + h];
                soft_chunk<float>(Sc, s, v, lane, vcb + (size_t)(64 * i) * 128, 128); }
            for (unsigned long long mm = selmask; mm; mm &= mm - 1) { const int j = __ffsll((long long)mm) - 1, sp = 64 * j + lane; const bool v = sp <= t; float s = 0.f;
                const bf16* kb = PROJ + (size_t)(b * T + 64 * j) * NCOMBP + OFF_NSA_KV + 2 * 256 + g * 128;
                if (v) s = dot_bf<128>(qs, kb + (size_t)lane * NCOMBP) + relb[t5_bucket(t - sp) * 16 + h];
                soft_chunk<bf16>(Ss, s, v, lane, kb + 256, NCOMBP); }
            for (int cc = 0; cc < 8; ++cc) { const int s0 = t - 511 + 64 * cc, sp = s0 + lane; const bool v = sp >= 0; float s = 0.f;
                const bf16* kb = PROJ + ((long)(b * T) + s0) * NCOMBP + OFF_NSA_KV + 4 * 256 + g * 128;
                if (v) s = dot_bf<128>(qs, kb + (long)lane * NCOMBP) + relb[t5_bucket(t - sp) * 16 + h];
                soft_chunk<bf16>(Sw, s, v, lane, kb + 256, NCOMBP); }
            const float g0 = sigmoidf_(bf2f(prow[OFF_NSA_GATE + h])), g1 = sigmoidf_(bf2f(prow[OFF_NSA_GATE + 16 + h])), g2 = sigmoidf_(bf2f(prow[OFF_NSA_GATE + 32 + h]));
            const float ic = Sc.l > 0.f ? g0 / Sc.l : 0.f, is = Ss.l > 0.f ? g1 / Ss.l : 0.f, iw = Sw.l > 0.f ? g2 / Sw.l : 0.f;
            *(unsigned*)(ONSA + (size_t)row * D + h * 128 + 2 * lane) = pk2(Sc.o0 * ic + Ss.o0 * is + Sw.o0 * iw, Sc.o1 * ic + Ss.o1 * is + Sw.o1 * iw);
            LDS_WAIT(); }
    }
}

__device__ __forceinline__ void ph_mla(const Args& a, const Ctx& c) {
    unsigned char* ws = a.ws; const bf16* PROJ = (const bf16*)(ws + WS_PROJ); const bf16* KVUP = (const bf16*)(ws + WS_KVUP); const bf16* KPE = (const bf16*)(ws + WS_KPE);
    bf16* OMLA = (bf16*)(ws + WS_OMLA); const int lane = c.lane; LAS float* qs = (LAS float*)(c.lds + c.wave * 8192);
    for (int task = c.gw; task < NTOK * 16; task += c.ngw) {
        const int h = task & 15, row = task >> 4, b = row / T, t = row % T; const bf16* q = PROJ + (size_t)row * NCOMBP + OFF_MLA_Q + h * 192;
        qs[lane] = bf2f(q[lane]); qs[lane + 64] = bf2f(q[lane + 64]); qs[lane + 128] = bf2f(q[lane + 128]); LDS_WAIT();
        Soft S; soft_init(S);
        for (int cc = 0; cc <= (t >> 6); ++cc) { const int sp = 64 * cc + lane; const bool v = sp <= t; float s = 0.f;
            const bf16* kb = KVUP + (size_t)(b * T + 64 * cc) * 4096 + h * 128;
            if (v) s = dot_bf<128>(qs, kb + (size_t)lane * 4096) + dot_bf<64>(qs + 128, KPE + (size_t)(b * T + sp) * 64);
            soft_chunk<bf16>(S, s, v, lane, kb + 2048, 4096); }
        const float il = S.l > 0.f ? 1.f / S.l : 0.f;
        *(unsigned*)(OMLA + (size_t)row * D + h * 128 + 2 * lane) = pk2(S.o0 * il, S.o1 * il);
        LDS_WAIT();
    }
}

__device__ __forceinline__ void ph_merge(const Args& a, const Ctx& c) {
    unsigned char* ws = a.ws; const bf16* PROJ = (const bf16*)(ws + WS_PROJ); const bf16* YN = (const bf16*)(ws + WS_YN); const bf16* YM = (const bf16*)(ws + WS_YM); bf16* MG = (bf16*)(ws + WS_MERGED);
    const size_t gt = (size_t)blockIdx.x * NTHREADS + c.tid, nt = (size_t)c.G * NTHREADS;
    for (size_t i = gt; i < (size_t)NTOK * D / 8; i += nt) { const size_t row = i / (D / 8); const int col = (int)(i % (D / 8)) * 8;
        const v4u g0 = *(const v4u*)(PROJ + row * NCOMBP + OFF_MERGE + col), g1 = *(const v4u*)(PROJ + row * NCOMBP + OFF_MERGE + D + col), yn = *(const v4u*)(YN + row * D + col), ym = *(const v4u*)(YM + row * D + col);
        v4u o;
#define MRG(f) pk2(sigmoidf_(lo_bf(g0.f)) * lo_bf(yn.f) + sigmoidf_(lo_bf(g1.f)) * lo_bf(ym.f), sigmoidf_(hi_bf(g0.f)) * hi_bf(yn.f) + sigmoidf_(hi_bf(g1.f)) * hi_bf(ym.f))
        o.x = MRG(x); o.y = MRG(y); o.z = MRG(z); o.w = MRG(w);
#undef MRG
        *(v4u*)(MG + row * D + col) = o; }
}

__device__ __forceinline__ void ln_rows_store(f32x4 (&v)[8], const float* gam, const float* bet, float* outf, bf16* outb, int lane) {
    float s = 0.f;
#pragma unroll
    for (int j = 0; j < 8; ++j) s += (v[j].x + v[j].y) + (v[j].z + v[j].w);
    const float mean = wave_sum(s) * (1.f / D); float s2 = 0.f;
#pragma unroll
    for (int j = 0; j < 8; ++j) { v[j] = v[j] - mean; s2 += (v[j].x * v[j].x + v[j].y * v[j].y) + (v[j].z * v[j].z + v[j].w * v[j].w); }
    const float rstd = rsqrtf(wave_sum(s2) * (1.f / D) + 1e-5f);
#pragma unroll
    for (int j = 0; j < 8; ++j) { const int e = 4 * lane + 256 * j; const f32x4 gg = *(const f32x4*)(gam + e), bb = *(const f32x4*)(bet + e); const f32x4 o = v[j] * rstd * gg + bb;
        *(f32x4*)(outf + e) = o;
        if (outb) { uint2 w; w.x = pk2(o.x, o.y); w.y = pk2(o.z, o.w); *(uint2*)(outb + e) = w; } }
}
__device__ __forceinline__ void ph_ln(const Ctx& c, const float* xin, const float* z, const float* gam, const float* bet, float* outf, bf16* outb) {
    for (int row = c.gw; row < NTOK; row += c.ngw) { f32x4 v[8];
#pragma unroll
        for (int j = 0; j < 8; ++j) { const size_t e = (size_t)row * D + 4 * c.lane + 256 * j; v[j] = *(const f32x4*)(xin + e) * ALPHA + *(const f32x4*)(z + e); }
        ln_rows_store(v, gam, bet, outf + (size_t)row * D, outb + (size_t)row * D, c.lane); }
}

__device__ __forceinline__ void ph_memattn(const Args& a, const Ctx& c) {
    unsigned char* ws = a.ws; const bf16* QM = (const bf16*)(ws + WS_QMEM); const bf16* KV = (const bf16*)(ws + WS_KVMEM); bf16* OM = (bf16*)(ws + WS_OMEM);
    const int lane = c.lane; LAS float* qs = (LAS float*)(c.lds + c.wave * 8192);
    for (int task = c.gw; task < NTOK * 4; task += c.ngw) { const int h = task & 3, row = task >> 2, b = row / T; const bf16* q = QM + (size_t)row * 512 + h * 128;
        qs[lane] = bf2f(q[lane]) * MEM_SCALE; qs[lane + 64] = bf2f(q[lane + 64]) * MEM_SCALE; LDS_WAIT();
        Soft S; soft_init(S);
        for (int cc = 0; cc < 4; ++cc) { const bf16* kb = KV + (size_t)(b * NMEM + 64 * cc) * 1024 + h * 128;
            const float s = dot_bf<128>(qs, kb + (size_t)lane * 1024); soft_chunk<bf16>(S, s, true, lane, kb + 512, 1024); }
        const float il = 1.f / S.l;
        *(unsigned*)(OM + (size_t)row * 512 + h * 128 + 2 * lane) = pk2(S.o0 * il, S.o1 * il);
        LDS_WAIT(); }
}

__device__ __forceinline__ void top16_of128(float x0, float x1, LAS float* vs, LAS int* is, int lane) {
    for (int r = 0; r < 16; ++r) { const float m = wave_max(fmaxf(x0, x1));
        const int idx = wave_min_i(x0 == m ? lane : (x1 == m ? lane + 64 : 1 << 20));
        if (lane == 0) { vs[r] = m; is[r] = idx; }
        if (idx == lane) x0 = -__builtin_inff(); if (idx == lane + 64) x1 = -__builtin_inff(); }
}
__device__ __forceinline__ void ph_peer_select(const Args& a, const Ctx& c) {
    unsigned char* ws = a.ws; const float* PQ = (const float*)(ws + WS_PQ); const float* keys = a.in[I_PKEYS]; int* PIDX = (int*)(ws + WS_PIDX); float* PGATE = (float*)(ws + WS_PGATE);
    const int lane = c.lane; LAS float* qs = (LAS float*)(c.lds + c.wave * 8192); LAS float* v1 = qs + 256; LAS int* i1 = (LAS int*)(qs + 272); LAS float* v2 = qs + 288; LAS int* i2 = (LAS int*)(qs + 304);
    for (int task = c.gw; task < NTOK * 8; task += c.ngw) { const int hh = task & 7, tok = task >> 3; const float* q = PQ + (size_t)tok * D + hh * 256;
#pragma unroll
        for (int i = 0; i < 4; ++i) qs[lane + 64 * i] = q[lane + 64 * i];
        LDS_WAIT();
        const float a0 = dot_f32<128>(qs, keys + (size_t)lane * 128), a1 = dot_f32<128>(qs, keys + (size_t)(lane + 64) * 128);
        const float b0 = dot_f32<128>(qs + 128, keys + (size_t)(128 + lane) * 128), b1 = dot_f32<128>(qs + 128, keys + (size_t)(128 + lane + 64) * 128);
        top16_of128(a0, a1, v1, i1, lane); top16_of128(b0, b1, v2, i2, lane); LDS_WAIT();
        float cv[4];
#pragma unroll
        for (int k = 0; k < 4; ++k) { const int f = 4 * lane + k; cv[k] = v1[f >> 4] + v2[f & 15]; }
        float top_s = 0.f; int flat = 0;
        for (int r = 0; r < 16; ++r) { const float m = wave_max(fmaxf(fmaxf(cv[0], cv[1]), fmaxf(cv[2], cv[3])));
            int cand = 1 << 20;
#pragma unroll
            for (int k = 3; k >= 0; --k) if (cv[k] == m) cand = 4 * lane + k;
            const int idx = wave_min_i(cand);
            if (lane == r) { top_s = m; flat = idx; }
#pragma unroll
            for (int k = 0; k < 4; ++k) if (idx == 4 * lane + k) cv[k] = -__builtin_inff(); }
        const float mx = __shfl(top_s, 0); const float e = lane < 16 ? expf(top_s - mx) : 0.f; const float l = wave_sum(e);
        if (lane < 16) { PIDX[(size_t)tok * 128 + hh * 16 + lane] = i1[flat >> 4] * 128 + i2[flat & 15]; PGATE[(size_t)tok * 128 + hh * 16 + lane] = e / l; }
        LDS_WAIT(); }
}

__device__ __forceinline__ void ph_peer_ffn(const Args& a, const Ctx& c) {
    unsigned char* ws = a.ws; const float* X2 = (const float*)(ws + WS_X2); const int* PIDX = (const int*)(ws + WS_PIDX); const float* PGATE = (const float*)(ws + WS_PGATE);
    const float* U = a.in[I_PU]; const float* V = a.in[I_PV]; const int lane = c.lane;
    for (int tok = c.gw; tok < NTOK; tok += c.ngw) { f32x4 xv[8], acc[8];
#pragma unroll
        for (int j = 0; j < 8; ++j) { xv[j] = *(const f32x4*)(X2 + (size_t)tok * D + 4 * lane + 256 * j); acc[j] = (f32x4){0.f, 0.f, 0.f, 0.f}; }
        for (int k = 0; k < 128; k += 2) { const int e0 = PIDX[(size_t)tok * 128 + k], e1 = PIDX[(size_t)tok * 128 + k + 1]; const float g0 = PGATE[(size_t)tok * 128 + k], g1 = PGATE[(size_t)tok * 128 + k + 1];
            const float* u0 = U + (size_t)e0 * D + 4 * lane; const float* u1 = U + (size_t)e1 * D + 4 * lane; float d0 = 0.f, d1 = 0.f;
#pragma unroll
            for (int j = 0; j < 8; ++j) { const f32x4 w0 = *(const f32x4*)(u0 + 256 * j), w1 = *(const f32x4*)(u1 + 256 * j);
                d0 += (w0.x * xv[j].x + w0.y * xv[j].y) + (w0.z * xv[j].z + w0.w * xv[j].w); d1 += (w1.x * xv[j].x + w1.y * xv[j].y) + (w1.z * xv[j].z + w1.w * xv[j].w); }
            d0 = wave_sum(d0); d1 = wave_sum(d1); const float c0 = g0 * gelu_tanh(d0), c1 = g1 * gelu_tanh(d1);
            const float* p0 = V + (size_t)e0 * D + 4 * lane; const float* p1 = V + (size_t)e1 * D + 4 * lane;
#pragma unroll
            for (int j = 0; j < 8; ++j) acc[j] += *(const f32x4*)(p0 + 256 * j) * c0 + *(const f32x4*)(p1 + 256 * j) * c1; }
#pragma unroll
        for (int j = 0; j < 8; ++j) acc[j] += xv[j] * ALPHA;
        ln_rows_store(acc, a.in[I_LN3G], a.in[I_LN3B], a.out + (size_t)tok * D, nullptr, lane); }
}

struct OneUnit { int pm, pn; bool has;
    __device__ bool next(int i, pg8::Unit& u) const { if (i != 0 || !has) return false; u.pm = pm; u.pn = pn; return true; }
    __device__ __forceinline__ void a_ready(const pg8::Unit&) const {}
    __device__ __forceinline__ void done(const pg8::Unit&) const {} };

constexpr int N_PHASES = 18;
__global__ void __launch_bounds__(NTHREADS, 2) fwd(Args args) {
    extern __shared__ __attribute__((aligned(16))) unsigned char lds_raw[];
    Ctx c; c.lds = (LAS unsigned char*)lds_raw; c.tid = threadIdx.x; c.lane = c.tid & 63; c.wave = __builtin_amdgcn_readfirstlane(c.tid >> 6);
    c.G = gridDim.x; c.gw = blockIdx.x * NWAVES + c.wave; c.ngw = c.G * NWAVES;
    volatile LAS unsigned* MISC = (volatile LAS unsigned*)(c.lds + MISC_OFF);
    unsigned char* ws = args.ws; unsigned* ctl = (unsigned*)(ws + WS_CTL);
    for (int u = c.tid; u < (LDS_BYTES - LDSCTL_OFF) / 4; u += NTHREADS) ((LAS unsigned*)(c.lds + LDSCTL_OFF))[u] = 0u;
    __syncthreads();
    XcdBarrier bar; bar.bar = ctl + CW_BAR; bar.x = 0; bar.st = nullptr;
    if (N_LAUNCHES == 1) bar = xcd_barrier_post(ctl + CW_BAR, MISC + 8);
    const int lo = args.ph_lo, hi = args.ph_hi;
#define IN(k) (lo <= (k) && (k) < hi)
#define SEAM(k) do { if (N_LAUNCHES == 1 && IN(k) && IN((k) + 1)) xcd_barrier(bar); } while (0)
    LAS unsigned char* ring = c.lds;
    const int bx = (int)blockIdx.x;

    if (IN(0)) { ph_prologue(args, c); } SEAM(0);
    if (IN(1)) {
        { pg8::Gemm g{(const bf16*)(ws + WS_XB), (const bf16*)(ws + WS_W_IN), NTOK, NCOMBP, D, D, D}; pg8::StaticOrder S; S.init(NTOK, NCOMBP, c.G, bx);
          pg8::EpiBf16<0> E{(bf16*)(ws + WS_PROJ), NCOMBP, nullptr, 0, 0, 1.f}; pg8::gemm_phase<pg8::EpiBf16<0>, pg8::StaticOrder, true, true>(ring, g, S, E); }
        { pg8::Gemm g{(const bf16*)(ws + WS_MEMB), (const bf16*)(ws + WS_W_MKV), BATCH * NMEM, 1024, D, D, D}; pg8::StaticOrder S; S.init(BATCH * NMEM, 1024, c.G, bx);
          pg8::EpiBf16<0> E{(bf16*)(ws + WS_KVMEM), 1024, nullptr, 0, 0, 1.f}; pg8::gemm_phase<pg8::EpiBf16<0>, pg8::StaticOrder, true, true>(ring, g, S, E); }
    } SEAM(1);
    if (IN(2)) { ph_rowprep(args, c); } SEAM(2);
    if (IN(3)) {
        { pg8::Gemm g{(const bf16*)(ws + WS_CKVN), (const bf16*)(ws + WS_W_UKV), NTOK, 4096, 512, 512, 512}; pg8::StaticOrder S; S.init(NTOK, 4096, c.G, bx);
          pg8::EpiBf16<0> E{(bf16*)(ws + WS_KVUP), 4096, nullptr, 0, 0, 1.f}; pg8::gemm_phase<pg8::EpiBf16<0>, pg8::StaticOrder, true, true>(ring, g, S, E); }
        { const int kv = (bx >> 2) & 1; OneUnit S{bx & 3, 0, bx < 8};
          pg8::Gemm g{(const bf16*)(ws + (kv ? WS_CMPA_V : WS_CMPA_K)), (const bf16*)(ws + (kv ? WS_W_C1V : WS_W_C1K)), 1024, 256, 4096, 2048, 4096};
          pg8::EpiF32 E{(float*)(ws + WS_H1) + (size_t)kv * 1024 * 256, 256, nullptr}; pg8::gemm_phase<pg8::EpiF32, OneUnit, false, true>(ring, g, S, E); }
    } SEAM(3);
    if (IN(4)) { ph_cmp2(args, c); } SEAM(4);
    if (IN(5)) { ph_nsa_fa(args, c); } SEAM(5);
    if (IN(6)) { ph_mla_fa(args, c); } SEAM(6);
    if (IN(7)) {
        { pg8::Gemm g{(const bf16*)(ws + WS_ONSA), (const bf16*)(ws + WS_W_BN), NTOK, D, D, D, D}; pg8::StaticOrder S; S.init(NTOK, D, c.G, bx);
          pg8::EpiBf16<0> E{(bf16*)(ws + WS_YN), D, nullptr, 0, 0, 1.f}; pg8::gemm_phase<pg8::EpiBf16<0>, pg8::StaticOrder, true, true>(ring, g, S, E); }
        { pg8::Gemm g{(const bf16*)(ws + WS_OMLA), (const bf16*)(ws + WS_W_BM), NTOK, D, D, D, D}; pg8::StaticOrder S; S.init(NTOK, D, c.G, bx);
          pg8::EpiBf16<0> E{(bf16*)(ws + WS_YM), D, nullptr, 0, 0, 1.f}; pg8::gemm_phase<pg8::EpiBf16<0>, pg8::StaticOrder, true, true>(ring, g, S, E); }
    } SEAM(7);
    if (IN(8)) { ph_merge(args, c); } SEAM(8);
    if (IN(9)) { pg8::Gemm g{(const bf16*)(ws + WS_MERGED), (const bf16*)(ws + WS_W_MO), NTOK, D, D, D, D}; pg8::StaticOrder S; S.init(NTOK, D, c.G, bx);
        pg8::EpiF32 E{(float*)(ws + WS_Z), D, nullptr}; pg8::gemm_phase<pg8::EpiF32, pg8::StaticOrder, true, true>(ring, g, S, E); } SEAM(9);
    if (IN(10)) { ph_ln(c, args.in[I_X], (const float*)(ws + WS_Z), args.in[I_LN1G], args.in[I_LN1B], (float*)(ws + WS_X1), (bf16*)(ws + WS_X1B)); } SEAM(10);
    if (IN(11)) { pg8::Gemm g{(const bf16*)(ws + WS_X1B), (const bf16*)(ws + WS_W_MQ), NTOK, 512, D, D, D}; pg8::StaticOrder S; S.init(NTOK, 512, c.G, bx);
        pg8::EpiBf16<0> E{(bf16*)(ws + WS_QMEM), 512, nullptr, 0, 0, 1.f}; pg8::gemm_phase<pg8::EpiBf16<0>, pg8::StaticOrder, true, true>(ring, g, S, E); } SEAM(11);
    if (IN(12)) { ph_memattn(args, c); } SEAM(12);
    if (IN(13)) { pg8::Gemm g{(const bf16*)(ws + WS_OMEM), (const bf16*)(ws + WS_W_MO2), NTOK, D, 512, 512, 512}; pg8::StaticOrder S; S.init(NTOK, D, c.G, bx);
        pg8::EpiF32 E{(float*)(ws + WS_Z), D, nullptr}; pg8::gemm_phase<pg8::EpiF32, pg8::StaticOrder, true, true>(ring, g, S, E); } SEAM(13);
    if (IN(14)) { ph_ln(c, (const float*)(ws + WS_X1), (const float*)(ws + WS_Z), args.in[I_LN2G], args.in[I_LN2B], (float*)(ws + WS_X2), (bf16*)(ws + WS_X2B)); } SEAM(14);
    if (IN(15)) { pg8::Gemm g{(const bf16*)(ws + WS_X2B), (const bf16*)(ws + WS_W_PQ), NTOK, D, D, D, D}; pg8::StaticOrder S; S.init(NTOK, D, c.G, bx);
        pg8::EpiF32 E{(float*)(ws + WS_PQ), D, nullptr}; pg8::gemm_phase<pg8::EpiF32, pg8::StaticOrder, true, true>(ring, g, S, E); } SEAM(15);
    if (IN(16)) { ph_peer_select(args, c); } SEAM(16);
    if (IN(17)) { ph_peer_ffn(args, c); }
#undef IN
#undef SEAM
}

extern "C" void kernel_launch(void* const* d_in, const int* in_sizes, int n_in, void* d_out, int out_size, void* d_ws, size_t ws_size, hipStream_t stream) {
    static int grid = 0;
    if (grid == 0) {
        if (n_in != N_IN || in_sizes[0] != NTOK * D || out_size != NTOK * D || ws_size < WS_END) { fprintf(stderr, "kernel_launch: unexpected shapes (n_in %d, in0 %d, out %d, ws %zu)\n", n_in, n_in > 0 ? in_sizes[0] : -1, out_size, ws_size); grid = -1; return; }
        int dev = 0, cus = 0, per_cu = 0;
        if (hipGetDevice(&dev) != hipSuccess || hipDeviceGetAttribute(&cus, hipDeviceAttributeMultiprocessorCount, dev) != hipSuccess) { grid = -1; return; }
        if (hipFuncSetAttribute((const void*)fwd, hipFuncAttributeMaxDynamicSharedMemorySize, LDS_BYTES) != hipSuccess) { fprintf(stderr, "kernel_launch: hipFuncSetAttribute failed\n"); grid = -1; return; }
        if (hipOccupancyMaxActiveBlocksPerMultiprocessor(&per_cu, (const void*)fwd, NTHREADS, LDS_BYTES) != hipSuccess || per_cu < 1) fprintf(stderr, "kernel_launch: occupancy query reports %d\n", per_cu);
        (void)hipGetLastError();
        grid = cus;
    }
    if (grid < 0) return;
    (void)hipMemsetAsync((char*)d_ws + WS_CTL, 0, CTL_ZERO_BYTES, stream);
    Args a{};
    for (int i = 0; i < N_IN; ++i) a.in[i] = (const float*)d_in[i];
    a.out = (float*)d_out; a.ws = (unsigned char*)d_ws;
    if (N_LAUNCHES == 1) { a.ph_lo = 0; a.ph_hi = N_PHASES; hipLaunchKernelGGL(fwd, dim3(grid), dim3(NTHREADS), LDS_BYTES, stream, a); }
    else for (int p = 0; p < N_PHASES; ++p) { a.ph_lo = p; a.ph_hi = p + 1; hipLaunchKernelGGL(fwd, dim3(grid), dim3(NTHREADS), LDS_BYTES, stream, a); }
    const hipError_t le = hipPeekAtLastError();
    if (le != hipSuccess) fprintf(stderr, "kernel_launch: launch failed: %s\n", hipGetErrorName(le));
}
```

```cpp
#include <hip/hip_runtime.h>
#include <cstdio>
#include <cstdint>
#ifndef N_LAUNCHES
#define N_LAUNCHES 1
#endif
namespace pg8 {
#define PG8_LAS __attribute__((address_space(3)))
typedef unsigned short bf16_t;
typedef short bf16x8 __attribute__((ext_vector_type(8)));
typedef float f32x4 __attribute__((ext_vector_type(4)));
typedef unsigned u32x4 __attribute__((ext_vector_type(4)));
constexpr int BM = 256, BK = 64, HALF = 128, HTB = HALF * BK * 2  , STAGE_BYTES = 8 * HTB, NXCD = 8, WGM = 8;

__host__ __device__ __forceinline__ int lds_byte(int r, int c) { const int st = (r >> 4) * 2 + (c >> 5), rr = r & 15, cc = c & 31, ob = rr * 64 + cc * 2; return st * 1024 + (ob ^ (((ob >> 9) & 1) << 5)); }
__host__ __device__ __forceinline__ void stage_rc(int b, int& R, int& C) { const int st = b / 1024, sb = b % 1024, swz = sb ^ (((sb >> 9) & 1) << 5); R = (st >> 1) * 16 + swz / 64; C = (st & 1) * 32 + (swz % 64) / 2; }
__host__ __device__ __forceinline__ int perm32(int rho) { const int n = rho >> 4, i = rho & 15; return 8 * (i >> 2) + 4 * n + (i & 3); }

struct Unit { int pm, pn; };
struct Gemm { const bf16_t* A; const bf16_t* Bt; int M, N, K, lda, ldb; };

struct StaticOrder {
    int nM, nN, nwg, G, c;
    __host__ __device__ void init(int M, int N, int G_, int c_) { nM = M / BM; nN = N / BM; nwg = nM * nN; G = G_; c = c_; }
    __host__ __device__ bool next(int i, Unit& u) const {
        const long L = (long)i * G + c; if (L >= nwg) return false;
        int wgid = (int)L; { const int q = nwg / NXCD, r = nwg % NXCD, xcd = wgid % NXCD, off = wgid / NXCD; wgid = (xcd < r ? xcd * (q + 1) : r * (q + 1) + (xcd - r) * q) + off; }
        const int nig = WGM * nN, gid = wgid / nig, fm = gid * WGM, gsz = (nM - fm) < WGM ? (nM - fm) : WGM;
        u.pm = fm + ((wgid % nig) % gsz); u.pn = (wgid % nig) / gsz; return true;
    }
    __device__ __forceinline__ void a_ready(const Unit&) const {}
    __device__ __forceinline__ void done(const Unit&) const {}
};

__device__ __forceinline__ unsigned cvt_pk_bf16(float lo, float hi) { unsigned r; asm volatile("v_cvt_pk_bf16_f32 %0, %1, %2" : "=v"(r) : "v"(lo), "v"(hi)); return r; }
typedef float f32x2 __attribute__((ext_vector_type(2)));
__device__ __forceinline__ f32x2 gelu_pk(f32x2 v) {
    const f32x2 av = __builtin_elementwise_abs(v), d = av * 0.2316418882f + 1.0f;
    f32x2 t; t.x = __builtin_amdgcn_rcpf(d.x); t.y = __builtin_amdgcn_rcpf(d.y);
    f32x2 q = t * 0.5307027145f + (-0.7265760135f); q = q * t + 0.7107068705f; q = q * t + (-0.142248368f); q = q * t + 0.127414796f; q = q * t;
    const f32x2 s = (v * v) * (-0.72134752044f);
    f32x2 e; e.x = __builtin_amdgcn_exp2f(s.x); e.y = __builtin_amdgcn_exp2f(s.y);
    const f32x2 m = v * (q * e), r = v - m;
    f32x2 o; o.x = v.x < 0.f ? m.x : r.x; o.y = v.y < 0.f ? m.y : r.y; return o;
}

template <int ACT  > struct EpiBf16 {
    static constexpr bool PERM = true, AFTER_DRAIN = false; static_assert(ACT == 0 || ACT == 1, "EpiBf16: ACT is 0 (none) or 1 (gelu_pk)");
    bf16_t* O; int ldc; const float* bias; int split_cols; size_t split_stride; float scale0;
    __device__ __forceinline__ void operator()(const f32x4 (&acc)[2][2][4][2], const Unit& u, int wr, int wc, int fr, int fq) const {
        const int row0 = u.pm * BM + wr * 64 + fr; int colt = u.pn * BM; bf16_t* base = O;
        float sc = 1.f; if (split_cols) { const int t = colt / split_cols; base += (size_t)t * split_stride; colt -= t * split_cols; if (t == 0) sc = scale0; }
        const int col0 = colt + wc * 32 + 8 * fq, bcol0 = u.pn * BM + wc * 32 + 8 * fq;
        f32x4 bv[2][2];
#pragma unroll
        for (int bj = 0; bj < 2; ++bj)
#pragma unroll
            for (int n = 0; n < 2; ++n) bv[bj][n] = bias ? *(const f32x4*)(bias + bcol0 + bj * HALF + 4 * n) : (f32x4){0.f, 0.f, 0.f, 0.f};
#pragma unroll
        for (int ai = 0; ai < 2; ++ai)
#pragma unroll
            for (int m = 0; m < 4; ++m) { bf16_t* rowp = base + (size_t)(row0 + ai * HALF + m * 16) * ldc + col0;
#pragma unroll
                for (int bj = 0; bj < 2; ++bj) { f32x4 v0 = acc[ai][bj][m][0] + bv[bj][0], v1 = acc[ai][bj][m][1] + bv[bj][1];
                    if (ACT == 1) { f32x2 a = gelu_pk((f32x2){v0[0], v0[1]}), b = gelu_pk((f32x2){v0[2], v0[3]}), c = gelu_pk((f32x2){v1[0], v1[1]}), d = gelu_pk((f32x2){v1[2], v1[3]});
                        v0 = (f32x4){a.x, a.y, b.x, b.y}; v1 = (f32x4){c.x, c.y, d.x, d.y}; }
                    v0 = v0 * sc; v1 = v1 * sc; u32x4 w; w.x = cvt_pk_bf16(v0[0], v0[1]); w.y = cvt_pk_bf16(v0[2], v0[3]); w.z = cvt_pk_bf16(v1[0], v1[1]); w.w = cvt_pk_bf16(v1[2], v1[3]);
                    *(u32x4*)(rowp + bj * HALF) = w; } }
    }
};
struct EpiF32 {
    static constexpr bool PERM = false, AFTER_DRAIN = false;
    float* C; int ldc; const float* bias;
    __device__ __forceinline__ void operator()(const f32x4 (&acc)[2][2][4][2], const Unit& u, int wr, int wc, int fr, int fq) const {
        const int row0 = u.pm * BM + wr * 64 + fr, col0 = u.pn * BM + wc * 32 + 4 * fq;
        f32x4 bv[2][2];
#pragma unroll
        for (int bj = 0; bj < 2; ++bj)
#pragma unroll
            for (int n = 0; n < 2; ++n) bv[bj][n] = bias ? *(const f32x4*)(bias + col0 + bj * HALF + n * 16) : (f32x4){0.f, 0.f, 0.f, 0.f};
#pragma unroll
        for (int ai = 0; ai < 2; ++ai)
#pragma unroll
            for (int m = 0; m < 4; ++m) { float* rowp = C + (size_t)(row0 + ai * HALF + m * 16) * ldc + col0;
#pragma unroll
                for (int bj = 0; bj < 2; ++bj)
#pragma unroll
                    for (int n = 0; n < 2; ++n) *(f32x4*)(rowp + bj * HALF + n * 16) = acc[ai][bj][m][n] + bv[bj][n]; }
    }
};
template <class Epi, class Sched, bool ALIGN_EPI = false, bool SP2 = false>
__device__ __forceinline__ void gemm_phase(PG8_LAS unsigned char* lds, const Gemm g, const Sched& S, const Epi& E) {
    const int tid = threadIdx.x, wid = __builtin_amdgcn_readfirstlane(tid >> 6), lane = tid & 63, wr = wid >> 2, wc = wid & 3, fr = lane & 15, fq = lane >> 4;
    const int K = g.K, nt = K / BK;
    unsigned voffA[2], voffB[2];
#pragma unroll
    for (int i = 0; i < 2; ++i) { int R, C; stage_rc(tid * 16 + i * 8192, R, C); const int Rb = Epi::PERM ? ((R & ~31) + perm32(R & 31)) : R;
        voffA[i] = (unsigned)(R * g.lda + C) * 2u; voffB[i] = (unsigned)(Rb * g.ldb + C) * 2u; }
    const size_t kstep = (size_t)(BK * 2);
    const size_t hstepA = (size_t)HALF * g.lda * 2, hstepB = (size_t)HALF * g.ldb * 2;
    const size_t tstepA = 2 * hstepA, tstepB = 2 * hstepB;
    const unsigned ldsw = (unsigned)wid * 1024u;
    const int aoff = lds_byte(wr * 64 + fr, fq * 8), boff = lds_byte(wc * 32 + fr, fq * 8);
#define PG8_SA(b, h) (((b) * 2 + (h)) * HTB)
#define PG8_SB(b, h) ((4 + (b) * 2 + (h)) * HTB)
#define PG8_STAGE(bufoff, gbase, voff) do { _Pragma("unroll") for (int _i = 0; _i < 2; ++_i) \
        __builtin_amdgcn_global_load_lds((const unsigned*)((const char*)(gbase) + (voff)[_i]), (PG8_LAS unsigned*)(lds + (bufoff) + ldsw + _i * 8192), 16, 0, 0); } while (0)
#define PG8_LDA(dst, b, h) do { _Pragma("unroll") for (int m = 0; m < 4; ++m) _Pragma("unroll") for (int k = 0; k < 2; ++k) dst[m][k] = *(const PG8_LAS bf16x8*)(lds + PG8_SA(b, h) + aoff + m * 2048 + k * 1024); } while (0)
#define PG8_LDB(dst, b, h) do { _Pragma("unroll") for (int n = 0; n < 2; ++n) _Pragma("unroll") for (int k = 0; k < 2; ++k) dst[n][k] = *(const PG8_LAS bf16x8*)(lds + PG8_SB(b, h) + boff + n * 2048 + k * 1024); } while (0)
#define PG8_MMA(ai, bj, At, Bt) do { __builtin_amdgcn_s_setprio(1); _Pragma("unroll") for (int m = 0; m < 4; ++m) _Pragma("unroll") for (int n = 0; n < 2; ++n) _Pragma("unroll") for (int k = 0; k < 2; ++k) \
        acc[ai][bj][m][n] = __builtin_amdgcn_mfma_f32_16x16x32_bf16(Bt[n][k], At[m][k], acc[ai][bj][m][n], 0, 0, 0); __builtin_amdgcn_s_setprio(0); } while (0)
#define PG8_WAIT_V(n) asm volatile("s_waitcnt vmcnt(" #n ")" ::: "memory")
#define PG8_WAIT_L(n) asm volatile("s_waitcnt lgkmcnt(" #n ")" ::: "memory")
#define PG8_BAR __builtin_amdgcn_s_barrier()
#define PG8_SCHED __builtin_amdgcn_sched_barrier(0)
    Unit cur, nxt; int ui = 0;
    if (!S.next(0, cur)) return;
    f32x4 acc[2][2][4][2];
#pragma unroll
    for (int a = 0; a < 2; ++a)
#pragma unroll
        for (int b = 0; b < 2; ++b)
#pragma unroll
            for (int m = 0; m < 4; ++m)
#pragma unroll
                for (int n = 0; n < 2; ++n) acc[a][b][m][n] = (f32x4){0.f, 0.f, 0.f, 0.f};
    bf16x8 At[4][2], B0[2][2], B1[2][2];
    const char* cA = (const char*)g.A + (size_t)cur.pm * tstepA; const char* cB = (const char*)g.Bt + (size_t)cur.pn * tstepB;
    S.a_ready(cur);
    if constexpr (SP2) {
        PG8_STAGE(PG8_SB(0, 0), cB, voffB); PG8_STAGE(PG8_SB(0, 1), cB + hstepB, voffB); PG8_STAGE(PG8_SA(0, 0), cA, voffA); PG8_STAGE(PG8_SA(0, 1), cA + hstepA, voffA);
        if (wr == 1) PG8_BAR;
        PG8_WAIT_V(2); PG8_BAR;
        PG8_STAGE(PG8_SB(1, 0), cB + kstep, voffB); PG8_STAGE(PG8_SA(1, 0), cA + kstep, voffA); PG8_STAGE(PG8_SB(1, 1), cB + hstepB + kstep, voffB);
        PG8_WAIT_V(6); PG8_BAR;
    } else {
        PG8_STAGE(PG8_SB(0, 0), cB, voffB); PG8_STAGE(PG8_SA(0, 0), cA, voffA); PG8_STAGE(PG8_SB(0, 1), cB + hstepB, voffB); PG8_STAGE(PG8_SA(0, 1), cA + hstepA, voffA);
        if (wr == 1) PG8_BAR;
        PG8_WAIT_V(4); PG8_BAR;
        PG8_STAGE(PG8_SB(1, 0), cB + kstep, voffB); PG8_STAGE(PG8_SA(1, 0), cA + kstep, voffA); PG8_STAGE(PG8_SB(1, 1), cB + hstepB + kstep, voffB);
        PG8_WAIT_V(6); PG8_BAR;
    }
    for (;;) {
        const bool has_next = S.next(ui + 1, nxt);
        const char* nA = has_next ? (const char*)g.A + (size_t)nxt.pm * tstepA : cA; const char* nB = has_next ? (const char*)g.Bt + (size_t)nxt.pn * tstepB : cB;
        for (int t = 0; t < nt; t += 2) {
            const bool last = (t == nt - 2);
            const char* a1 = cA + (size_t)(t + 1) * kstep;
            const char* a2 = last ? nA : cA + (size_t)(t + 2) * kstep; const char* b2 = last ? nB : cB + (size_t)(t + 2) * kstep;
            const char* a3 = a2 + kstep; const char* b3 = b2 + kstep;
            if (last && has_next) S.a_ready(nxt);
            if constexpr (SP2) {
            PG8_LDB(B0, 0, 0); PG8_LDB(B1, 0, 1); PG8_SCHED; PG8_LDA(At, 0, 0); PG8_STAGE(PG8_SA(1, 1), a1 + hstepA, voffA);
            PG8_WAIT_V(8); PG8_WAIT_L(0); PG8_BAR; PG8_MMA(0, 0, At, B0); PG8_MMA(0, 1, At, B1); PG8_BAR; PG8_SCHED;
            PG8_LDA(At, 0, 1); PG8_STAGE(PG8_SB(0, 0), b2, voffB); PG8_STAGE(PG8_SB(0, 1), b2 + hstepB, voffB); PG8_STAGE(PG8_SA(0, 0), a2, voffA);
            PG8_WAIT_V(8); PG8_WAIT_L(0); PG8_BAR; PG8_MMA(1, 0, At, B0); PG8_MMA(1, 1, At, B1); PG8_BAR; PG8_SCHED;
            PG8_LDB(B0, 1, 0); PG8_LDB(B1, 1, 1); PG8_SCHED; PG8_LDA(At, 1, 0); PG8_STAGE(PG8_SA(0, 1), a2 + hstepA, voffA);
            PG8_WAIT_V(8); PG8_WAIT_L(0); PG8_BAR; PG8_MMA(0, 0, At, B0); PG8_MMA(0, 1, At, B1); PG8_BAR; PG8_SCHED;
            PG8_LDA(At, 1, 1); PG8_STAGE(PG8_SB(1, 0), b3, voffB); PG8_STAGE(PG8_SB(1, 1), b3 + hstepB, voffB); PG8_STAGE(PG8_SA(1, 0), a3, voffA);
            PG8_WAIT_V(8); PG8_WAIT_L(0); PG8_BAR; PG8_MMA(1, 0, At, B0); PG8_MMA(1, 1, At, B1); PG8_BAR; PG8_SCHED;
            } else {
            PG8_LDB(B0, 0, 0); PG8_SCHED; PG8_LDA(At, 0, 0); PG8_STAGE(PG8_SA(1, 1), a1 + hstepA, voffA);
            PG8_WAIT_L(8); PG8_BAR; PG8_WAIT_L(0); PG8_MMA(0, 0, At, B0); PG8_BAR; PG8_SCHED;
            PG8_LDB(B1, 0, 1); PG8_STAGE(PG8_SB(0, 0), b2, voffB);
            PG8_BAR; PG8_WAIT_L(0); PG8_MMA(0, 1, At, B1); PG8_BAR;
            PG8_LDA(At, 0, 1); PG8_STAGE(PG8_SA(0, 0), a2, voffA);
            PG8_BAR; PG8_WAIT_L(0); PG8_MMA(1, 0, At, B0); PG8_BAR; PG8_SCHED;
            PG8_STAGE(PG8_SB(0, 1), b2 + hstepB, voffB);
            PG8_WAIT_V(6); PG8_BAR; PG8_MMA(1, 1, At, B1); PG8_BAR;
            PG8_LDB(B0, 1, 0); PG8_SCHED; PG8_LDA(At, 1, 0); PG8_STAGE(PG8_SA(0, 1), a2 + hstepA, voffA);
            PG8_WAIT_L(8); PG8_BAR; PG8_WAIT_L(0); PG8_MMA(0, 0, At, B0); PG8_BAR; PG8_SCHED;
            PG8_LDB(B1, 1, 1); PG8_STAGE(PG8_SB(1, 0), b3, voffB);
            PG8_BAR; PG8_WAIT_L(0); PG8_MMA(0, 1, At, B1); PG8_BAR;
            PG8_LDA(At, 1, 1); PG8_STAGE(PG8_SA(1, 0), a3, voffA);
            PG8_BAR; PG8_WAIT_L(0); PG8_MMA(1, 0, At, B0); PG8_BAR; PG8_SCHED;
            PG8_STAGE(PG8_SB(1, 1), b3 + hstepB, voffB);
            PG8_WAIT_V(6); PG8_BAR; PG8_MMA(1, 1, At, B1); PG8_BAR;
            }
        }
        if constexpr (ALIGN_EPI) { if (wr == 0) PG8_BAR; }
        if constexpr (!Epi::AFTER_DRAIN) { E(acc, cur, wr, wc, fr, fq); S.done(cur); }
        if (!has_next) break;
#pragma unroll
        for (int a = 0; a < 2; ++a)
#pragma unroll
            for (int b = 0; b < 2; ++b)
#pragma unroll
                for (int m = 0; m < 4; ++m)
#pragma unroll
                    for (int n = 0; n < 2; ++n) acc[a][b][m][n] = (f32x4){0.f, 0.f, 0.f, 0.f};
        cur = nxt; cA = nA; cB = nB; ++ui;
        if constexpr (ALIGN_EPI) { if (wr == 1) PG8_BAR; }
    }
    PG8_WAIT_V(0);
    if constexpr (!ALIGN_EPI) { if (wr == 0) PG8_BAR; }
    PG8_BAR;
    if constexpr (Epi::AFTER_DRAIN) { E.fused(acc, cur, wr, wc, fr, fq, lds, wid, lane); S.done(cur); }
#undef PG8_SA
#undef PG8_SB
#undef PG8_STAGE
#undef PG8_LDA
#undef PG8_LDB
#undef PG8_MMA
#undef PG8_WAIT_V
#undef PG8_WAIT_L
#undef PG8_BAR
#undef PG8_SCHED
}
}

constexpr int BATCH = 2, T = 4096, D = 2048, NTOK = BATCH * T, NMEM = 256;
constexpr int NCOMB = 11376, NCOMBP = 11520;
constexpr int OFF_NSA_KV = 2048, OFF_NSA_GATE = 3584, OFF_MLA_Q = 3632, OFF_MLA_KV = 6704, OFF_MERGE = 7280;
constexpr float ALPHA = 1.189207115002721f;
constexpr float NSA_SCALE = 0.08838834764831845f, MLA_SCALE = 0.07216878364870323f, MEM_SCALE = 0.08838834764831845f;
enum { I_X = 0, I_MEM, I_RELB, I_WIN, I_CKPE, I_CKW1, I_CKW2, I_CVPE, I_CVW1, I_CVW2, I_KVNORM, I_WUK, I_WUV, I_WBN, I_WBM, I_WMO, I_LN1G, I_LN1B,
       I_MWQ, I_MWK, I_MWV, I_MWO, I_LN2G, I_LN2B, I_PWQ, I_PKEYS, I_PU, I_PV, I_LN3G, I_LN3B, N_IN };

constexpr size_t MiB = 1u << 20;
constexpr size_t WS_CTL = 0, CTL_ZERO_BYTES = 1 * MiB;
constexpr size_t WS_W_IN = 1 * MiB, WS_W_UKV = 46 * MiB, WS_W_BN = 50 * MiB, WS_W_BM = 58 * MiB, WS_W_MO = 66 * MiB, WS_W_MQ = 74 * MiB, WS_W_MKV = 76 * MiB, WS_W_MO2 = 80 * MiB,
                 WS_W_PQ = 82 * MiB, WS_W_C1K = 90 * MiB, WS_W_C1V = 92 * MiB;
constexpr size_t WS_CVEC = 94 * MiB, WS_KCVC = 95 * MiB, WS_H1 = 96 * MiB, WS_SEL = 98 * MiB, WS_KVMEM = 99 * MiB, WS_MEMB = 100 * MiB, WS_KPE = 102 * MiB;
constexpr size_t WS_PROJ = 106 * MiB;
constexpr size_t WS_X1 = 106 * MiB, WS_X2 = 170 * MiB, WS_X1B = 234 * MiB, WS_QMEM = 266 * MiB, WS_OMEM = 274 * MiB;
constexpr size_t WS_KVUP = 286 * MiB, WS_Z = 286 * MiB;
constexpr size_t WS_XB = 350 * MiB, WS_ONSA = 350 * MiB, WS_X2B = 350 * MiB;
constexpr size_t WS_OMLA = 382 * MiB, WS_PQ = 382 * MiB;
constexpr size_t WS_CKVN = 414 * MiB, WS_CMPA_K = 422 * MiB, WS_CMPA_V = 422 * MiB + 4 * MiB + 65536, WS_YN = 414 * MiB;
constexpr size_t WS_YM = 446 * MiB, WS_PIDX = 446 * MiB, WS_PGATE = 450 * MiB;
constexpr size_t WS_MERGED = 478 * MiB, WS_END = 512 * MiB;
constexpr size_t WS_S = 106 * MiB, WS_KEYB = 103 * MiB, WS_PQB = 382 * MiB;
constexpr int CW_BAR = 4096;

constexpr int RING_BYTES = 131072, LDSCTL_OFF = RING_BYTES, MISC_OFF = LDSCTL_OFF + 320, LDS_BYTES = 147456;
constexpr int NWAVES = 8, NTHREADS = 512;

#define LAS __attribute__((address_space(3)))
typedef unsigned short bf16;
typedef unsigned v4u __attribute__((ext_vector_type(4)));
typedef float f32x4 __attribute__((ext_vector_type(4)));
#define LDS_WAIT() asm volatile("s_waitcnt lgkmcnt(0)" ::: "memory")

__device__ __forceinline__ unsigned f2bf(float f) { unsigned u = __builtin_bit_cast(unsigned, f); return (u + 0x7fffu + ((u >> 16) & 1u)) >> 16; }
__device__ __forceinline__ unsigned pk2(float lo, float hi) { return f2bf(lo) | (f2bf(hi) << 16); }
__device__ __forceinline__ float bf2f(bf16 h) { return __builtin_bit_cast(float, (unsigned)h << 16); }
__device__ __forceinline__ float lo_bf(unsigned w) { return __builtin_bit_cast(float, w << 16); }
__device__ __forceinline__ float hi_bf(unsigned w) { return __builtin_bit_cast(float, w & 0xffff0000u); }
__device__ __forceinline__ float wave_sum(float v) {
#pragma unroll
    for (int o = 1; o < 64; o <<= 1) v += __shfl_xor(v, o);
    return v;
}
__device__ __forceinline__ float wave_max(float v) {
#pragma unroll
    for (int o = 1; o < 64; o <<= 1) v = fmaxf(v, __shfl_xor(v, o));
    return v;
}
__device__ __forceinline__ int wave_min_i(int v) {
#pragma unroll
    for (int o = 1; o < 64; o <<= 1) { const int w = __shfl_xor(v, o); v = w < v ? w : v; }
    return v;
}
__device__ __forceinline__ float sigmoidf_(float x) { return 1.f / (1.f + expf(-x)); }
__device__ __forceinline__ float gelu_tanh(float x) { return 0.5f * x * (1.f + tanhf(0.7978845608028654f * (x + 0.044715f * x * x * x))); }
__device__ __forceinline__ int t5_bucket(int dist) {
    if (dist < 16) return dist;
    const int b = 8 + (31 - __clz(dist * dist));
    return b < 31 ? b : 31;
}

#define XB_TMO      128
#define XB_XCNT(j)  (256  + 64 * (j))
#define XB_XSUB(j)  (1280 + 64 * (j))
#define XB_XGEN(j)  (2304 + 64 * (j))
#define XB_TOP      3328
#define XB_TOPGEN   3392
#define XCD_BAR_WORDS 3456
#define XB_SPIN_CAP (1u << 18)

__device__ __forceinline__ unsigned xb_ld(unsigned* p)              { return __hip_atomic_load(p, __ATOMIC_RELAXED, __HIP_MEMORY_SCOPE_AGENT); }
__device__ __forceinline__ unsigned xb_add(unsigned* p, unsigned v) { return __hip_atomic_fetch_add(p, v, __ATOMIC_RELAXED, __HIP_MEMORY_SCOPE_AGENT); }
__device__ __forceinline__ unsigned xb_xcc_id() { return (unsigned)__builtin_amdgcn_s_getreg((3 << 11) | 20) & 0xFu; }
#define XB_SPIN(cond, bar) do { unsigned _sp = 0; while (cond) { __builtin_amdgcn_s_sleep(1); \
    if ((++_sp & 255u) == 0u) { if (xb_ld(&(bar)[XB_TMO])) break; if (_sp > XB_SPIN_CAP) { atomicAdd(&(bar)[XB_TMO], 1u); break; } } } } while (0)

struct XcdBarrier {
    unsigned* bar; unsigned x;
    volatile LAS unsigned* st;
};

__device__ __forceinline__ XcdBarrier xcd_barrier_post(unsigned* bar, volatile LAS unsigned* st) {
    XcdBarrier b; b.bar = bar; b.x = xb_xcc_id(); b.st = st;
    if (threadIdx.x == 0) (void)xb_add(&bar[XB_XCNT(b.x)], 1u);
    return b;
}
__device__ __forceinline__ void xcd_barrier_complete(unsigned* bar, unsigned x, unsigned& nloc, unsigned& nx) {
    const unsigned G = gridDim.x * gridDim.y * gridDim.z;
    unsigned sum, cnt, mine, sp = 0u;
    for (;;) {
        sum = 0u; cnt = 0u; mine = 0u;
#pragma unroll
        for (unsigned j = 0; j < 16; ++j) { const unsigned c = xb_ld(&bar[XB_XCNT(j)]); sum += c; cnt += (c > 0u) ? 1u : 0u; mine = (j == x) ? c : mine; }
        if (sum == G) break;
        __builtin_amdgcn_s_sleep(1);
        if ((++sp & 255u) == 0u) { if (xb_ld(&bar[XB_TMO])) break; if (sp > XB_SPIN_CAP) { atomicAdd(&bar[XB_TMO], 1u); break; } }
    }
    nloc = mine > 0u ? mine : 1u; nx = cnt > 0u ? cnt : 1u;
}

__device__ __forceinline__ void xcd_barrier(const XcdBarrier& b) {
    asm volatile("s_waitcnt vmcnt(0)" ::: "memory");
    __syncthreads();
    if (threadIdx.x == 0) {
        unsigned* bar = b.bar;
        __builtin_amdgcn_s_waitcnt(0);
        unsigned nloc = b.st[0], nx = b.st[1];
        if (nloc == 0u) { xcd_barrier_complete(bar, b.x, nloc, nx); b.st[0] = nloc; b.st[1] = nx; }
        const unsigned old = xb_add(&bar[XB_XSUB(b.x)], 1u);
        const unsigned gen = old / nloc;
        if (old + 1u == (gen + 1u) * nloc) {
            __builtin_amdgcn_fence(__ATOMIC_RELEASE, "agent");
            asm volatile("s_waitcnt vmcnt(0)" ::: "memory");
            const unsigned og = xb_add(&bar[XB_TOP], 1u);
            const unsigned tg = og / nx;
            if (og + 1u == (tg + 1u) * nx) xb_add(&bar[XB_TOPGEN], 1u);
            else XB_SPIN(xb_ld(&bar[XB_TOPGEN]) == tg, bar);
            __builtin_amdgcn_fence(__ATOMIC_ACQUIRE, "agent");
            xb_add(&bar[XB_XGEN(b.x)], 1u);
            asm volatile("s_waitcnt vmcnt(0)" ::: "memory");
        } else {
            XB_SPIN(xb_ld(&bar[XB_XGEN(b.x)]) == gen, bar);
            __builtin_amdgcn_fence(__ATOMIC_ACQUIRE, "agent");
            asm volatile("s_waitcnt vmcnt(0)" ::: "memory");
        }
    }
    __syncthreads();
}

struct Args { const float* in[N_IN]; float* out; unsigned char* ws; int ph_lo, ph_hi; };
struct Ctx { LAS unsigned char* lds; int tid, lane, wave, gw, ngw, G; };


namespace fa {
typedef short bf16x8 __attribute__((ext_vector_type(8)));
typedef short s16x4 __attribute__((ext_vector_type(4)));
typedef float f32x16 __attribute__((ext_vector_type(16)));
#define FA_SBAR() __builtin_amdgcn_sched_barrier(0)
#define FA_VMW() asm volatile("s_waitcnt vmcnt(0)" ::: "memory")
constexpr int SHM_V = 16384, OFF_V = 0, OFF_K = 2 * SHM_V, OFF_AL = OFF_K + 2 * 24576, OFF_IMP = OFF_AL + 2048, OFF_SEL = OFF_IMP + 8448, LDS_END = OFF_SEL + 256;
static_assert(LDS_END <= RING_BYTES, "attention LDS map");
constexpr float LOG2E = 1.4426950408889634f, THR = 8.f;

__device__ __forceinline__ int v_st(int k, int c) { const int kk = (k & ~0xC) | ((k & 4) << 1) | ((k & 8) >> 1); return ((kk >> 3) * 4 + (c >> 5)) * 512 + ((kk & 7) * 32 + (c & 31)) * 2; }
__device__ __forceinline__ int v_rd_base(int lane) { return ((lane & 3) << 3) | (((lane >> 2) & 3) << 6) | (((lane >> 4) & 1) << 5) | (((lane >> 5) & 1) << 8); }
constexpr int v_rd_off(int d0, int ks, int half) { return d0 * 512 + ks * 4096 + half * 2048; }
__device__ __forceinline__ int crow(int r, int hi) { return (r & 3) + 8 * (r >> 2) + 4 * hi; }
__device__ __forceinline__ unsigned cvtpk(float lo, float hi) { unsigned r; asm volatile("v_cvt_pk_bf16_f32 %0, %1, %2" : "=v"(r) : "v"(lo), "v"(hi)); return r; }

template <int DQK> struct Geo {
    static constexpr int CPR = DQK / 8, ROWB = DQK * 2, SHM_K = 64 * ROWB, NPASS = SHM_K / 8192, NKS = DQK / 16;
    __device__ static __forceinline__ int swz(int row) { return DQK == 128 ? (row & 7) : ((row >> 1) & 7); }
    __device__ static __forceinline__ int off(int row, int chunk) { return row * ROWB + ((chunk ^ swz(row)) << 4); }
};

__device__ __forceinline__ void mask_tile(f32x16& p0, f32x16& p1, int dq, unsigned W) {
    const float NEG = -__builtin_inff();
#pragma unroll
    for (int r = 0; r < 16; ++r) { const int c = (r & 3) + 8 * (r >> 2);
        if ((unsigned)(dq - c) >= W) p0[r] = NEG;
        if ((unsigned)(dq - c - 32) >= W) p1[r] = NEG; }
}
__device__ __forceinline__ float half_max(float v) { auto rr = __builtin_amdgcn_permlane32_swap(__float_as_uint(v), __float_as_uint(v), false, false); return fmaxf(__uint_as_float(rr[0]), __uint_as_float(rr[1])); }
__device__ __forceinline__ float half_sum(float v) { auto rr = __builtin_amdgcn_permlane32_swap(__float_as_uint(v), __float_as_uint(v), false, false); return __uint_as_float(rr[0]) + __uint_as_float(rr[1]); }
__device__ __forceinline__ float row_max32(const f32x16& p0, const f32x16& p1) {
    float pmax = p0[0];
#pragma unroll
    for (int r = 1; r < 16; ++r) pmax = fmaxf(pmax, p0[r]);
#pragma unroll
    for (int r = 0; r < 16; ++r) pmax = fmaxf(pmax, p1[r]);
    return half_max(pmax);
}
__device__ __forceinline__ void partialSM(f32x16& p0, f32x16& p1, float& m_reg, float& mn, float& alpha) {
    const float pmax = row_max32(p0, p1);
    if (__builtin_expect(__all((pmax - m_reg) <= THR), 1)) { mn = m_reg; alpha = 1.f; }
    else { mn = fmaxf(m_reg, pmax); alpha = __builtin_amdgcn_exp2f((m_reg - mn) * LOG2E); m_reg = mn; }
    const float mnL = -mn * LOG2E;
#pragma unroll
    for (int r = 0; r < 16; ++r) p0[r] = fmaf(p0[r], LOG2E, mnL);
#pragma unroll
    for (int r = 0; r < 16; ++r) p1[r] = fmaf(p1[r], LOG2E, mnL);
#pragma unroll
    for (int r = 0; r < 16; ++r) p0[r] = __builtin_amdgcn_exp2f(p0[r]);
}
#define FA_PK4(P, B_, OUT) do { unsigned a0 = cvtpk(P[B_+0], P[B_+1]), a1 = cvtpk(P[B_+2], P[B_+3]);                          \
        unsigned b0 = cvtpk(P[B_+4], P[B_+5]), b1 = cvtpk(P[B_+6], P[B_+7]);                                             \
        auto r0 = __builtin_amdgcn_permlane32_swap(a0, b0, false, false); auto r1 = __builtin_amdgcn_permlane32_swap(a1, b1, false, false); \
        v4u w = {r0[0], r1[0], r0[1], r1[1]}; OUT = __builtin_bit_cast(bf16x8, w); } while (0)
__device__ __forceinline__ void finishSM(f32x16& p0, f32x16& p1, float alpha, float& l_reg, bf16x8& pa0, bf16x8& pa1, bf16x8& pa2, bf16x8& pa3) {
#pragma unroll
    for (int r = 0; r < 16; ++r) p1[r] = __builtin_amdgcn_exp2f(p1[r]);
    float ps = 0;
#pragma unroll
    for (int r = 0; r < 16; ++r) ps += p0[r];
#pragma unroll
    for (int r = 0; r < 16; ++r) ps += p1[r];
    ps = half_sum(ps);
    l_reg = l_reg * alpha + ps;
    FA_PK4(p0, 0, pa0); FA_PK4(p0, 8, pa1); FA_PK4(p1, 0, pa2); FA_PK4(p1, 8, pa3);
}
template <int DQK, int KB>
__device__ __forceinline__ void qkt(f32x16& p0, f32x16& p1, LAS const char* lds, int r32, int hi, const bf16x8 (&qr)[DQK / 16]) {
    using G = Geo<DQK>;
    p0 = f32x16{}; p1 = f32x16{};
    LAS const char* kb[4];
#pragma unroll
    for (int dd = 0; dd < 4; ++dd) kb[dd] = lds + OFF_K + KB * G::SHM_K + r32 * G::ROWB + (((2 * dd + hi) ^ G::swz(r32)) << 4);
    bf16x8 b0 = *(LAS const bf16x8*)kb[0], b1 = *(LAS const bf16x8*)(kb[0] + 32 * G::ROWB);
#pragma unroll
    for (int d0 = 0; d0 < G::NKS; ++d0) { bf16x8 n0 = b0, n1 = b1;
        if (d0 + 1 < G::NKS) { LAS const char* a = kb[(d0 + 1) & 3] + ((d0 + 1) >> 2) * 128; n0 = *(LAS const bf16x8*)a; n1 = *(LAS const bf16x8*)(a + 32 * G::ROWB); }
        p0 = __builtin_amdgcn_mfma_f32_32x32x16_bf16(b0, qr[d0], p0, 0, 0, 0);
        p1 = __builtin_amdgcn_mfma_f32_32x32x16_bf16(b1, qr[d0], p1, 0, 0, 0);
        FA_SBAR(); b0 = n0; b1 = n1; }
}
template <int VB>
__device__ __forceinline__ void pv_tile(f32x16 (&o)[4], int vb0, bf16x8 pa0, bf16x8 pa1, bf16x8 pa2, bf16x8 pa3) {
#define FA_TRRD(dst, off) asm volatile("ds_read_b64_tr_b16 %0, %1 offset:%2" : "=&v"(dst) : "v"(vb0), "i"(off) : "memory")
#define FA_PV_D0(d0) do { s16x4 l0, l1, l2, l3, h0, h1, h2, h3; constexpr int b_ = OFF_V + VB * SHM_V + v_rd_off(d0, 0, 0); \
        FA_TRRD(l0, b_); FA_TRRD(h0, b_ + 2048); FA_TRRD(l1, b_ + 4096); FA_TRRD(h1, b_ + 6144); FA_TRRD(l2, b_ + 8192); FA_TRRD(h2, b_ + 10240); FA_TRRD(l3, b_ + 12288); FA_TRRD(h3, b_ + 14336); \
        asm volatile("s_waitcnt lgkmcnt(0)" ::: "memory"); FA_SBAR(); \
        o[d0] = __builtin_amdgcn_mfma_f32_32x32x16_bf16(pa0, (bf16x8){l0[0], l0[1], l0[2], l0[3], h0[0], h0[1], h0[2], h0[3]}, o[d0], 0, 0, 0);   \
        o[d0] = __builtin_amdgcn_mfma_f32_32x32x16_bf16(pa1, (bf16x8){l1[0], l1[1], l1[2], l1[3], h1[0], h1[1], h1[2], h1[3]}, o[d0], 0, 0, 0);   \
        o[d0] = __builtin_amdgcn_mfma_f32_32x32x16_bf16(pa2, (bf16x8){l2[0], l2[1], l2[2], l2[3], h2[0], h2[1], h2[2], h2[3]}, o[d0], 0, 0, 0);   \
        o[d0] = __builtin_amdgcn_mfma_f32_32x32x16_bf16(pa3, (bf16x8){l3[0], l3[1], l3[2], l3[3], h3[0], h3[1], h3[2], h3[3]}, o[d0], 0, 0, 0); } while (0)
    FA_PV_D0(0); FA_PV_D0(1); FA_PV_D0(2); FA_PV_D0(3);
#undef FA_PV_D0
#undef FA_TRRD
}

template <int DQK, int MODE, class Pol>
__device__ __forceinline__ void attend(const Pol& P, LAS char* lds, const bf16x8 (&qr)[DQK / 16], unsigned long long tiles, f32x16 (&o)[4], float& m_reg, float& l_reg, const float il_fin, int tid, int wid, int lane) {
    using G = Geo<DQK>;
    if (tiles == 0ull) return;
    asm volatile("" : "+v"(tid), "+v"(lane));
    const int r32 = lane & 31, hi = lane >> 5;
    int koff[G::NPASS];
#pragma unroll
    for (int p = 0; p < G::NPASS; ++p) { const int L = tid + 512 * p; koff[p] = G::off(L / G::CPR, L % G::CPR); }
    const int sr = tid >> 4, sc = (tid & 15) * 8, vst0 = v_st(sr, sc), vst1 = v_st(32 + sr, sc);
    const int vb0 = (int)(unsigned)(uintptr_t)(lds) + v_rd_base(lane);
    LAS float* al_l = (LAS float*)(lds + OFF_AL) + wid * 64 + 32;
    bf16x8 sk[G::NPASS], sv0, sv1;
#define FA_ISSUE(j) do { _Pragma("unroll") for (int p_ = 0; p_ < G::NPASS; ++p_) sk[p_] = *(const bf16x8*)P.kptr(p_, (j)); \
        if (MODE != 1) { sv0 = *(const bf16x8*)P.vptr(0, (j)); sv1 = *(const bf16x8*)P.vptr(1, (j)); } } while (0)
#define FA_WRITE(bf) do { _Pragma("unroll") for (int p_ = 0; p_ < G::NPASS; ++p_) *(LAS bf16x8*)(lds + OFF_K + (bf) * G::SHM_K + koff[p_]) = sk[p_]; \
        if (MODE != 1) { *(LAS bf16x8*)(lds + OFF_V + (bf) * SHM_V + vst0) = sv0; *(LAS bf16x8*)(lds + OFF_V + (bf) * SHM_V + vst1) = sv1; } } while (0)
    int j = __builtin_ctzll(tiles); tiles &= tiles - 1;
    FA_ISSUE(j); FA_VMW(); FA_WRITE(0); __syncthreads();
#define FA_STEP(BF) do { \
        const int jn = tiles ? __builtin_ctzll(tiles) : -1; tiles &= tiles - 1; \
        if (jn >= 0) FA_ISSUE(jn); \
        FA_SBAR(); \
        if (P.act(j)) { f32x16 p0, p1; bf16x8 pa0, pa1, pa2, pa3; \
            qkt<DQK, BF>(p0, p1, lds, r32, hi, qr); \
            P.mod(p0, p1, j); \
            if (MODE == 0) { float mn, alpha; partialSM(p0, p1, m_reg, mn, alpha); \
                if (__any(alpha < 1.f)) { if (hi == 0) al_l[r32] = alpha; LDS_WAIT(); \
                    _Pragma("unroll") for (int d_ = 0; d_ < 4; ++d_) _Pragma("unroll") for (int r = 0; r < 16; ++r) o[d_][r] *= al_l[crow(r, hi)]; } \
                finishSM(p0, p1, alpha, l_reg, pa0, pa1, pa2, pa3); FA_SBAR(); \
                pv_tile<BF>(o, vb0, pa0, pa1, pa2, pa3); } \
            else if (MODE == 1) { const float pmax = row_max32(p0, p1), mn = fmaxf(m_reg, pmax), mnL = -mn * LOG2E; float ps = 0.f; \
                _Pragma("unroll") for (int r = 0; r < 16; ++r) ps += __builtin_amdgcn_exp2f(fmaf(p0[r], LOG2E, mnL)) + __builtin_amdgcn_exp2f(fmaf(p1[r], LOG2E, mnL)); \
                l_reg = l_reg * __builtin_amdgcn_exp2f((m_reg - mn) * LOG2E) + half_sum(ps); m_reg = mn; } \
            else { const float mnL = -m_reg * LOG2E; \
                _Pragma("unroll") for (int r = 0; r < 16; ++r) { p0[r] = __builtin_amdgcn_exp2f(fmaf(p0[r], LOG2E, mnL)) * il_fin; p1[r] = __builtin_amdgcn_exp2f(fmaf(p1[r], LOG2E, mnL)) * il_fin; } \
                P.post(p0, p1, j); \
                FA_PK4(p0, 0, pa0); FA_PK4(p0, 8, pa1); FA_PK4(p1, 0, pa2); FA_PK4(p1, 8, pa3); FA_SBAR(); \
                pv_tile<BF>(o, vb0, pa0, pa1, pa2, pa3); } } \
        FA_SBAR(); \
        if (jn >= 0) { FA_VMW(); FA_WRITE((BF) ^ 1); } \
        __syncthreads(); j = jn; } while (0)
    for (;;) { FA_STEP(0); if (j < 0) break; FA_STEP(1); if (j < 0) break; }
#undef FA_STEP
#undef FA_ISSUE
#undef FA_WRITE
}

__device__ __forceinline__ void scale_rows(f32x16 (&o)[4], float fac, LAS char* lds, int wid, int r32, int hi) {
    LAS float* li_l = (LAS float*)(lds + OFF_AL) + wid * 64;
    if (hi == 0) li_l[r32] = fac;
    LDS_WAIT();
#pragma unroll
    for (int r = 0; r < 16; ++r) { const float f = li_l[crow(r, hi)];
#pragma unroll
        for (int d0 = 0; d0 < 4; ++d0) o[d0][r] *= f; }
    LDS_WAIT();
}
__device__ __forceinline__ void store_bf16(const f32x16 (&o)[4], bf16* O, size_t ldo, int r32, int hi) {
#pragma unroll
    for (int r = 0; r < 16; ++r) { const int orow = crow(r, hi);
#pragma unroll
        for (int d0 = 0; d0 < 4; ++d0) { const float v = o[d0][r]; const float vn = __shfl_xor(v, 1);
            if ((r32 & 1) == 0) *(unsigned*)(O + (size_t)orow * ldo + d0 * 32 + r32) = cvtpk(v, vn); } }
}
}

struct MlaPol {
    const bf16* kp[3]; long kst[3]; const bf16* vp[2]; int qlo, qm;
    __device__ __forceinline__ const bf16* kptr(int p, int j) const { return kp[p] + (long)j * kst[p]; }
    __device__ __forceinline__ const bf16* vptr(int i, int j) const { return vp[i] + (long)j * (64 * 4096); }
    __device__ __forceinline__ bool act(int j) const { return 64 * j <= qlo + 31; }
    __device__ __forceinline__ void mod(fa::f32x16& p0, fa::f32x16& p1, int j) const { if (64 * j + 63 > qlo) fa::mask_tile(p0, p1, qm - 64 * j, 0x7fffffffu); }
    __device__ __forceinline__ void post(fa::f32x16&, fa::f32x16&, int) const {}
};
__device__ __forceinline__ void ph_mla_fa(const Args& a, const Ctx& c) {
    unsigned char* ws = a.ws; const bf16* PROJ = (const bf16*)(ws + WS_PROJ); const bf16* KVUP = (const bf16*)(ws + WS_KVUP); const bf16* KPE = (const bf16*)(ws + WS_KPE);
    bf16* OMLA = (bf16*)(ws + WS_OMLA); const int tid = c.tid, lane = c.lane, wid = c.wave, r32 = lane & 31, hi = lane >> 5;
    for (int item = blockIdx.x; item < BATCH * 16 * 8; item += c.G) {
        const int pr = item & 7, h = (item >> 3) & 15, b = item >> 7;
        for (int pass = 0; pass < 2; ++pass) { const int qb = pass ? 15 - pr : pr, q0 = 256 * qb;
            MlaPol P;
#pragma unroll
            for (int p = 0; p < 3; ++p) { const int L = tid + 512 * p, row = L / 24, ch = L % 24;
                if (ch < 16) { P.kp[p] = KVUP + (size_t)(b * T + row) * 4096 + h * 128 + ch * 8; P.kst[p] = 64 * 4096; }
                else { P.kp[p] = KPE + (size_t)(b * T + row) * 64 + (ch - 16) * 8; P.kst[p] = 64 * 64; } }
            { const int sr = tid >> 4, sc = (tid & 15) * 8; P.vp[0] = KVUP + (size_t)(b * T + sr) * 4096 + 2048 + h * 128 + sc; P.vp[1] = P.vp[0] + (size_t)32 * 4096; }
            P.qlo = q0 + 32 * wid; P.qm = P.qlo + r32 - 4 * hi;
            fa::bf16x8 qr[12]; const bf16* q = PROJ + (size_t)(b * T + P.qlo + r32) * NCOMBP + OFF_MLA_Q + h * 192 + hi * 8;
#pragma unroll
            for (int d0 = 0; d0 < 12; ++d0) qr[d0] = *(const fa::bf16x8*)(q + d0 * 16);
            fa::f32x16 o[4] = {}; float m_reg = -1e30f, l_reg = 0.f;
            const unsigned long long tiles = (2ull << (4 * qb + 3)) - 1ull;
            fa::attend<192, 0>(P, (LAS char*)c.lds, qr, tiles, o, m_reg, l_reg, 0.f, tid, wid, lane);
            fa::scale_rows(o, l_reg > 0.f ? 1.f / l_reg : 0.f, (LAS char*)c.lds, wid, r32, hi);
            fa::store_bf16(o, OMLA + (size_t)(b * T + P.qlo) * D + h * 128, D, r32, hi);
        }
    }
}

constexpr size_t WS_KCB = WS_SEL + 512 * 1024;
constexpr size_t WS_OACC = 446 * MiB;
constexpr int IMP_LD = 65;
__device__ __forceinline__ float t5_bias(float tab, int dist) {
    const int sq = dist * dist, lg = 39 - __clz(sq), b = dist < 16 ? dist : (lg < 31 ? lg : 31);
    return __builtin_bit_cast(float, __builtin_amdgcn_ds_bpermute(b << 2, __builtin_bit_cast(int, tab)));
}
struct NsaSrc { const bf16* kp[2]; const bf16* vp[2]; long kst, vst; };
struct CmpPol { NsaSrc s; int dq0; float tab; LAS float* imp;
    __device__ __forceinline__ const bf16* kptr(int p, int j) const { return s.kp[p] + (long)j * s.kst; }
    __device__ __forceinline__ const bf16* vptr(int i, int j) const { return s.vp[i] + (long)j * s.vst; }
    __device__ __forceinline__ bool act(int) const { return true; }
    __device__ __forceinline__ void mod(fa::f32x16& p0, fa::f32x16& p1, int j) const { const float NEG = -__builtin_inff(); const int d0 = dq0 - 1024 * j;
#pragma unroll
        for (int r = 0; r < 16; ++r) { const int c = (r & 3) + 8 * (r >> 2), da = d0 - 16 * c, db = da - 512;
            p0[r] = da >= 0 ? p0[r] + t5_bias(tab, da) : NEG; p1[r] = db >= 0 ? p1[r] + t5_bias(tab, db) : NEG; if ((r & 3) == 3) FA_SBAR(); } }
    __device__ __forceinline__ void post(fa::f32x16& p0, fa::f32x16& p1, int j) const {
#pragma unroll
        for (int q4 = 0; q4 < 4; ++q4) { LAS float* a = imp + 16 * j + 2 * q4;
            __hip_atomic_fetch_add(a, (p0[4 * q4] + p0[4 * q4 + 1]) + (p0[4 * q4 + 2] + p0[4 * q4 + 3]), __ATOMIC_RELAXED, __HIP_MEMORY_SCOPE_WORKGROUP);
            __hip_atomic_fetch_add(a + 1, p0[4 * q4 + 3], __ATOMIC_RELAXED, __HIP_MEMORY_SCOPE_WORKGROUP);
            __hip_atomic_fetch_add(a + 8, (p1[4 * q4] + p1[4 * q4 + 1]) + (p1[4 * q4 + 2] + p1[4 * q4 + 3]), __ATOMIC_RELAXED, __HIP_MEMORY_SCOPE_WORKGROUP);
            __hip_atomic_fetch_add(a + 9, p1[4 * q4 + 3], __ATOMIC_RELAXED, __HIP_MEMORY_SCOPE_WORKGROUP); } }
};
struct SlcPol { NsaSrc s; int dq0; float tab; unsigned long long sel;
    __device__ __forceinline__ const bf16* kptr(int p, int j) const { return s.kp[p] + (long)j * s.kst; }
    __device__ __forceinline__ const bf16* vptr(int i, int j) const { return s.vp[i] + (long)j * s.vst; }
    __device__ __forceinline__ bool act(int) const { return true; }
    __device__ __forceinline__ void mod(fa::f32x16& p0, fa::f32x16& p1, int j) const { const float NEG = -__builtin_inff(); const int d0 = dq0 - 64 * j; const bool on = (sel >> j) & 1ull;
#pragma unroll
        for (int r = 0; r < 16; ++r) { const int c = (r & 3) + 8 * (r >> 2), da = d0 - c, db = da - 32;
            p0[r] = (on && da >= 0) ? p0[r] + t5_bias(tab, da) : NEG; p1[r] = (on && db >= 0) ? p1[r] + t5_bias(tab, db) : NEG; if ((r & 3) == 3) FA_SBAR(); } }
    __device__ __forceinline__ void post(fa::f32x16&, fa::f32x16&, int) const {}
};
struct WinPol { NsaSrc s; int dq0; float tab;
    __device__ __forceinline__ const bf16* kptr(int p, int j) const { return s.kp[p] + (long)j * s.kst; }
    __device__ __forceinline__ const bf16* vptr(int i, int j) const { return s.vp[i] + (long)j * s.vst; }
    __device__ __forceinline__ bool act(int) const { return true; }
    __device__ __forceinline__ void mod(fa::f32x16& p0, fa::f32x16& p1, int j) const { const float NEG = -__builtin_inff(); const int d0 = dq0 - 64 * j;
#pragma unroll
        for (int r = 0; r < 16; ++r) { const int c = (r & 3) + 8 * (r >> 2), da = d0 - c, db = da - 32;
            p0[r] = (unsigned)da < 512u ? p0[r] + t5_bias(tab, da) : NEG; p1[r] = (unsigned)db < 512u ? p1[r] + t5_bias(tab, db) : NEG; if ((r & 3) == 3) FA_SBAR(); } }
    __device__ __forceinline__ void post(fa::f32x16&, fa::f32x16&, int) const {}
};
template <int MODE> __device__ __forceinline__ void oacc_rw(const fa::f32x16 (&o)[4], float* A, bf16* Bo, int r32, int hi) {
    asm volatile("" : "+v"(A), "+v"(Bo), "+v"(r32), "+v"(hi));
#pragma unroll
    for (int r = 0; r < 16; ++r) { const int orow = fa::crow(r, hi);
#pragma unroll
        for (int d0 = 0; d0 < 4; ++d0) { float* p = A + (size_t)orow * D + d0 * 32 + r32; float v = o[d0][r];
            if (MODE == 0) *p = v;
            else if (MODE == 1) *p = *p + v;
            else { v += *p; const float vn = __shfl_xor(v, 1); if ((r32 & 1) == 0) *(unsigned*)(Bo + (size_t)orow * D + d0 * 32 + r32) = fa::cvtpk(v, vn); } } }
}
__device__ __forceinline__ int opaque_i(int x) { asm volatile("" : "+v"(x)); return x; }
__device__ __forceinline__ void nsa_load_q(fa::bf16x8 (&qr)[8], const bf16* prow, int h, int hi) {
#pragma unroll
    for (int d0 = 0; d0 < 8; ++d0) { const v4u w = *(const v4u*)(prow + h * 128 + d0 * 16 + hi * 8); v4u o;
        o.x = fa::cvtpk(lo_bf(w.x) * NSA_SCALE, hi_bf(w.x) * NSA_SCALE); o.y = fa::cvtpk(lo_bf(w.y) * NSA_SCALE, hi_bf(w.y) * NSA_SCALE);
        o.z = fa::cvtpk(lo_bf(w.z) * NSA_SCALE, hi_bf(w.z) * NSA_SCALE); o.w = fa::cvtpk(lo_bf(w.w) * NSA_SCALE, hi_bf(w.w) * NSA_SCALE); qr[d0] = __builtin_bit_cast(fa::bf16x8, o); }
}
__device__ __forceinline__ void ph_nsa_fa(const Args& a, const Ctx& c) {
    unsigned char* ws = a.ws; const bf16* PROJ = (const bf16*)(ws + WS_PROJ); const bf16* KCB = (const bf16*)(ws + WS_KCB); const bf16* VCB = KCB + 1024 * 128;
    const float* relb = a.in[I_RELB]; bf16* ONSA = (bf16*)(ws + WS_ONSA); float* OACC = (float*)(ws + WS_OACC);
    const int wid = c.wave; LAS char* lds = (LAS char*)c.lds;
    LAS float* impT = (LAS float*)(lds + fa::OFF_IMP); LAS unsigned long long* selT = (LAS unsigned long long*)(lds + fa::OFF_SEL);
    for (int k = 0; ; ++k) { int u;
        if (c.G == 256) { if (k >= 2) break; u = k == 0 ? (int)blockIdx.x : 511 - (int)blockIdx.x; } else { u = (int)blockIdx.x + k * c.G; if (u >= 512) break; }
        const int tb = u >> 2, bg = u & 3, b = bg >> 1, g = bg & 1, h = g * 8 + wid, t0 = 32 * tb;
#define NSA_LANE() const int tid = opaque_i(c.tid), lane = tid & 63, r32 = lane & 31, hi = lane >> 5, sr = tid >> 4, sc = (tid & 15) * 8, tq = t0 + r32; \
        const bf16* prow = PROJ + (size_t)(b * T + tq) * NCOMBP; float* orow0 = OACC + (size_t)(b * T + t0) * D + h * 128; (void)sr; (void)sc; (void)orow0; (void)prow
        { NSA_LANE(); for (int i = tid; i < 32 * IMP_LD; i += NTHREADS) impT[i] = 0.f; }
        __syncthreads();
        { NSA_LANE(); fa::bf16x8 qr[8]; nsa_load_q(qr, prow, h, hi);
          CmpPol P; const bf16* kb = KCB + (size_t)(bg * 256) * 128; const bf16* vb = VCB + (size_t)(bg * 256) * 128;
          P.s.kp[0] = kb + sr * 128 + sc; P.s.kp[1] = P.s.kp[0] + 32 * 128; P.s.vp[0] = vb + sr * 128 + sc; P.s.vp[1] = P.s.vp[0] + 32 * 128; P.s.kst = 64 * 128; P.s.vst = 64 * 128;
          P.dq0 = tq - 31 - 64 * hi; P.tab = relb[r32 * 16 + h]; P.imp = impT + r32 * IMP_LD + hi;
          const unsigned long long tiles = (2ull << (t0 >> 10)) - 1ull;
          fa::f32x16 o[4] = {}; float m_c = -1e30f, l_c = 0.f;
          fa::attend<128, 1>(P, lds, qr, tiles, o, m_c, l_c, 0.f, tid, wid, lane);
          const float il = l_c > 0.f ? 1.f / l_c : 0.f;
          fa::attend<128, 2>(P, lds, qr, tiles, o, m_c, l_c, il, tid, wid, lane);
          { NSA_LANE(); fa::scale_rows(o, sigmoidf_(bf2f(prow[OFF_NSA_GATE + h])), lds, wid, r32, hi);
            oacc_rw<0>(o, orow0, nullptr, r32, hi); } }
        __syncthreads();
        { const int lane = opaque_i(c.lane);
          for (int i = 0; i < 4; ++i) { const int tk = 4 * wid + i, t = t0 + tk, cur = t >> 6; const float impv = impT[tk * IMP_LD + lane];
            const bool forced = (lane == 0) | (lane == cur) | (lane == cur - 1), validb = lane <= cur; float scv = forced ? 1e4f : (validb ? impv : -1e30f);
            unsigned long long selmask = 0ull;
            for (int r = 0; r < 16; ++r) { const float m = wave_max(scv); if (!(m > -5e29f)) break;
                const int sidx = wave_min_i(scv == m ? lane : 64); selmask |= 1ull << sidx; if (lane == sidx) scv = -3e30f; }
            if (lane == 0) selT[tk] = selmask; } }
        __syncthreads();
        { NSA_LANE(); fa::bf16x8 qr[8]; nsa_load_q(qr, prow, h, hi);
          SlcPol P; const bf16* kb = PROJ + (size_t)(b * T) * NCOMBP + OFF_NSA_KV + 2 * 256 + g * 128;
          P.s.kp[0] = kb + (size_t)sr * NCOMBP + sc; P.s.kp[1] = P.s.kp[0] + (size_t)32 * NCOMBP; P.s.vp[0] = P.s.kp[0] + 256; P.s.vp[1] = P.s.kp[1] + 256; P.s.kst = 64 * NCOMBP; P.s.vst = 64 * NCOMBP;
          P.dq0 = tq - 4 * hi; P.tab = relb[r32 * 16 + h]; P.sel = selT[r32];
          unsigned lo = (unsigned)P.sel, hi32 = (unsigned)(P.sel >> 32);
#pragma unroll
          for (int o_ = 1; o_ < 32; o_ <<= 1) { lo |= __shfl_xor(lo, o_); hi32 |= __shfl_xor(hi32, o_); }
          const unsigned long long tiles = ((unsigned long long)(unsigned)__builtin_amdgcn_readfirstlane((int)hi32) << 32) | (unsigned)__builtin_amdgcn_readfirstlane((int)lo);
          fa::f32x16 o[4] = {}; float m_s = -1e30f, l_s = 0.f;
          fa::attend<128, 0>(P, lds, qr, tiles, o, m_s, l_s, 0.f, tid, wid, lane);
          { NSA_LANE(); const float g1 = sigmoidf_(bf2f(prow[OFF_NSA_GATE + 16 + h]));
            fa::scale_rows(o, l_s > 0.f ? g1 / l_s : 0.f, lds, wid, r32, hi);
            oacc_rw<1>(o, orow0, nullptr, r32, hi); } }
        { NSA_LANE(); fa::bf16x8 qr[8]; nsa_load_q(qr, prow, h, hi);
          WinPol P; const bf16* kb = PROJ + (size_t)(b * T) * NCOMBP + OFF_NSA_KV + 4 * 256 + g * 128;
          P.s.kp[0] = kb + (size_t)sr * NCOMBP + sc; P.s.kp[1] = P.s.kp[0] + (size_t)32 * NCOMBP; P.s.vp[0] = P.s.kp[0] + 256; P.s.vp[1] = P.s.kp[1] + 256; P.s.kst = 64 * NCOMBP; P.s.vst = 64 * NCOMBP;
          P.dq0 = tq - 4 * hi; P.tab = relb[r32 * 16 + h];
          const int jlo = t0 >= 511 ? (t0 - 511) >> 6 : 0, jhi = (t0 + 31) >> 6;
          const unsigned long long tiles = ((2ull << jhi) - 1ull) & ~((1ull << jlo) - 1ull);
          fa::f32x16 o[4] = {}; float m_w = -1e30f, l_w = 0.f;
          fa::attend<128, 0>(P, lds, qr, tiles, o, m_w, l_w, 0.f, tid, wid, lane);
          { NSA_LANE(); const float g2 = sigmoidf_(bf2f(prow[OFF_NSA_GATE + 32 + h]));
            fa::scale_rows(o, l_w > 0.f ? g2 / l_w : 0.f, lds, wid, r32, hi);
            oacc_rw<2>(o, orow0, ONSA + (size_t)(b * T + t0) * D + h * 128, r32, hi); } }
        __syncthreads();
#undef NSA_LANE
    }
}
template <int DIM> __device__ __forceinline__ float dot_bf(const LAS float* q, const bf16* k) {
    float s = 0.f;
#pragma unroll 4
    for (int d = 0; d < DIM; d += 8) { const v4u w = *(const v4u*)(k + d); const f32x4 q0 = *(const LAS f32x4*)(q + d), q1 = *(const LAS f32x4*)(q + d + 4);
        s += q0.x * lo_bf(w.x) + q0.y * hi_bf(w.x) + q0.z * lo_bf(w.y) + q0.w * hi_bf(w.y) + q1.x * lo_bf(w.z) + q1.y * hi_bf(w.z) + q1.z * lo_bf(w.w) + q1.w * hi_bf(w.w); }
    return s;
}
template <int DIM> __device__ __forceinline__ float dot_f32(const LAS float* q, const float* k) {
    float s = 0.f;
#pragma unroll 4
    for (int d = 0; d < DIM; d += 4) { const f32x4 w = *(const f32x4*)(k + d); const f32x4 q0 = *(const LAS f32x4*)(q + d); s += q0.x * w.x + q0.y * w.y + q0.z * w.z + q0.w * w.w; }
    return s;
}
struct Soft { float m, l, o0, o1; };
__device__ __forceinline__ void soft_init(Soft& S) { S.m = -1e30f; S.l = 0.f; S.o0 = 0.f; S.o1 = 0.f; }
__device__ __forceinline__ void load2(const bf16* p, float& a, float& b) { const unsigned w = *(const unsigned*)p; a = lo_bf(w); b = hi_bf(w); }
__device__ __forceinline__ void load2(const float* p, float& a, float& b) { a = p[0]; b = p[1]; }
template <class VT> __device__ __forceinline__ void soft_chunk(Soft& S, float s, bool valid, int lane, const VT* vbase, long vstride) {
    const unsigned long long vm = __ballot(valid);
    if (vm == 0ull) return;
    const float cm = wave_max(valid ? s : -1e30f), mn = fmaxf(S.m, cm), sc = expf(S.m - mn), p = valid ? expf(s - mn) : 0.f;
    S.l = S.l * sc + wave_sum(p); S.o0 *= sc; S.o1 *= sc; S.m = mn;
    for (int k = 0; k < 64; ++k) if ((vm >> k) & 1ull) {
        const float pk = __shfl(p, k); float a, b; load2(vbase + (long)k * vstride + 2 * lane, a, b);
        S.o0 += pk * a; S.o1 += pk * b; }
}

__device__ __forceinline__ void transpose_item(const float* W, int K, int N, bf16* WT, int row_off, LAS float* scr, int item, int nblk, int lane) {
    const int kb = item / nblk, nb = item % nblk, k0 = 64 * kb, n0 = 32 * nb, nn = n0 + (lane & 31);
#pragma unroll 8
    for (int i = 0; i < 32; ++i) { const int kk = 2 * i + (lane >> 5); scr[kk * 33 + (lane & 31)] = nn < N ? W[(size_t)(k0 + kk) * N + nn] : 0.f; }
    LDS_WAIT(); asm volatile("" ::: "memory");
    const int c = lane & 7;
#pragma unroll
    for (int j = 0; j < 4; ++j) { const int n = (lane >> 3) + 8 * j; const LAS float* s = scr + (8 * c) * 33 + n;
        v4u o; o.x = pk2(s[0 * 33], s[1 * 33]); o.y = pk2(s[2 * 33], s[3 * 33]); o.z = pk2(s[4 * 33], s[5 * 33]); o.w = pk2(s[6 * 33], s[7 * 33]);
        *(v4u*)(WT + (size_t)(row_off + n0 + n) * K + k0 + 8 * c) = o; }
    LDS_WAIT(); asm volatile("" ::: "memory");
}
__device__ __forceinline__ void cvt_rows(const float* src, bf16* dst, size_t n8, size_t gt, size_t nt) {
    for (size_t i = gt; i < n8; i += nt) { const f32x4 a = *(const f32x4*)(src + 8 * i), b = *(const f32x4*)(src + 8 * i + 4);
        v4u o; o.x = pk2(a.x, a.y); o.y = pk2(a.z, a.w); o.z = pk2(b.x, b.y); o.w = pk2(b.z, b.w); *(v4u*)(dst + 8 * i) = o; }
}
__device__ __forceinline__ void ph_prologue(const Args& a, const Ctx& c) {
    LAS float* scr = (LAS float*)(c.lds + c.wave * 16384);
    unsigned char* ws = a.ws;
    constexpr int I0 = 32 * 360, I1 = 8 * 64, I2 = 32 * 64, I3 = 32 * 16, I4 = 64 * 8;
    constexpr int NITEMS = I0 + 2 * I1 + 3 * I2 + 3 * I3 + I1 + I2 + 2 * I4;
    for (int it = c.gw; it < NITEMS; it += c.ngw) {
        int r = it;
        if (r < I0) { transpose_item(a.in[I_WIN], D, NCOMB, (bf16*)(ws + WS_W_IN), 0, scr, r, 360, c.lane); continue; } r -= I0;
        if (r < I1) { transpose_item(a.in[I_WUK], 512, 2048, (bf16*)(ws + WS_W_UKV), 0, scr, r, 64, c.lane); continue; } r -= I1;
        if (r < I1) { transpose_item(a.in[I_WUV], 512, 2048, (bf16*)(ws + WS_W_UKV), 2048, scr, r, 64, c.lane); continue; } r -= I1;
        if (r < I2) { transpose_item(a.in[I_WBN], D, D, (bf16*)(ws + WS_W_BN), 0, scr, r, 64, c.lane); continue; } r -= I2;
        if (r < I2) { transpose_item(a.in[I_WBM], D, D, (bf16*)(ws + WS_W_BM), 0, scr, r, 64, c.lane); continue; } r -= I2;
        if (r < I2) { transpose_item(a.in[I_WMO], D, D, (bf16*)(ws + WS_W_MO), 0, scr, r, 64, c.lane); continue; } r -= I2;
        if (r < I3) { transpose_item(a.in[I_MWQ], D, 512, (bf16*)(ws + WS_W_MQ), 0, scr, r, 16, c.lane); continue; } r -= I3;
        if (r < I3) { transpose_item(a.in[I_MWK], D, 512, (bf16*)(ws + WS_W_MKV), 0, scr, r, 16, c.lane); continue; } r -= I3;
        if (r < I3) { transpose_item(a.in[I_MWV], D, 512, (bf16*)(ws + WS_W_MKV), 512, scr, r, 16, c.lane); continue; } r -= I3;
        if (r < I1) { transpose_item(a.in[I_MWO], 512, D, (bf16*)(ws + WS_W_MO2), 0, scr, r, 64, c.lane); continue; } r -= I1;
        if (r < I2) { transpose_item(a.in[I_PWQ], D, D, (bf16*)(ws + WS_W_PQ), 0, scr, r, 64, c.lane); continue; } r -= I2;
        if (r < I4) { transpose_item(a.in[I_CKW1], 4096, 256, (bf16*)(ws + WS_W_C1K), 0, scr, r, 8, c.lane); continue; } r -= I4;
        transpose_item(a.in[I_CVW1], 4096, 256, (bf16*)(ws + WS_W_C1V), 0, scr, r, 8, c.lane);
    }
    const size_t gt = (size_t)blockIdx.x * NTHREADS + c.tid, nt = (size_t)c.G * NTHREADS;
    cvt_rows(a.in[I_X], (bf16*)(ws + WS_XB), (size_t)NTOK * D / 8, gt, nt);
    cvt_rows(a.in[I_MEM], (bf16*)(ws + WS_MEMB), (size_t)BATCH * NMEM * D / 8, gt, nt);
    for (int o = c.gw; o < 512; o += c.ngw) { const int kv = o >> 8, j = o & 255; const float* pe = a.in[kv ? I_CVPE : I_CKPE]; const float* w1 = a.in[kv ? I_CVW1 : I_CKW1];
        float s = 0.f; for (int r = c.lane; r < 4096; r += 64) s += pe[r] * w1[(size_t)r * 256 + j];
        s = wave_sum(s); if (c.lane == 0) ((float*)(ws + WS_CVEC))[o] = s; }
    for (size_t i = gt; i < 65536; i += nt) { const int n = (int)(i >> 8), kk = (int)(i & 255); const float* keys = a.in[I_PKEYS];
        const float v = (n < 128 && kk < 128) ? keys[n * 128 + kk] : ((n >= 128 && kk >= 128) ? keys[16384 + (n - 128) * 128 + (kk - 128)] : 0.f);
        ((bf16*)(ws + WS_KEYB))[i] = (bf16)f2bf(v); }
    for (size_t i = gt; i < 8192; i += nt) { ((bf16*)(ws + WS_CMPA_K))[(size_t)4 * 4096 * 128 + i] = 0; ((bf16*)(ws + WS_CMPA_V))[(size_t)4 * 4096 * 128 + i] = 0; }
}

__device__ __forceinline__ void ph_rowprep(const Args& a, const Ctx& c) {
    unsigned char* ws = a.ws; bf16* PROJ = (bf16*)(ws + WS_PROJ); const int lane = c.lane;
    const float inv = exp2f(-(float)(lane & 31) * (13.287712379549449f / 32.f));
    const float* gk = a.in[I_KVNORM];
    for (int row = c.gw; row < NTOK; row += c.ngw) {
        const int b = row / T, t = row % T; bf16* prow = PROJ + (size_t)row * NCOMBP;
        const float ang = (float)t * inv, cs = cosf(ang), sn = sinf(ang);
        { const v4u w = *(const v4u*)(prow + OFF_MLA_KV + 8 * lane);
          float v[8] = {lo_bf(w.x), hi_bf(w.x), lo_bf(w.y), hi_bf(w.y), lo_bf(w.z), hi_bf(w.z), lo_bf(w.w), hi_bf(w.w)};
          float ss = 0.f;
#pragma unroll
          for (int i = 0; i < 8; ++i) ss += v[i] * v[i];
          const float r = rsqrtf(wave_sum(ss) * (1.f / 512.f) + 1e-6f);
          v4u o; o.x = pk2(v[0] * r * gk[8 * lane], v[1] * r * gk[8 * lane + 1]); o.y = pk2(v[2] * r * gk[8 * lane + 2], v[3] * r * gk[8 * lane + 3]);
          o.z = pk2(v[4] * r * gk[8 * lane + 4], v[5] * r * gk[8 * lane + 5]); o.w = pk2(v[6] * r * gk[8 * lane + 6], v[7] * r * gk[8 * lane + 7]);
          *(v4u*)((bf16*)(ws + WS_CKVN) + (size_t)row * 512 + 8 * lane) = o; }
        if (lane < 32) { const float x1 = bf2f(prow[OFF_MLA_KV + 512 + lane]), x2 = bf2f(prow[OFF_MLA_KV + 512 + 32 + lane]);
          bf16* kp = (bf16*)(ws + WS_KPE) + (size_t)row * 64; kp[lane] = (bf16)f2bf(x1 * cs - x2 * sn); kp[32 + lane] = (bf16)f2bf(x1 * sn + x2 * cs); }
#pragma unroll
        for (int j = 0; j < 8; ++j) { const int p = lane + 64 * j, h = p >> 5, i = p & 31; bf16* q = prow + OFF_MLA_Q + h * 192;
          const float x1 = bf2f(q[128 + i]), x2 = bf2f(q[160 + i]);
          q[128 + i] = (bf16)f2bf((x1 * cs - x2 * sn) * MLA_SCALE); q[160 + i] = (bf16)f2bf((x1 * sn + x2 * cs) * MLA_SCALE); }
#pragma unroll
        for (int j = 0; j < 4; ++j) { const int e = 8 * (lane + 64 * j), h = e >> 7, d = e & 127; bf16* q = prow + OFF_MLA_Q + h * 192 + d;
          const v4u w = *(const v4u*)q; v4u o; o.x = pk2(lo_bf(w.x) * MLA_SCALE, hi_bf(w.x) * MLA_SCALE); o.y = pk2(lo_bf(w.y) * MLA_SCALE, hi_bf(w.y) * MLA_SCALE);
          o.z = pk2(lo_bf(w.z) * MLA_SCALE, hi_bf(w.z) * MLA_SCALE); o.w = pk2(lo_bf(w.w) * MLA_SCALE, hi_bf(w.w) * MLA_SCALE); *(v4u*)q = o; }
        { const int i = lane >> 5, g = (lane >> 4) & 1, ch = lane & 15;
          const v4u w = *(const v4u*)(prow + OFF_NSA_KV + i * 256 + g * 128 + 8 * ch);
          bf16* dst = (bf16*)(ws + (i ? WS_CMPA_V : WS_CMPA_K)) + ((size_t)(b * 2 + g) * T + t) * 128 + 8 * ch; *(v4u*)dst = w; }
    }
}

__device__ __forceinline__ void ph_cmp2(const Args& a, const Ctx& c) {
    unsigned char* ws = a.ws; const float* H1 = (const float*)(ws + WS_H1); const float* cvec = (const float*)(ws + WS_CVEC); float* KCVC = (float*)(ws + WS_KCVC);
    const int gt = blockIdx.x * NTHREADS + c.tid, nt = c.G * NTHREADS;
    for (int o = gt; o < 2 * 1024 * 128; o += nt) { const int kv = o >> 17, m = (o >> 7) & 1023, ch = o & 127;
        const float* h = H1 + ((size_t)kv * 1024 + m) * 256; const float* cv = cvec + kv * 256; const float* w2 = a.in[kv ? I_CVW2 : I_CKW2];
        float s = 0.f; for (int j = 0; j < 256; ++j) s += gelu_tanh(h[j] + cv[j]) * w2[j * 128 + ch];
        KCVC[o] = s; ((bf16*)(ws + WS_KCB))[o] = (bf16)f2bf(s); }
}

__device__ __forceinline__ void ph_nsa(const Args& a, const Ctx& c) {
    unsigned char* ws = a.ws; const bf16* PROJ = (const bf16*)(ws + WS_PROJ); const float* KC = (const float*)(ws + WS_KCVC); const float* VC = KC + 1024 * 128;
    const float* relb = a.in[I_RELB]; bf16* ONSA = (bf16*)(ws + WS_ONSA); const int lane = c.lane;
    LAS float* qs = (LAS float*)(c.lds + c.wave * 8192); LAS float* pl = qs + 256;
    for (int task = c.gw; task < NTOK * 2; task += c.ngw) {
        const int g = task & 1, row = task >> 1, b = row / T, t = row % T; const bf16* prow = PROJ + (size_t)row * NCOMBP;
        const int ncv = t >= 31 ? (t - 31) / 16 + 1 : 0;
        const float* kcb = KC + (size_t)(b * 2 + g) * 256 * 128; const float* vcb = VC + (size_t)(b * 2 + g) * 256 * 128;
        float imp = 0.f;
        for (int hh = 0; hh < 8; ++hh) { const int h = g * 8 + hh;
            qs[lane] = bf2f(prow[h * 128 + lane]) * NSA_SCALE; qs[lane + 64] = bf2f(prow[h * 128 + 64 + lane]) * NSA_SCALE; LDS_WAIT();
            float s[4]; bool v[4]; float mx = -1e30f;
#pragma unroll
            for (int i = 0; i < 4; ++i) { const int n = lane + 64 * i; v[i] = n < ncv; s[i] = -1e30f;
                if (v[i]) s[i] = dot_f32<128>(qs, kcb + (size_t)n * 128) + relb[t5_bucket(t - 16 * n - 31) * 16 + h];
                mx = fmaxf(mx, s[i]); }
            mx = wave_max(mx); float p[4], l = 0.f;
#pragma unroll
            for (int i = 0; i < 4; ++i) { p[i] = v[i] ? expf(s[i] - mx) : 0.f; l += p[i]; }
            l = wave_sum(l); const float il = l > 0.f ? 1.f / l : 0.f;
#pragma unroll
            for (int i = 0; i < 4; ++i) pl[lane + 64 * i] = p[i] * il;
            LDS_WAIT();
#pragma unroll
            for (int n = 4 * lane - 1; n <= 4 * lane + 3; ++n) if (n >= 0 && n < 255) imp += pl[n];
            LDS_WAIT(); }
        const int cur = t >> 6; unsigned long long selmask = 0ull;
        { const bool forced = (lane == 0) | (lane == cur) | (lane == cur - 1), validb = lane <= cur;
          float sc = forced ? 1e4f : (validb ? imp : -1e30f);
          for (int r = 0; r < 16; ++r) { const float m = wave_max(sc); if (!(m > -5e29f)) break;
              const int idx = wave_min_i(sc == m ? lane : 64); selmask |= 1ull << idx; if (lane == idx) sc = -3e30f; } }
        if (lane == 0) ((unsigned long long*)(ws + WS_SEL))[task] = selmask;
        for (int hh = 0; hh < 8; ++hh) { const int h = g * 8 + hh;
            qs[lane] = bf2f(prow[h * 128 + lane]) * NSA_SCALE; qs[lane + 64] = bf2f(prow[h * 128 + 64 + lane]) * NSA_SCALE; LDS_WAIT();
            Soft Sc, Ss, Sw; soft_init(Sc); soft_init(Ss); soft_init(Sw);
            for (int i = 0; i < 4; ++i) { const int n = lane + 64 * i; const bool v = n < ncv; float s = 0.f;
                if (v) s = dot_f32<128>(qs, kcb + (size_t)n * 128) + relb[t5_bucket(t - 16 * n - 31) * 16 + h];
                soft_chunk<float>(Sc, s, v, lane, vcb + (size_t)(64 * i) * 128, 128); }
            for (unsigned long long mm = selmask; mm; mm &= mm - 1) { const int j = __ffsll((long long)mm) - 1, sp = 64 * j + lane; const bool v = sp <= t; float s = 0.f;
                const bf16* kb = PROJ + (size_t)(b * T + 64 * j) * NCOMBP + OFF_NSA_KV + 2 * 256 + g * 128;
                if (v) s = dot_bf<128>(qs, kb + (size_t)lane * NCOMBP) + relb[t5_bucket(t - sp) * 16 + h];
                soft_chunk<bf16>(Ss, s, v, lane, kb + 256, NCOMBP); }
            for (int cc = 0; cc < 8; ++cc) { const int s0 = t - 511 + 64 * cc, sp = s0 + lane; const bool v = sp >= 0; float s = 0.f;
                const bf16* kb = PROJ + ((long)(b * T) + s0) * NCOMBP + OFF_NSA_KV + 4 * 256 + g * 128;
                if (v) s = dot_bf<128>(qs, kb + (long)lane * NCOMBP) + relb[t5_bucket(t - sp) * 16 + h];
                soft_chunk<bf16>(Sw, s, v, lane, kb + 256, NCOMBP); }
            const float g0 = sigmoidf_(bf2f(prow[OFF_NSA_GATE + h])), g1 = sigmoidf_(bf2f(prow[OFF_NSA_GATE + 16 + h])), g2 = sigmoidf_(bf2f(prow[OFF_NSA_GATE + 32 + h]));
            const float ic = Sc.l > 0.f ? g0 / Sc.l : 0.f, is = Ss.l > 0.f ? g1 / Ss.l : 0.f, iw = Sw.l > 0.f ? g2 / Sw.l : 0.f;
            *(unsigned*)(ONSA + (size_t)row * D + h * 128 + 2 * lane) = pk2(Sc.o0 * ic + Ss.o0 * is + Sw.o0 * iw, Sc.o1 * ic + Ss.o1 * is + Sw.o1 * iw);
            LDS_WAIT(); }
    }
}

__device__ __forceinline__ void ph_mla(const Args& a, const Ctx& c) {
    unsigned char* ws = a.ws; const bf16* PROJ = (const bf16*)(ws + WS_PROJ); const bf16* KVUP = (const bf16*)(ws + WS_KVUP); const bf16* KPE = (const bf16*)(ws + WS_KPE);
    bf16* OMLA = (bf16*)(ws + WS_OMLA); const int lane = c.lane; LAS float* qs = (LAS float*)(c.lds + c.wave * 8192);
    for (int task = c.gw; task < NTOK * 16; task += c.ngw) {
        const int h = task & 15, row = task >> 4, b = row / T, t = row % T; const bf16* q = PROJ + (size_t)row * NCOMBP + OFF_MLA_Q + h * 192;
        qs[lane] = bf2f(q[lane]); qs[lane + 64] = bf2f(q[lane + 64]); qs[lane + 128] = bf2f(q[lane + 128]); LDS_WAIT();
        Soft S; soft_init(S);
        for (int cc = 0; cc <= (t >> 6); ++cc) { const int sp = 64 * cc + lane; const bool v = sp <= t; float s = 0.f;
            const bf16* kb = KVUP + (size_t)(b * T + 64 * cc) * 4096 + h * 128;
            if (v) s = dot_bf<128>(qs, kb + (size_t)lane * 4096) + dot_bf<64>(qs + 128, KPE + (size_t)(b * T + sp) * 64);
            soft_chunk<bf16>(S, s, v, lane, kb + 2048, 4096); }
        const float il = S.l > 0.f ? 1.f / S.l : 0.f;
        *(unsigned*)(OMLA + (size_t)row * D + h * 128 + 2 * lane) = pk2(S.o0 * il, S.o1 * il);
        LDS_WAIT();
    }
}

__device__ __forceinline__ void ph_merge(const Args& a, const Ctx& c) {
    unsigned char* ws = a.ws; const bf16* PROJ = (const bf16*)(ws + WS_PROJ); const bf16* YN = (const bf16*)(ws + WS_YN); const bf16* YM = (const bf16*)(ws + WS_YM); bf16* MG = (bf16*)(ws + WS_MERGED);
    const size_t gt = (size_t)blockIdx.x * NTHREADS + c.tid, nt = (size_t)c.G * NTHREADS;
    for (size_t i = gt; i < (size_t)NTOK * D / 8; i += nt) { const size_t row = i / (D / 8); const int col = (int)(i % (D / 8)) * 8;
        const v4u g0 = *(const v4u*)(PROJ + row * NCOMBP + OFF_MERGE + col), g1 = *(const v4u*)(PROJ + row * NCOMBP + OFF_MERGE + D + col), yn = *(const v4u*)(YN + row * D + col), ym = *(const v4u*)(YM + row * D + col);
        v4u o;
#define MRG(f) pk2(sigmoidf_(lo_bf(g0.f)) * lo_bf(yn.f) + sigmoidf_(lo_bf(g1.f)) * lo_bf(ym.f), sigmoidf_(hi_bf(g0.f)) * hi_bf(yn.f) + sigmoidf_(hi_bf(g1.f)) * hi_bf(ym.f))
        o.x = MRG(x); o.y = MRG(y); o.z = MRG(z); o.w = MRG(w);
#undef MRG
        *(v4u*)(MG + row * D + col) = o; }
}

__device__ __forceinline__ void ln_rows_store(f32x4 (&v)[8], const float* gam, const float* bet, float* outf, bf16* outb, int lane) {
    float s = 0.f;
#pragma unroll
    for (int j = 0; j < 8; ++j) s += (v[j].x + v[j].y) + (v[j].z + v[j].w);
    const float mean = wave_sum(s) * (1.f / D); float s2 = 0.f;
#pragma unroll
    for (int j = 0; j < 8; ++j) { v[j] = v[j] - mean; s2 += (v[j].x * v[j].x + v[j].y * v[j].y) + (v[j].z * v[j].z + v[j].w * v[j].w); }
    const float rstd = rsqrtf(wave_sum(s2) * (1.f / D) + 1e-5f);
#pragma unroll
    for (int j = 0; j < 8; ++j) { const int e = 4 * lane + 256 * j; const f32x4 gg = *(const f32x4*)(gam + e), bb = *(const f32x4*)(bet + e); const f32x4 o = v[j] * rstd * gg + bb;
        *(f32x4*)(outf + e) = o;
        if (outb) { uint2 w; w.x = pk2(o.x, o.y); w.y = pk2(o.z, o.w); *(uint2*)(outb + e) = w; } }
}
__device__ __forceinline__ void ph_ln(const Ctx& c, const float* xin, const float* z, const float* gam, const float* bet, float* outf, bf16* outb) {
    for (int row = c.gw; row < NTOK; row += c.ngw) { f32x4 v[8];
#pragma unroll
        for (int j = 0; j < 8; ++j) { const size_t e = (size_t)row * D + 4 * c.lane + 256 * j; v[j] = *(const f32x4*)(xin + e) * ALPHA + *(const f32x4*)(z + e); }
        ln_rows_store(v, gam, bet, outf + (size_t)row * D, outb + (size_t)row * D, c.lane); }
}

__device__ __forceinline__ void ph_memattn(const Args& a, const Ctx& c) {
    unsigned char* ws = a.ws; const bf16* QM = (const bf16*)(ws + WS_QMEM); const bf16* KV = (const bf16*)(ws + WS_KVMEM); bf16* OM = (bf16*)(ws + WS_OMEM);
    const int lane = c.lane; LAS float* qs = (LAS float*)(c.lds + c.wave * 8192);
    for (int task = c.gw; task < NTOK * 4; task += c.ngw) { const int h = task & 3, row = task >> 2, b = row / T; const bf16* q = QM + (size_t)row * 512 + h * 128;
        qs[lane] = bf2f(q[lane]) * MEM_SCALE; qs[lane + 64] = bf2f(q[lane + 64]) * MEM_SCALE; LDS_WAIT();
        Soft S; soft_init(S);
        for (int cc = 0; cc < 4; ++cc) { const bf16* kb = KV + (size_t)(b * NMEM + 64 * cc) * 1024 + h * 128;
            const float s = dot_bf<128>(qs, kb + (size_t)lane * 1024); soft_chunk<bf16>(S, s, true, lane, kb + 512, 1024); }
        const float il = 1.f / S.l;
        *(unsigned*)(OM + (size_t)row * 512 + h * 128 + 2 * lane) = pk2(S.o0 * il, S.o1 * il);
        LDS_WAIT(); }
}

__device__ __forceinline__ void top16_of128(float x0, float x1, LAS float* vs, LAS int* is, int lane) {
    for (int r = 0; r < 16; ++r) { const float m = wave_max(fmaxf(x0, x1));
        const int idx = wave_min_i(x0 == m ? lane : (x1 == m ? lane + 64 : 1 << 20));
        if (lane == 0) { vs[r] = m; is[r] = idx; }
        if (idx == lane) x0 = -__builtin_inff(); if (idx == lane + 64) x1 = -__builtin_inff(); }
}
__device__ __forceinline__ void ph_peer_select(const Args& a, const Ctx& c) {
    unsigned char* ws = a.ws; const float* PQ = (const float*)(ws + WS_PQ); const float* keys = a.in[I_PKEYS]; int* PIDX = (int*)(ws + WS_PIDX); float* PGATE = (float*)(ws + WS_PGATE);
    const int lane = c.lane; LAS float* qs = (LAS float*)(c.lds + c.wave * 8192); LAS float* v1 = qs + 256; LAS int* i1 = (LAS int*)(qs + 272); LAS float* v2 = qs + 288; LAS int* i2 = (LAS int*)(qs + 304);
    for (int task = c.gw; task < NTOK * 8; task += c.ngw) { const int hh = task & 7, tok = task >> 3; const float* q = PQ + (size_t)tok * D + hh * 256;
#pragma unroll
        for (int i = 0; i < 4; ++i) qs[lane + 64 * i] = q[lane + 64 * i];
        LDS_WAIT();
        const float a0 = dot_f32<128>(qs, keys + (size_t)lane * 128), a1 = dot_f32<128>(qs, keys + (size_t)(lane + 64) * 128);
        const float b0 = dot_f32<128>(qs + 128, keys + (size_t)(128 + lane) * 128), b1 = dot_f32<128>(qs + 128, keys + (size_t)(128 + lane + 64) * 128);
        top16_of128(a0, a1, v1, i1, lane); top16_of128(b0, b1, v2, i2, lane); LDS_WAIT();
        float cv[4];
#pragma unroll
        for (int k = 0; k < 4; ++k) { const int f = 4 * lane + k; cv[k] = v1[f >> 4] + v2[f & 15]; }
        float top_s = 0.f; int flat = 0;
        for (int r = 0; r < 16; ++r) { const float m = wave_max(fmaxf(fmaxf(cv[0], cv[1]), fmaxf(cv[2], cv[3])));
            int cand = 1 << 20;
#pragma unroll
            for (int k = 3; k >= 0; --k) if (cv[k] == m) cand = 4 * lane + k;
            const int idx = wave_min_i(cand);
            if (lane == r) { top_s = m; flat = idx; }
#pragma unroll
            for (int k = 0; k < 4; ++k) if (idx == 4 * lane + k) cv[k] = -__builtin_inff(); }
        const float mx = __shfl(top_s, 0); const float e = lane < 16 ? expf(top_s - mx) : 0.f; const float l = wave_sum(e);
        if (lane < 16) { PIDX[(size_t)tok * 128 + hh * 16 + lane] = i1[flat >> 4] * 128 + i2[flat & 15]; PGATE[(size_t)tok * 128 + hh * 16 + lane] = e / l; }
        LDS_WAIT(); }
}

__device__ const unsigned char PEER_CAND[64] = {0,1,2,3,4,5,6,7,8,9,10,11,12,13,14,15,16,17,18,19,20,21,22,23,32,33,34,35,36,48,49,50,51,64,65,66,80,81,96,97,112,113,128,144,160,176,192,208,224,240,
                                                255,255,255,255,255,255,255,255,255,255,255,255,255,255};
__device__ __forceinline__ unsigned fkey(float x) { const unsigned u = __float_as_uint(x); return u ^ ((unsigned)((int)u >> 31) | 0x80000000u); }
__device__ __forceinline__ float funkey(unsigned k) { return __uint_as_float((k & 0x80000000u) ? (k ^ 0x80000000u) : ~k); }
template <int CTRL> __device__ __forceinline__ unsigned dppu(unsigned v) { return (unsigned)__builtin_amdgcn_update_dpp((int)v, (int)v, CTRL, 0xF, 0xF, false); }
__device__ __forceinline__ unsigned row16_max_u(unsigned v) {
    unsigned t = dppu<0xB1>(v); v = v > t ? v : t; t = dppu<0x4E>(v); v = v > t ? v : t; t = dppu<0x141>(v); v = v > t ? v : t; t = dppu<0x140>(v); v = v > t ? v : t; return v; }
__device__ __forceinline__ float row16_sum_f(float v) {
    v += __uint_as_float(dppu<0xB1>(__float_as_uint(v))); v += __uint_as_float(dppu<0x4E>(__float_as_uint(v))); v += __uint_as_float(dppu<0x141>(__float_as_uint(v))); v += __uint_as_float(dppu<0x140>(__float_as_uint(v))); return v; }
#define PEER_CE(x, y) do { const unsigned hi_ = (x) > (y) ? (x) : (y), lo_ = (x) > (y) ? (y) : (x); (x) = hi_; (y) = lo_; } while (0)
__device__ __forceinline__ unsigned top16_of_row8(unsigned (&k)[8], int l16) {
    PEER_CE(k[0], k[1]); PEER_CE(k[2], k[3]); PEER_CE(k[4], k[5]); PEER_CE(k[6], k[7]); PEER_CE(k[0], k[2]); PEER_CE(k[1], k[3]); PEER_CE(k[4], k[6]); PEER_CE(k[5], k[7]);
    PEER_CE(k[1], k[2]); PEER_CE(k[5], k[6]); PEER_CE(k[0], k[4]); PEER_CE(k[1], k[5]); PEER_CE(k[2], k[6]); PEER_CE(k[3], k[7]); PEER_CE(k[2], k[4]); PEER_CE(k[3], k[5]);
    PEER_CE(k[1], k[2]); PEER_CE(k[3], k[4]); PEER_CE(k[5], k[6]);
    unsigned res = 0u;
    for (int t = 0; t < 16; ++t) { const unsigned m = row16_max_u(k[0]); res = l16 == t ? m : res; const bool pop = k[0] == m;
        k[0] = pop ? k[1] : k[0]; k[1] = pop ? k[2] : k[1]; k[2] = pop ? k[3] : k[2]; k[3] = pop ? k[4] : k[3]; k[4] = pop ? k[5] : k[4]; k[5] = pop ? k[6] : k[5]; k[6] = pop ? k[7] : k[6]; k[7] = pop ? 0u : k[7]; }
    return res;
}
__device__ __forceinline__ void ph_peer_select2(const Args& a, const Ctx& c) {
    unsigned char* ws = a.ws; const float* S = (const float*)(ws + WS_S); int* PIDX = (int*)(ws + WS_PIDX); float* PGATE = (float*)(ws + WS_PGATE);
    const int lane = c.lane, l16 = lane & 15, rq = lane >> 4, rowbase = lane & 48;
    for (int it = c.gw; it < NTOK * 2; it += c.ngw) { const int R = 4 * it + rq; const float* s = S + (size_t)R * 256 + 8 * l16;
        const f32x4 x0 = *(const f32x4*)s, x1 = *(const f32x4*)(s + 4), y0 = *(const f32x4*)(s + 128), y1 = *(const f32x4*)(s + 132);
        unsigned k[8]; const unsigned ib = 127u - 8u * (unsigned)l16;
        k[0] = (fkey(x0.x) & ~127u) | ib; k[1] = (fkey(x0.y) & ~127u) | (ib - 1); k[2] = (fkey(x0.z) & ~127u) | (ib - 2); k[3] = (fkey(x0.w) & ~127u) | (ib - 3);
        k[4] = (fkey(x1.x) & ~127u) | (ib - 4); k[5] = (fkey(x1.y) & ~127u) | (ib - 5); k[6] = (fkey(x1.z) & ~127u) | (ib - 6); k[7] = (fkey(x1.w) & ~127u) | (ib - 7);
        const unsigned r1 = top16_of_row8(k, l16);
        k[0] = (fkey(y0.x) & ~127u) | ib; k[1] = (fkey(y0.y) & ~127u) | (ib - 1); k[2] = (fkey(y0.z) & ~127u) | (ib - 2); k[3] = (fkey(y0.w) & ~127u) | (ib - 3);
        k[4] = (fkey(y1.x) & ~127u) | (ib - 4); k[5] = (fkey(y1.y) & ~127u) | (ib - 5); k[6] = (fkey(y1.z) & ~127u) | (ib - 6); k[7] = (fkey(y1.w) & ~127u) | (ib - 7);
        const unsigned r2 = top16_of_row8(k, l16);
        unsigned ck[4];
#pragma unroll
        for (int si = 0; si < 4; ++si) { const int ci = 4 * l16 + si; const unsigned flat = PEER_CAND[ci];
            const unsigned ka = (unsigned)__builtin_amdgcn_ds_bpermute((rowbase + (int)(flat >> 4)) << 2, (int)r1), kb = (unsigned)__builtin_amdgcn_ds_bpermute((rowbase + (int)(flat & 15u)) << 2, (int)r2);
            const float sum = funkey(ka & ~127u) + funkey(kb & ~127u);
            ck[si] = ci < 50 ? ((fkey(sum) & ~255u) | (255u - flat)) : 0u; }
        PEER_CE(ck[0], ck[1]); PEER_CE(ck[2], ck[3]); PEER_CE(ck[0], ck[2]); PEER_CE(ck[1], ck[3]); PEER_CE(ck[1], ck[2]);
        unsigned rf = 0u;
        for (int t = 0; t < 16; ++t) { const unsigned m = row16_max_u(ck[0]); rf = l16 == t ? m : rf; const bool pop = ck[0] == m;
            ck[0] = pop ? ck[1] : ck[0]; ck[1] = pop ? ck[2] : ck[1]; ck[2] = pop ? ck[3] : ck[2]; ck[3] = pop ? 0u : ck[3]; }
        const unsigned flat = 255u - (rf & 255u); const float ts = funkey(rf & ~255u), mx = funkey(row16_max_u(rf) & ~255u);
        const unsigned ka = (unsigned)__builtin_amdgcn_ds_bpermute((rowbase + (int)(flat >> 4)) << 2, (int)r1), kb = (unsigned)__builtin_amdgcn_ds_bpermute((rowbase + (int)(flat & 15u)) << 2, (int)r2);
        const float ex = expf(ts - mx), den = row16_sum_f(ex);
        PIDX[(size_t)R * 16 + l16] = (int)((127u - (ka & 127u)) * 128u + (127u - (kb & 127u))); PGATE[(size_t)R * 16 + l16] = ex / den; }
}

constexpr size_t WS_U8 = 1 * MiB, WS_USC = 33 * MiB, WS_V8 = 478 * MiB;
__device__ __forceinline__ void peer_convert(const Args& a, int gw, int ngw, int lane) {
    unsigned char* ws = a.ws; float* SC = (float*)(ws + WS_USC);
    for (int r = gw; r < 2 * 16384; r += ngw) { const int which = r >> 14, e = r & 16383; const float* src = a.in[which ? I_PV : I_PU] + (size_t)e * D;
        f32x4 v[8]; float am = 0.f;
#pragma unroll
        for (int j = 0; j < 8; ++j) { v[j] = __builtin_nontemporal_load((const f32x4*)(src + 4 * lane + 256 * j)); am = fmaxf(am, fmaxf(fmaxf(fabsf(v[j].x), fabsf(v[j].y)), fmaxf(fabsf(v[j].z), fabsf(v[j].w)))); }
        am = wave_max(am); const float s = am > 0.f ? am * (1.f / 127.f) : 1.f, is = 1.f / s;
        unsigned* dst = (unsigned*)(ws + (which ? WS_V8 : WS_U8) + (size_t)e * D);
#pragma unroll
        for (int j = 0; j < 8; ++j) { const int q0 = (int)rintf(v[j].x * is) + 128, q1 = (int)rintf(v[j].y * is) + 128, q2 = (int)rintf(v[j].z * is) + 128, q3 = (int)rintf(v[j].w * is) + 128;
            dst[lane + 64 * j] = (unsigned)q0 | ((unsigned)q1 << 8) | ((unsigned)q2 << 16) | ((unsigned)q3 << 24); }
        if (lane == 0) SC[r] = s; }
}
#define PEER_DOT4(bw_, xj) (((float)((bw_) & 0xffu) * (xj).x + (float)(((bw_) >> 8) & 0xffu) * (xj).y) + ((float)(((bw_) >> 16) & 0xffu) * (xj).z + (float)((bw_) >> 24) * (xj).w))
__device__ __forceinline__ void ph_peer_ffn(const Args& a, const Ctx& c) {
    unsigned char* ws = a.ws; const float* X2 = (const float*)(ws + WS_X2); const int* PIDX = (const int*)(ws + WS_PIDX); const float* PGATE = (const float*)(ws + WS_PGATE);
    const unsigned* U8 = (const unsigned*)(ws + WS_U8); const unsigned* V8 = (const unsigned*)(ws + WS_V8); const float* SC = (const float*)(ws + WS_USC); const int lane = c.lane;
    for (int tok = c.gw; tok < NTOK; tok += c.ngw) { f32x4 xv[8], acc[8]; float sx = 0.f;
#pragma unroll
        for (int j = 0; j < 8; ++j) { xv[j] = *(const f32x4*)(X2 + (size_t)tok * D + 4 * lane + 256 * j); acc[j] = (f32x4){0.f, 0.f, 0.f, 0.f}; sx += (xv[j].x + xv[j].y) + (xv[j].z + xv[j].w); }
        sx = wave_sum(sx) * 128.f; float csum = 0.f;
        for (int k = 0; k < 128; k += 4) { int e[4]; float g[4], d[4];
#pragma unroll
            for (int i = 0; i < 4; ++i) { e[i] = __builtin_amdgcn_readfirstlane(PIDX[(size_t)tok * 128 + k + i]); g[i] = PGATE[(size_t)tok * 128 + k + i]; }
            unsigned ub[4][8];
#pragma unroll
            for (int i = 0; i < 4; ++i)
#pragma unroll
                for (int j = 0; j < 8; ++j) ub[i][j] = U8[(size_t)e[i] * 512 + lane + 64 * j];
#pragma unroll
            for (int i = 0; i < 4; ++i) { float s = 0.f;
#pragma unroll
                for (int j = 0; j < 8; ++j) s += PEER_DOT4(ub[i][j], xv[j]);
                d[i] = s; }
#pragma unroll
            for (int i = 0; i < 4; ++i) { const float h = (wave_sum(d[i]) - sx) * SC[e[i]]; d[i] = g[i] * gelu_tanh(h) * SC[16384 + e[i]]; csum += d[i]; }
#pragma unroll
            for (int i = 0; i < 4; ++i)
#pragma unroll
                for (int j = 0; j < 8; ++j) ub[i][j] = V8[(size_t)e[i] * 512 + lane + 64 * j];
#pragma unroll
            for (int i = 0; i < 4; ++i)
#pragma unroll
                for (int j = 0; j < 8; ++j) { const unsigned w = ub[i][j];
                    acc[j].x += d[i] * (float)(w & 0xffu); acc[j].y += d[i] * (float)((w >> 8) & 0xffu); acc[j].z += d[i] * (float)((w >> 16) & 0xffu); acc[j].w += d[i] * (float)(w >> 24); } }
        const float off = csum * 128.f;
#pragma unroll
        for (int j = 0; j < 8; ++j) acc[j] = acc[j] - off + xv[j] * ALPHA;
        ln_rows_store(acc, a.in[I_LN3G], a.in[I_LN3B], a.out + (size_t)tok * D, nullptr, lane); }
}

struct OneUnit { int pm, pn; bool has;
    __device__ bool next(int i, pg8::Unit& u) const { if (i != 0 || !has) return false; u.pm = pm; u.pn = pn; return true; }
    __device__ __forceinline__ void a_ready(const pg8::Unit&) const {}
    __device__ __forceinline__ void done(const pg8::Unit&) const {} };

constexpr int N_PHASES = 19;
__global__ void __launch_bounds__(NTHREADS, 2) fwd(Args args) {
    extern __shared__ __attribute__((aligned(16))) unsigned char lds_raw[];
    Ctx c; c.lds = (LAS unsigned char*)lds_raw; c.tid = threadIdx.x; c.lane = c.tid & 63; c.wave = __builtin_amdgcn_readfirstlane(c.tid >> 6);
    c.G = gridDim.x; c.gw = blockIdx.x * NWAVES + c.wave; c.ngw = c.G * NWAVES;
    volatile LAS unsigned* MISC = (volatile LAS unsigned*)(c.lds + MISC_OFF);
    unsigned char* ws = args.ws; unsigned* ctl = (unsigned*)(ws + WS_CTL);
    for (int u = c.tid; u < (LDS_BYTES - LDSCTL_OFF) / 4; u += NTHREADS) ((LAS unsigned*)(c.lds + LDSCTL_OFF))[u] = 0u;
    __syncthreads();
    XcdBarrier bar; bar.bar = ctl + CW_BAR; bar.x = 0; bar.st = nullptr;
    if (N_LAUNCHES == 1) bar = xcd_barrier_post(ctl + CW_BAR, MISC + 8);
    const int lo = args.ph_lo, hi = args.ph_hi;
#define IN(k) (lo <= (k) && (k) < hi)
#define SEAM(k) do { if (N_LAUNCHES == 1 && IN(k) && IN((k) + 1)) xcd_barrier(bar); } while (0)
    LAS unsigned char* ring = c.lds;
    const int bx = (int)blockIdx.x;

    if (IN(0)) { ph_prologue(args, c); } SEAM(0);
    if (IN(1)) {
        { pg8::Gemm g{(const bf16*)(ws + WS_XB), (const bf16*)(ws + WS_W_IN), NTOK, NCOMBP, D, D, D}; pg8::StaticOrder S; S.init(NTOK, NCOMBP, c.G, bx);
          pg8::EpiBf16<0> E{(bf16*)(ws + WS_PROJ), NCOMBP, nullptr, 0, 0, 1.f}; pg8::gemm_phase<pg8::EpiBf16<0>, pg8::StaticOrder, true, true>(ring, g, S, E); }
        { pg8::Gemm g{(const bf16*)(ws + WS_MEMB), (const bf16*)(ws + WS_W_MKV), BATCH * NMEM, 1024, D, D, D}; pg8::StaticOrder S; S.init(BATCH * NMEM, 1024, c.G, bx);
          pg8::EpiBf16<0> E{(bf16*)(ws + WS_KVMEM), 1024, nullptr, 0, 0, 1.f}; pg8::gemm_phase<pg8::EpiBf16<0>, pg8::StaticOrder, true, true>(ring, g, S, E); }
    } SEAM(1);
    if (IN(2)) { ph_rowprep(args, c); } SEAM(2);
    if (IN(3)) {
        { pg8::Gemm g{(const bf16*)(ws + WS_CKVN), (const bf16*)(ws + WS_W_UKV), NTOK, 4096, 512, 512, 512}; pg8::StaticOrder S; S.init(NTOK, 4096, c.G, bx);
          pg8::EpiBf16<0> E{(bf16*)(ws + WS_KVUP), 4096, nullptr, 0, 0, 1.f}; pg8::gemm_phase<pg8::EpiBf16<0>, pg8::StaticOrder, true, true>(ring, g, S, E); }
        { const int kv = (bx >> 2) & 1; OneUnit S{bx & 3, 0, bx < 8};
          pg8::Gemm g{(const bf16*)(ws + (kv ? WS_CMPA_V : WS_CMPA_K)), (const bf16*)(ws + (kv ? WS_W_C1V : WS_W_C1K)), 1024, 256, 4096, 2048, 4096};
          pg8::EpiF32 E{(float*)(ws + WS_H1) + (size_t)kv * 1024 * 256, 256, nullptr}; pg8::gemm_phase<pg8::EpiF32, OneUnit, false, true>(ring, g, S, E); }
    } SEAM(3);
    if (IN(4)) { ph_cmp2(args, c); } SEAM(4);
    if (IN(5)) { ph_nsa_fa(args, c); } SEAM(5);
    if (IN(6)) { ph_mla_fa(args, c); } SEAM(6);
    if (IN(7)) {
        { pg8::Gemm g{(const bf16*)(ws + WS_ONSA), (const bf16*)(ws + WS_W_BN), NTOK, D, D, D, D}; pg8::StaticOrder S; S.init(NTOK, D, c.G, bx);
          pg8::EpiBf16<0> E{(bf16*)(ws + WS_YN), D, nullptr, 0, 0, 1.f}; pg8::gemm_phase<pg8::EpiBf16<0>, pg8::StaticOrder, true, true>(ring, g, S, E); }
        { pg8::Gemm g{(const bf16*)(ws + WS_OMLA), (const bf16*)(ws + WS_W_BM), NTOK, D, D, D, D}; pg8::StaticOrder S; S.init(NTOK, D, c.G, bx);
          pg8::EpiBf16<0> E{(bf16*)(ws + WS_YM), D, nullptr, 0, 0, 1.f}; pg8::gemm_phase<pg8::EpiBf16<0>, pg8::StaticOrder, true, true>(ring, g, S, E); }
    } SEAM(7);
    if (IN(8)) { ph_merge(args, c); } SEAM(8);
    if (IN(9)) { pg8::Gemm g{(const bf16*)(ws + WS_MERGED), (const bf16*)(ws + WS_W_MO), NTOK, D, D, D, D}; pg8::StaticOrder S; S.init(NTOK, D, c.G, bx);
        pg8::EpiF32 E{(float*)(ws + WS_Z), D, nullptr}; pg8::gemm_phase<pg8::EpiF32, pg8::StaticOrder, true, true>(ring, g, S, E); } SEAM(9);
    if (IN(10)) { ph_ln(c, args.in[I_X], (const float*)(ws + WS_Z), args.in[I_LN1G], args.in[I_LN1B], (float*)(ws + WS_X1), (bf16*)(ws + WS_X1B)); } SEAM(10);
    if (IN(11)) { pg8::Gemm g{(const bf16*)(ws + WS_X1B), (const bf16*)(ws + WS_W_MQ), NTOK, 512, D, D, D}; pg8::StaticOrder S; S.init(NTOK, 512, c.G, bx);
        pg8::EpiBf16<0> E{(bf16*)(ws + WS_QMEM), 512, nullptr, 0, 0, 1.f}; pg8::gemm_phase<pg8::EpiBf16<0>, pg8::StaticOrder, true, true>(ring, g, S, E);
        if (c.G > 64) { if (bx >= 64) peer_convert(args, (bx - 64) * NWAVES + c.wave, (c.G - 64) * NWAVES, c.lane); } else peer_convert(args, c.gw, c.ngw, c.lane); } SEAM(11);
    if (IN(12)) { ph_memattn(args, c); } SEAM(12);
    if (IN(13)) { pg8::Gemm g{(const bf16*)(ws + WS_OMEM), (const bf16*)(ws + WS_W_MO2), NTOK, D, 512, 512, 512}; pg8::StaticOrder S; S.init(NTOK, D, c.G, bx);
        pg8::EpiF32 E{(float*)(ws + WS_Z), D, nullptr}; pg8::gemm_phase<pg8::EpiF32, pg8::StaticOrder, true, true>(ring, g, S, E); } SEAM(13);
    if (IN(14)) { ph_ln(c, (const float*)(ws + WS_X1), (const float*)(ws + WS_Z), args.in[I_LN2G], args.in[I_LN2B], (float*)(ws + WS_X2), (bf16*)(ws + WS_X2B)); } SEAM(14);
    if (IN(15)) { pg8::Gemm g{(const bf16*)(ws + WS_X2B), (const bf16*)(ws + WS_W_PQ), NTOK, D, D, D, D}; pg8::StaticOrder S; S.init(NTOK, D, c.G, bx);
        pg8::EpiBf16<0> E{(bf16*)(ws + WS_PQB), D, nullptr, 0, 0, 1.f}; pg8::gemm_phase<pg8::EpiBf16<0>, pg8::StaticOrder, true, true>(ring, g, S, E); } SEAM(15);
    if (IN(16)) {
        pg8::Gemm g{(const bf16*)(ws + WS_PQB), (const bf16*)(ws + WS_KEYB), NTOK * 8, 256, 256, 256, 256}; pg8::StaticOrder S; S.init(NTOK * 8, 256, c.G, bx);
        pg8::EpiF32 E{(float*)(ws + WS_S), 256, nullptr}; pg8::gemm_phase<pg8::EpiF32, pg8::StaticOrder, true, true>(ring, g, S, E); } SEAM(16);
    if (IN(17)) { ph_peer_select2(args, c); } SEAM(17);
    if (IN(18)) { ph_peer_ffn(args, c); }
#undef IN
#undef SEAM
}

extern "C" void kernel_launch(void* const* d_in, const int* in_sizes, int n_in, void* d_out, int out_size, void* d_ws, size_t ws_size, hipStream_t stream) {
    static int grid = 0;
    if (grid == 0) {
        if (n_in != N_IN || in_sizes[0] != NTOK * D || out_size != NTOK * D || ws_size < WS_END) { fprintf(stderr, "kernel_launch: unexpected shapes (n_in %d, in0 %d, out %d, ws %zu)\n", n_in, n_in > 0 ? in_sizes[0] : -1, out_size, ws_size); grid = -1; return; }
        int dev = 0, cus = 0, per_cu = 0;
        if (hipGetDevice(&dev) != hipSuccess || hipDeviceGetAttribute(&cus, hipDeviceAttributeMultiprocessorCount, dev) != hipSuccess) { grid = -1; return; }
        if (hipFuncSetAttribute((const void*)fwd, hipFuncAttributeMaxDynamicSharedMemorySize, LDS_BYTES) != hipSuccess) { fprintf(stderr, "kernel_launch: hipFuncSetAttribute failed\n"); grid = -1; return; }
        if (hipOccupancyMaxActiveBlocksPerMultiprocessor(&per_cu, (const void*)fwd, NTHREADS, LDS_BYTES) != hipSuccess || per_cu < 1) fprintf(stderr, "kernel_launch: occupancy query reports %d\n", per_cu);
        (void)hipGetLastError();
        grid = cus;
    }
    if (grid < 0) return;
    (void)hipMemsetAsync((char*)d_ws + WS_CTL, 0, CTL_ZERO_BYTES, stream);
    Args a{};
    for (int i = 0; i < N_IN; ++i) a.in[i] = (const float*)d_in[i];
    a.out = (float*)d_out; a.ws = (unsigned char*)d_ws;
    if (N_LAUNCHES == 1) { a.ph_lo = 0; a.ph_hi = N_PHASES; hipLaunchKernelGGL(fwd, dim3(grid), dim3(NTHREADS), LDS_BYTES, stream, a); }
    else for (int p = 0; p < N_PHASES; ++p) { a.ph_lo = p; a.ph_hi = p + 1; hipLaunchKernelGGL(fwd, dim3(grid), dim3(NTHREADS), LDS_BYTES, stream, a); }
    const hipError_t le = hipPeekAtLastError();
    if (le != hipSuccess) fprintf(stderr, "kernel_launch: launch failed: %s\n", hipGetErrorName(le));
}
```

```cpp
#include <hip/hip_runtime.h>
#include <cstdio>
#include <cstdint>
#ifndef N_LAUNCHES
#define N_LAUNCHES 1
#endif
namespace pg8 {
#define PG8_LAS __attribute__((address_space(3)))
typedef unsigned short bf16_t;
typedef short bf16x8 __attribute__((ext_vector_type(8)));
typedef float f32x4 __attribute__((ext_vector_type(4)));
typedef unsigned u32x4 __attribute__((ext_vector_type(4)));
constexpr int BM = 256, BK = 64, HALF = 128, HTB = HALF * BK * 2  , STAGE_BYTES = 8 * HTB, NXCD = 8, WGM = 8;

__host__ __device__ __forceinline__ int lds_byte(int r, int c) { const int st = (r >> 4) * 2 + (c >> 5), rr = r & 15, cc = c & 31, ob = rr * 64 + cc * 2; return st * 1024 + (ob ^ (((ob >> 9) & 1) << 5)); }
__host__ __device__ __forceinline__ void stage_rc(int b, int& R, int& C) { const int st = b / 1024, sb = b % 1024, swz = sb ^ (((sb >> 9) & 1) << 5); R = (st >> 1) * 16 + swz / 64; C = (st & 1) * 32 + (swz % 64) / 2; }
__host__ __device__ __forceinline__ int perm32(int rho) { const int n = rho >> 4, i = rho & 15; return 8 * (i >> 2) + 4 * n + (i & 3); }

struct Unit { int pm, pn; };
struct Gemm { const bf16_t* A; const bf16_t* Bt; int M, N, K, lda, ldb; };

struct StaticOrder {
    int nM, nN, nwg, G, c;
    __host__ __device__ void init(int M, int N, int G_, int c_) { nM = M / BM; nN = N / BM; nwg = nM * nN; G = G_; c = c_; }
    __host__ __device__ bool next(int i, Unit& u) const {
        const long L = (long)i * G + c; if (L >= nwg) return false;
        int wgid = (int)L; { const int q = nwg / NXCD, r = nwg % NXCD, xcd = wgid % NXCD, off = wgid / NXCD; wgid = (xcd < r ? xcd * (q + 1) : r * (q + 1) + (xcd - r) * q) + off; }
        const int nig = WGM * nN, gid = wgid / nig, fm = gid * WGM, gsz = (nM - fm) < WGM ? (nM - fm) : WGM;
        u.pm = fm + ((wgid % nig) % gsz); u.pn = (wgid % nig) / gsz; return true;
    }
    __device__ __forceinline__ void a_ready(const Unit&) const {}
    __device__ __forceinline__ void done(const Unit&) const {}
};

__device__ __forceinline__ unsigned cvt_pk_bf16(float lo, float hi) { unsigned r; asm volatile("v_cvt_pk_bf16_f32 %0, %1, %2" : "=v"(r) : "v"(lo), "v"(hi)); return r; }
typedef float f32x2 __attribute__((ext_vector_type(2)));
__device__ __forceinline__ f32x2 gelu_pk(f32x2 v) {
    const f32x2 av = __builtin_elementwise_abs(v), d = av * 0.2316418882f + 1.0f;
    f32x2 t; t.x = __builtin_amdgcn_rcpf(d.x); t.y = __builtin_amdgcn_rcpf(d.y);
    f32x2 q = t * 0.5307027145f + (-0.7265760135f); q = q * t + 0.7107068705f; q = q * t + (-0.142248368f); q = q * t + 0.127414796f; q = q * t;
    const f32x2 s = (v * v) * (-0.72134752044f);
    f32x2 e; e.x = __builtin_amdgcn_exp2f(s.x); e.y = __builtin_amdgcn_exp2f(s.y);
    const f32x2 m = v * (q * e), r = v - m;
    f32x2 o; o.x = v.x < 0.f ? m.x : r.x; o.y = v.y < 0.f ? m.y : r.y; return o;
}

template <int ACT  > struct EpiBf16 {
    static constexpr bool PERM = true, AFTER_DRAIN = false; static_assert(ACT == 0 || ACT == 1, "EpiBf16: ACT is 0 (none) or 1 (gelu_pk)");
    bf16_t* O; int ldc; const float* bias; int split_cols; size_t split_stride; float scale0;
    __device__ __forceinline__ void operator()(const f32x4 (&acc)[2][2][4][2], const Unit& u, int wr, int wc, int fr, int fq) const {
        const int row0 = u.pm * BM + wr * 64 + fr; int colt = u.pn * BM; bf16_t* base = O;
        float sc = 1.f; if (split_cols) { const int t = colt / split_cols; base += (size_t)t * split_stride; colt -= t * split_cols; if (t == 0) sc = scale0; }
        const int col0 = colt + wc * 32 + 8 * fq, bcol0 = u.pn * BM + wc * 32 + 8 * fq;
        f32x4 bv[2][2];
#pragma unroll
        for (int bj = 0; bj < 2; ++bj)
#pragma unroll
            for (int n = 0; n < 2; ++n) bv[bj][n] = bias ? *(const f32x4*)(bias + bcol0 + bj * HALF + 4 * n) : (f32x4){0.f, 0.f, 0.f, 0.f};
#pragma unroll
        for (int ai = 0; ai < 2; ++ai)
#pragma unroll
            for (int m = 0; m < 4; ++m) { bf16_t* rowp = base + (size_t)(row0 + ai * HALF + m * 16) * ldc + col0;
#pragma unroll
                for (int bj = 0; bj < 2; ++bj) { f32x4 v0 = acc[ai][bj][m][0] + bv[bj][0], v1 = acc[ai][bj][m][1] + bv[bj][1];
                    if (ACT == 1) { f32x2 a = gelu_pk((f32x2){v0[0], v0[1]}), b = gelu_pk((f32x2){v0[2], v0[3]}), c = gelu_pk((f32x2){v1[0], v1[1]}), d = gelu_pk((f32x2){v1[2], v1[3]});
                        v0 = (f32x4){a.x, a.y, b.x, b.y}; v1 = (f32x4){c.x, c.y, d.x, d.y}; }
                    v0 = v0 * sc; v1 = v1 * sc; u32x4 w; w.x = cvt_pk_bf16(v0[0], v0[1]); w.y = cvt_pk_bf16(v0[2], v0[3]); w.z = cvt_pk_bf16(v1[0], v1[1]); w.w = cvt_pk_bf16(v1[2], v1[3]);
                    *(u32x4*)(rowp + bj * HALF) = w; } }
    }
};
struct EpiF32 {
    static constexpr bool PERM = false, AFTER_DRAIN = false;
    float* C; int ldc; const float* bias;
    __device__ __forceinline__ void operator()(const f32x4 (&acc)[2][2][4][2], const Unit& u, int wr, int wc, int fr, int fq) const {
        const int row0 = u.pm * BM + wr * 64 + fr, col0 = u.pn * BM + wc * 32 + 4 * fq;
        f32x4 bv[2][2];
#pragma unroll
        for (int bj = 0; bj < 2; ++bj)
#pragma unroll
            for (int n = 0; n < 2; ++n) bv[bj][n] = bias ? *(const f32x4*)(bias + col0 + bj * HALF + n * 16) : (f32x4){0.f, 0.f, 0.f, 0.f};
#pragma unroll
        for (int ai = 0; ai < 2; ++ai)
#pragma unroll
            for (int m = 0; m < 4; ++m) { float* rowp = C + (size_t)(row0 + ai * HALF + m * 16) * ldc + col0;
#pragma unroll
                for (int bj = 0; bj < 2; ++bj)
#pragma unroll
                    for (int n = 0; n < 2; ++n) *(f32x4*)(rowp + bj * HALF + n * 16) = acc[ai][bj][m][n] + bv[bj][n]; }
    }
};
template <class Epi, class Sched, bool ALIGN_EPI = false, bool SP2 = false>
__device__ __forceinline__ void gemm_phase(PG8_LAS unsigned char* lds, const Gemm g, const Sched& S, const Epi& E) {
    const int tid = threadIdx.x, wid = __builtin_amdgcn_readfirstlane(tid >> 6), lane = tid & 63, wr = wid >> 2, wc = wid & 3, fr = lane & 15, fq = lane >> 4;
    const int K = g.K, nt = K / BK;
    unsigned voffA[2], voffB[2];
#pragma unroll
    for (int i = 0; i < 2; ++i) { int R, C; stage_rc(tid * 16 + i * 8192, R, C); const int Rb = Epi::PERM ? ((R & ~31) + perm32(R & 31)) : R;
        voffA[i] = (unsigned)(R * g.lda + C) * 2u; voffB[i] = (unsigned)(Rb * g.ldb + C) * 2u; }
    const size_t kstep = (size_t)(BK * 2);
    const size_t hstepA = (size_t)HALF * g.lda * 2, hstepB = (size_t)HALF * g.ldb * 2;
    const size_t tstepA = 2 * hstepA, tstepB = 2 * hstepB;
    const unsigned ldsw = (unsigned)wid * 1024u;
    const int aoff = lds_byte(wr * 64 + fr, fq * 8), boff = lds_byte(wc * 32 + fr, fq * 8);
#define PG8_SA(b, h) (((b) * 2 + (h)) * HTB)
#define PG8_SB(b, h) ((4 + (b) * 2 + (h)) * HTB)
#define PG8_STAGE(bufoff, gbase, voff) do { _Pragma("unroll") for (int _i = 0; _i < 2; ++_i) \
        __builtin_amdgcn_global_load_lds((const unsigned*)((const char*)(gbase) + (voff)[_i]), (PG8_LAS unsigned*)(lds + (bufoff) + ldsw + _i * 8192), 16, 0, 0); } while (0)
#define PG8_LDA(dst, b, h) do { _Pragma("unroll") for (int m = 0; m < 4; ++m) _Pragma("unroll") for (int k = 0; k < 2; ++k) dst[m][k] = *(const PG8_LAS bf16x8*)(lds + PG8_SA(b, h) + aoff + m * 2048 + k * 1024); } while (0)
#define PG8_LDB(dst, b, h) do { _Pragma("unroll") for (int n = 0; n < 2; ++n) _Pragma("unroll") for (int k = 0; k < 2; ++k) dst[n][k] = *(const PG8_LAS bf16x8*)(lds + PG8_SB(b, h) + boff + n * 2048 + k * 1024); } while (0)
#define PG8_MMA(ai, bj, At, Bt) do { __builtin_amdgcn_s_setprio(1); _Pragma("unroll") for (int m = 0; m < 4; ++m) _Pragma("unroll") for (int n = 0; n < 2; ++n) _Pragma("unroll") for (int k = 0; k < 2; ++k) \
        acc[ai][bj][m][n] = __builtin_amdgcn_mfma_f32_16x16x32_bf16(Bt[n][k], At[m][k], acc[ai][bj][m][n], 0, 0, 0); __builtin_amdgcn_s_setprio(0); } while (0)
#define PG8_WAIT_V(n) asm volatile("s_waitcnt vmcnt(" #n ")" ::: "memory")
#define PG8_WAIT_L(n) asm volatile("s_waitcnt lgkmcnt(" #n ")" ::: "memory")
#define PG8_BAR __builtin_amdgcn_s_barrier()
#define PG8_SCHED __builtin_amdgcn_sched_barrier(0)
    Unit cur, nxt; int ui = 0;
    if (!S.next(0, cur)) return;
    f32x4 acc[2][2][4][2];
#pragma unroll
    for (int a = 0; a < 2; ++a)
#pragma unroll
        for (int b = 0; b < 2; ++b)
#pragma unroll
            for (int m = 0; m < 4; ++m)
#pragma unroll
                for (int n = 0; n < 2; ++n) acc[a][b][m][n] = (f32x4){0.f, 0.f, 0.f, 0.f};
    bf16x8 At[4][2], B0[2][2], B1[2][2];
    const char* cA = (const char*)g.A + (size_t)cur.pm * tstepA; const char* cB = (const char*)g.Bt + (size_t)cur.pn * tstepB;
    S.a_ready(cur);
    if constexpr (SP2) {
        PG8_STAGE(PG8_SB(0, 0), cB, voffB); PG8_STAGE(PG8_SB(0, 1), cB + hstepB, voffB); PG8_STAGE(PG8_SA(0, 0), cA, voffA); PG8_STAGE(PG8_SA(0, 1), cA + hstepA, voffA);
        if (wr == 1) PG8_BAR;
        PG8_WAIT_V(2); PG8_BAR;
        PG8_STAGE(PG8_SB(1, 0), cB + kstep, voffB); PG8_STAGE(PG8_SA(1, 0), cA + kstep, voffA); PG8_STAGE(PG8_SB(1, 1), cB + hstepB + kstep, voffB);
        PG8_WAIT_V(6); PG8_BAR;
    } else {
        PG8_STAGE(PG8_SB(0, 0), cB, voffB); PG8_STAGE(PG8_SA(0, 0), cA, voffA); PG8_STAGE(PG8_SB(0, 1), cB + hstepB, voffB); PG8_STAGE(PG8_SA(0, 1), cA + hstepA, voffA);
        if (wr == 1) PG8_BAR;
        PG8_WAIT_V(4); PG8_BAR;
        PG8_STAGE(PG8_SB(1, 0), cB + kstep, voffB); PG8_STAGE(PG8_SA(1, 0), cA + kstep, voffA); PG8_STAGE(PG8_SB(1, 1), cB + hstepB + kstep, voffB);
        PG8_WAIT_V(6); PG8_BAR;
    }
    for (;;) {
        const bool has_next = S.next(ui + 1, nxt);
        const char* nA = has_next ? (const char*)g.A + (size_t)nxt.pm * tstepA : cA; const char* nB = has_next ? (const char*)g.Bt + (size_t)nxt.pn * tstepB : cB;
        for (int t = 0; t < nt; t += 2) {
            const bool last = (t == nt - 2);
            const char* a1 = cA + (size_t)(t + 1) * kstep;
            const char* a2 = last ? nA : cA + (size_t)(t + 2) * kstep; const char* b2 = last ? nB : cB + (size_t)(t + 2) * kstep;
            const char* a3 = a2 + kstep; const char* b3 = b2 + kstep;
            if (last && has_next) S.a_ready(nxt);
            if constexpr (SP2) {
            PG8_LDB(B0, 0, 0); PG8_LDB(B1, 0, 1); PG8_SCHED; PG8_LDA(At, 0, 0); PG8_STAGE(PG8_SA(1, 1), a1 + hstepA, voffA);
            PG8_WAIT_V(8); PG8_WAIT_L(0); PG8_BAR; PG8_MMA(0, 0, At, B0); PG8_MMA(0, 1, At, B1); PG8_BAR; PG8_SCHED;
            PG8_LDA(At, 0, 1); PG8_STAGE(PG8_SB(0, 0), b2, voffB); PG8_STAGE(PG8_SB(0, 1), b2 + hstepB, voffB); PG8_STAGE(PG8_SA(0, 0), a2, voffA);
            PG8_WAIT_V(8); PG8_WAIT_L(0); PG8_BAR; PG8_MMA(1, 0, At, B0); PG8_MMA(1, 1, At, B1); PG8_BAR; PG8_SCHED;
            PG8_LDB(B0, 1, 0); PG8_LDB(B1, 1, 1); PG8_SCHED; PG8_LDA(At, 1, 0); PG8_STAGE(PG8_SA(0, 1), a2 + hstepA, voffA);
            PG8_WAIT_V(8); PG8_WAIT_L(0); PG8_BAR; PG8_MMA(0, 0, At, B0); PG8_MMA(0, 1, At, B1); PG8_BAR; PG8_SCHED;
            PG8_LDA(At, 1, 1); PG8_STAGE(PG8_SB(1, 0), b3, voffB); PG8_STAGE(PG8_SB(1, 1), b3 + hstepB, voffB); PG8_STAGE(PG8_SA(1, 0), a3, voffA);
            PG8_WAIT_V(8); PG8_WAIT_L(0); PG8_BAR; PG8_MMA(1, 0, At, B0); PG8_MMA(1, 1, At, B1); PG8_BAR; PG8_SCHED;
            } else {
            PG8_LDB(B0, 0, 0); PG8_SCHED; PG8_LDA(At, 0, 0); PG8_STAGE(PG8_SA(1, 1), a1 + hstepA, voffA);
            PG8_WAIT_L(8); PG8_BAR; PG8_WAIT_L(0); PG8_MMA(0, 0, At, B0); PG8_BAR; PG8_SCHED;
            PG8_LDB(B1, 0, 1); PG8_STAGE(PG8_SB(0, 0), b2, voffB);
            PG8_BAR; PG8_WAIT_L(0); PG8_MMA(0, 1, At, B1); PG8_BAR;
            PG8_LDA(At, 0, 1); PG8_STAGE(PG8_SA(0, 0), a2, voffA);
            PG8_BAR; PG8_WAIT_L(0); PG8_MMA(1, 0, At, B0); PG8_BAR; PG8_SCHED;
            PG8_STAGE(PG8_SB(0, 1), b2 + hstepB, voffB);
            PG8_WAIT_V(6); PG8_BAR; PG8_MMA(1, 1, At, B1); PG8_BAR;
            PG8_LDB(B0, 1, 0); PG8_SCHED; PG8_LDA(At, 1, 0); PG8_STAGE(PG8_SA(0, 1), a2 + hstepA, voffA);
            PG8_WAIT_L(8); PG8_BAR; PG8_WAIT_L(0); PG8_MMA(0, 0, At, B0); PG8_BAR; PG8_SCHED;
            PG8_LDB(B1, 1, 1); PG8_STAGE(PG8_SB(1, 0), b3, voffB);
            PG8_BAR; PG8_WAIT_L(0); PG8_MMA(0, 1, At, B1); PG8_BAR;
            PG8_LDA(At, 1, 1); PG8_STAGE(PG8_SA(1, 0), a3, voffA);
            PG8_BAR; PG8_WAIT_L(0); PG8_MMA(1, 0, At, B0); PG8_BAR; PG8_SCHED;
            PG8_STAGE(PG8_SB(1, 1), b3 + hstepB, voffB);
            PG8_WAIT_V(6); PG8_BAR; PG8_MMA(1, 1, At, B1); PG8_BAR;
            }
        }
        if constexpr (ALIGN_EPI) { if (wr == 0) PG8_BAR; }
        if constexpr (!Epi::AFTER_DRAIN) { E(acc, cur, wr, wc, fr, fq); S.done(cur); }
        if (!has_next) break;
#pragma unroll
        for (int a = 0; a < 2; ++a)
#pragma unroll
            for (int b = 0; b < 2; ++b)
#pragma unroll
                for (int m = 0; m < 4; ++m)
#pragma unroll
                    for (int n = 0; n < 2; ++n) acc[a][b][m][n] = (f32x4){0.f, 0.f, 0.f, 0.f};
        cur = nxt; cA = nA; cB = nB; ++ui;
        if constexpr (ALIGN_EPI) { if (wr == 1) PG8_BAR; }
    }
    PG8_WAIT_V(0);
    if constexpr (!ALIGN_EPI) { if (wr == 0) PG8_BAR; }
    PG8_BAR;
    if constexpr (Epi::AFTER_DRAIN) { E.fused(acc, cur, wr, wc, fr, fq, lds, wid, lane); S.done(cur); }
#undef PG8_SA
#undef PG8_SB
#undef PG8_STAGE
#undef PG8_LDA
#undef PG8_LDB
#undef PG8_MMA
#undef PG8_WAIT_V
#undef PG8_WAIT_L
#undef PG8_BAR
#undef PG8_SCHED
}
}

constexpr int BATCH = 2, T = 4096, D = 2048, NTOK = BATCH * T, NMEM = 256;
constexpr int NCOMB = 11376, NCOMBP = 11520;
constexpr int OFF_NSA_KV = 2048, OFF_NSA_GATE = 3584, OFF_MLA_Q = 3632, OFF_MLA_KV = 6704, OFF_MERGE = 7280;
constexpr float ALPHA = 1.189207115002721f;
constexpr float NSA_SCALE = 0.08838834764831845f, MLA_SCALE = 0.07216878364870323f, MEM_SCALE = 0.08838834764831845f;
enum { I_X = 0, I_MEM, I_RELB, I_WIN, I_CKPE, I_CKW1, I_CKW2, I_CVPE, I_CVW1, I_CVW2, I_KVNORM, I_WUK, I_WUV, I_WBN, I_WBM, I_WMO, I_LN1G, I_LN1B,
       I_MWQ, I_MWK, I_MWV, I_MWO, I_LN2G, I_LN2B, I_PWQ, I_PKEYS, I_PU, I_PV, I_LN3G, I_LN3B, N_IN };

constexpr size_t MiB = 1u << 20;
constexpr size_t WS_CTL = 0, CTL_ZERO_BYTES = 1 * MiB;
constexpr size_t WS_W_IN = 1 * MiB, WS_W_UKV = 46 * MiB, WS_W_BN = 50 * MiB, WS_W_BM = 58 * MiB, WS_W_MO = 66 * MiB, WS_W_MQ = 74 * MiB, WS_W_MKV = 76 * MiB, WS_W_MO2 = 80 * MiB,
                 WS_W_PQ = 82 * MiB, WS_W_C1K = 90 * MiB, WS_W_C1V = 92 * MiB;
constexpr size_t WS_CVEC = 94 * MiB, WS_CVECP = 94 * MiB + 4096  , WS_KCVC = 95 * MiB, WS_H1 = 96 * MiB, WS_SEL = 98 * MiB, WS_KVMEM = 99 * MiB, WS_MEMB = 100 * MiB, WS_KPE = 102 * MiB;
constexpr size_t WS_PROJ = 106 * MiB;
constexpr size_t WS_X1 = 106 * MiB, WS_X2 = 170 * MiB, WS_X1B = 234 * MiB, WS_QMEM = 266 * MiB, WS_OMEM = 274 * MiB;
constexpr size_t WS_KVUP = 286 * MiB, WS_Z = 286 * MiB;
constexpr size_t WS_XB = 350 * MiB, WS_ONSA = 350 * MiB, WS_X2B = 350 * MiB;
constexpr size_t WS_OMLA = 382 * MiB, WS_PQ = 382 * MiB;
constexpr size_t WS_CKVN = 414 * MiB, WS_CMPA_K = 422 * MiB, WS_CMPA_V = 422 * MiB + 4 * MiB + 65536, WS_YN = 414 * MiB;
constexpr size_t WS_YM = 446 * MiB, WS_PIDX = 446 * MiB, WS_PGATE = 450 * MiB;
constexpr size_t WS_MERGED = 478 * MiB, WS_END = 512 * MiB;
constexpr size_t WS_S = 106 * MiB, WS_KEYB = 103 * MiB, WS_PQB = 382 * MiB;
constexpr int CW_BAR = 4096;

constexpr int RING_BYTES = 131072, LDSCTL_OFF = RING_BYTES, MISC_OFF = LDSCTL_OFF + 320, LDS_BYTES = 147456;
constexpr int NWAVES = 8, NTHREADS = 512;

#define LAS __attribute__((address_space(3)))
typedef unsigned short bf16;
typedef unsigned v4u __attribute__((ext_vector_type(4)));
typedef float f32x4 __attribute__((ext_vector_type(4)));
#define LDS_WAIT() asm volatile("s_waitcnt lgkmcnt(0)" ::: "memory")

__device__ __forceinline__ unsigned f2bf(float f) { unsigned u = __builtin_bit_cast(unsigned, f); return (u + 0x7fffu + ((u >> 16) & 1u)) >> 16; }
__device__ __forceinline__ unsigned pk2(float lo, float hi) { return f2bf(lo) | (f2bf(hi) << 16); }
__device__ __forceinline__ float bf2f(bf16 h) { return __builtin_bit_cast(float, (unsigned)h << 16); }
__device__ __forceinline__ float lo_bf(unsigned w) { return __builtin_bit_cast(float, w << 16); }
__device__ __forceinline__ float hi_bf(unsigned w) { return __builtin_bit_cast(float, w & 0xffff0000u); }
__device__ __forceinline__ float wave_sum(float v) {
#pragma unroll
    for (int o = 1; o < 64; o <<= 1) v += __shfl_xor(v, o);
    return v;
}
__device__ __forceinline__ float wave_max(float v) {
#pragma unroll
    for (int o = 1; o < 64; o <<= 1) v = fmaxf(v, __shfl_xor(v, o));
    return v;
}
__device__ __forceinline__ int wave_min_i(int v) {
#pragma unroll
    for (int o = 1; o < 64; o <<= 1) { const int w = __shfl_xor(v, o); v = w < v ? w : v; }
    return v;
}
__device__ __forceinline__ float sigmoidf_(float x) { return 1.f / (1.f + expf(-x)); }
__device__ __forceinline__ float sigmoid_fast(float x) { return __builtin_amdgcn_rcpf(1.f + __builtin_amdgcn_exp2f(-1.4426950408889634f * x)); }
__device__ __forceinline__ float gelu_tanh(float x) { return 0.5f * x * (1.f + tanhf(0.7978845608028654f * (x + 0.044715f * x * x * x))); }
__device__ __forceinline__ int t5_bucket(int dist) {
    if (dist < 16) return dist;
    const int b = 8 + (31 - __clz(dist * dist));
    return b < 31 ? b : 31;
}

#define XB_TMO      128
#define XB_XCNT(j)  (256  + 64 * (j))
#define XB_XSUB(j)  (1280 + 64 * (j))
#define XB_XGEN(j)  (2304 + 64 * (j))
#define XB_TOP      3328
#define XB_TOPGEN   3392
#define XCD_BAR_WORDS 3456
#define XB_SPIN_CAP (1u << 18)

__device__ __forceinline__ unsigned xb_ld(unsigned* p)              { return __hip_atomic_load(p, __ATOMIC_RELAXED, __HIP_MEMORY_SCOPE_AGENT); }
__device__ __forceinline__ unsigned xb_add(unsigned* p, unsigned v) { return __hip_atomic_fetch_add(p, v, __ATOMIC_RELAXED, __HIP_MEMORY_SCOPE_AGENT); }
__device__ __forceinline__ unsigned xb_xcc_id() { return (unsigned)__builtin_amdgcn_s_getreg((3 << 11) | 20) & 0xFu; }
#define XB_SPIN(cond, bar) do { unsigned _sp = 0; while (cond) { __builtin_amdgcn_s_sleep(1); \
    if ((++_sp & 255u) == 0u) { if (xb_ld(&(bar)[XB_TMO])) break; if (_sp > XB_SPIN_CAP) { atomicAdd(&(bar)[XB_TMO], 1u); break; } } } } while (0)

struct XcdBarrier {
    unsigned* bar; unsigned x;
    volatile LAS unsigned* st;
};

__device__ __forceinline__ XcdBarrier xcd_barrier_post(unsigned* bar, volatile LAS unsigned* st) {
    XcdBarrier b; b.bar = bar; b.x = xb_xcc_id(); b.st = st;
    if (threadIdx.x == 0) (void)xb_add(&bar[XB_XCNT(b.x)], 1u);
    return b;
}
__device__ __forceinline__ void xcd_barrier_complete(unsigned* bar, unsigned x, unsigned& nloc, unsigned& nx) {
    const unsigned G = gridDim.x * gridDim.y * gridDim.z;
    unsigned sum, cnt, mine, sp = 0u;
    for (;;) {
        sum = 0u; cnt = 0u; mine = 0u;
#pragma unroll
        for (unsigned j = 0; j < 16; ++j) { const unsigned c = xb_ld(&bar[XB_XCNT(j)]); sum += c; cnt += (c > 0u) ? 1u : 0u; mine = (j == x) ? c : mine; }
        if (sum == G) break;
        __builtin_amdgcn_s_sleep(1);
        if ((++sp & 255u) == 0u) { if (xb_ld(&bar[XB_TMO])) break; if (sp > XB_SPIN_CAP) { atomicAdd(&bar[XB_TMO], 1u); break; } }
    }
    nloc = mine > 0u ? mine : 1u; nx = cnt > 0u ? cnt : 1u;
}

__device__ __forceinline__ void xcd_barrier(const XcdBarrier& b) {
    asm volatile("s_waitcnt vmcnt(0)" ::: "memory");
    __syncthreads();
    if (threadIdx.x == 0) {
        unsigned* bar = b.bar;
        __builtin_amdgcn_s_waitcnt(0);
        unsigned nloc = b.st[0], nx = b.st[1];
        if (nloc == 0u) { xcd_barrier_complete(bar, b.x, nloc, nx); b.st[0] = nloc; b.st[1] = nx; }
        const unsigned old = xb_add(&bar[XB_XSUB(b.x)], 1u);
        const unsigned gen = old / nloc;
        if (old + 1u == (gen + 1u) * nloc) {
            __builtin_amdgcn_fence(__ATOMIC_RELEASE, "agent");
            asm volatile("s_waitcnt vmcnt(0)" ::: "memory");
            const unsigned og = xb_add(&bar[XB_TOP], 1u);
            const unsigned tg = og / nx;
            if (og + 1u == (tg + 1u) * nx) xb_add(&bar[XB_TOPGEN], 1u);
            else XB_SPIN(xb_ld(&bar[XB_TOPGEN]) == tg, bar);
            __builtin_amdgcn_fence(__ATOMIC_ACQUIRE, "agent");
            xb_add(&bar[XB_XGEN(b.x)], 1u);
            asm volatile("s_waitcnt vmcnt(0)" ::: "memory");
        } else {
            XB_SPIN(xb_ld(&bar[XB_XGEN(b.x)]) == gen, bar);
            __builtin_amdgcn_fence(__ATOMIC_ACQUIRE, "agent");
            asm volatile("s_waitcnt vmcnt(0)" ::: "memory");
        }
    }
    __syncthreads();
}

struct Args { const float* in[N_IN]; float* out; unsigned char* ws; int ph_lo, ph_hi; };
struct Ctx { LAS unsigned char* lds; int tid, lane, wave, gw, ngw, G; };


__device__ __forceinline__ unsigned fkey(float x) { const unsigned u = __float_as_uint(x); return u ^ ((unsigned)((int)u >> 31) | 0x80000000u); }
__device__ __forceinline__ float funkey(unsigned k) { return __uint_as_float((k & 0x80000000u) ? (k ^ 0x80000000u) : ~k); }
template <int CTRL> __device__ __forceinline__ unsigned dppu(unsigned v) { return (unsigned)__builtin_amdgcn_update_dpp((int)v, (int)v, CTRL, 0xF, 0xF, false); }
__device__ __forceinline__ unsigned row16_max_u(unsigned v) {
    unsigned t = dppu<0xB1>(v); v = v > t ? v : t; t = dppu<0x4E>(v); v = v > t ? v : t; t = dppu<0x141>(v); v = v > t ? v : t; t = dppu<0x140>(v); v = v > t ? v : t; return v; }
__device__ __forceinline__ float row16_sum_f(float v) {
    v += __uint_as_float(dppu<0xB1>(__float_as_uint(v))); v += __uint_as_float(dppu<0x4E>(__float_as_uint(v))); v += __uint_as_float(dppu<0x141>(__float_as_uint(v))); v += __uint_as_float(dppu<0x140>(__float_as_uint(v))); return v; }
#define PEER_CE(x, y) do { const unsigned hi_ = (x) > (y) ? (x) : (y), lo_ = (x) > (y) ? (y) : (x); (x) = hi_; (y) = lo_; } while (0)
__device__ __forceinline__ float wave_sum_u(float v) {
    v = row16_sum_f(v);
    const float s0 = __builtin_bit_cast(float, __builtin_amdgcn_readlane(__builtin_bit_cast(int, v), 0)), s1 = __builtin_bit_cast(float, __builtin_amdgcn_readlane(__builtin_bit_cast(int, v), 16));
    const float s2 = __builtin_bit_cast(float, __builtin_amdgcn_readlane(__builtin_bit_cast(int, v), 32)), s3 = __builtin_bit_cast(float, __builtin_amdgcn_readlane(__builtin_bit_cast(int, v), 48));
    return (s0 + s1) + (s2 + s3);
}
__device__ __forceinline__ int wave_sum_i(int v) {
    v += (int)dppu<0xB1>((unsigned)v); v += (int)dppu<0x4E>((unsigned)v); v += (int)dppu<0x141>((unsigned)v); v += (int)dppu<0x140>((unsigned)v);
    return (__builtin_amdgcn_readlane(v, 0) + __builtin_amdgcn_readlane(v, 16)) + (__builtin_amdgcn_readlane(v, 32) + __builtin_amdgcn_readlane(v, 48));
}
__device__ __forceinline__ float wave_max_u(float v) {
    unsigned k = row16_max_u(fkey(v));
    const unsigned a = (unsigned)__builtin_amdgcn_readlane((int)k, 0), b = (unsigned)__builtin_amdgcn_readlane((int)k, 16), c2 = (unsigned)__builtin_amdgcn_readlane((int)k, 32), d = (unsigned)__builtin_amdgcn_readlane((int)k, 48);
    const unsigned m1 = a > b ? a : b, m2 = c2 > d ? c2 : d; return funkey(m1 > m2 ? m1 : m2);
}

namespace fa {
typedef short bf16x8 __attribute__((ext_vector_type(8)));
typedef short s16x4 __attribute__((ext_vector_type(4)));
typedef float f32x16 __attribute__((ext_vector_type(16)));
#define FA_SBAR() __builtin_amdgcn_sched_barrier(0)
#define FA_VMW() asm volatile("s_waitcnt vmcnt(0)" ::: "memory")
constexpr int SHM_V = 16384, OFF_V = 0, OFF_K = 2 * SHM_V, OFF_AL = OFF_K + 2 * 24576, OFF_IMP = OFF_AL + 2048, OFF_SEL = OFF_IMP + 8448, LDS_END = OFF_SEL + 256;
static_assert(LDS_END <= RING_BYTES, "attention LDS map");
constexpr float LOG2E = 1.4426950408889634f, THR = 8.f;

__device__ __forceinline__ int v_st(int k, int c) { const int kk = (k & ~0xC) | ((k & 4) << 1) | ((k & 8) >> 1); return ((kk >> 3) * 4 + (c >> 5)) * 512 + ((kk & 7) * 32 + (c & 31)) * 2; }
__device__ __forceinline__ int v_rd_base(int lane) { return ((lane & 3) << 3) | (((lane >> 2) & 3) << 6) | (((lane >> 4) & 1) << 5) | (((lane >> 5) & 1) << 8); }
constexpr int v_rd_off(int d0, int ks, int half) { return d0 * 512 + ks * 4096 + half * 2048; }
__device__ __forceinline__ int crow(int r, int hi) { return (r & 3) + 8 * (r >> 2) + 4 * hi; }
__device__ __forceinline__ unsigned cvtpk(float lo, float hi) { unsigned r; asm volatile("v_cvt_pk_bf16_f32 %0, %1, %2" : "=v"(r) : "v"(lo), "v"(hi)); return r; }

template <int DQK> struct Geo {
    static constexpr int CPR = DQK / 8, ROWB = DQK * 2, SHM_K = 64 * ROWB, NPASS = SHM_K / 8192, NKS = DQK / 16;
    __device__ static __forceinline__ int swz(int row) { return DQK == 128 ? (row & 7) : ((row >> 1) & 7); }
    __device__ static __forceinline__ int off(int row, int chunk) { return row * ROWB + ((chunk ^ swz(row)) << 4); }
};

__device__ __forceinline__ void mask_tile(f32x16& p0, f32x16& p1, int dq, unsigned W) {
    const float NEG = -__builtin_inff();
#pragma unroll
    for (int r = 0; r < 16; ++r) { const int c = (r & 3) + 8 * (r >> 2);
        if ((unsigned)(dq - c) >= W) p0[r] = NEG;
        if ((unsigned)(dq - c - 32) >= W) p1[r] = NEG; }
}
__device__ __forceinline__ float half_max(float v) { auto rr = __builtin_amdgcn_permlane32_swap(__float_as_uint(v), __float_as_uint(v), false, false); return fmaxf(__uint_as_float(rr[0]), __uint_as_float(rr[1])); }
__device__ __forceinline__ float half_sum(float v) { auto rr = __builtin_amdgcn_permlane32_swap(__float_as_uint(v), __float_as_uint(v), false, false); return __uint_as_float(rr[0]) + __uint_as_float(rr[1]); }
__device__ __forceinline__ float row_max32(const f32x16& p0, const f32x16& p1) {
    float pmax = p0[0];
#pragma unroll
    for (int r = 1; r < 16; ++r) pmax = fmaxf(pmax, p0[r]);
#pragma unroll
    for (int r = 0; r < 16; ++r) pmax = fmaxf(pmax, p1[r]);
    return half_max(pmax);
}
__device__ __forceinline__ void partialSM(f32x16& p0, f32x16& p1, float& m_reg, float& mn, float& alpha) {
    const float pmax = row_max32(p0, p1);
    if (__builtin_expect(__all((pmax - m_reg) <= THR), 1)) { mn = m_reg; alpha = 1.f; }
    else { mn = fmaxf(m_reg, pmax); alpha = __builtin_amdgcn_exp2f((m_reg - mn) * LOG2E); m_reg = mn; }
    const float mnL = -mn * LOG2E;
#pragma unroll
    for (int r = 0; r < 16; ++r) p0[r] = fmaf(p0[r], LOG2E, mnL);
#pragma unroll
    for (int r = 0; r < 16; ++r) p1[r] = fmaf(p1[r], LOG2E, mnL);
#pragma unroll
    for (int r = 0; r < 16; ++r) p0[r] = __builtin_amdgcn_exp2f(p0[r]);
}
#define FA_PK4(P, B_, OUT) do { unsigned a0 = cvtpk(P[B_+0], P[B_+1]), a1 = cvtpk(P[B_+2], P[B_+3]);                          \
        unsigned b0 = cvtpk(P[B_+4], P[B_+5]), b1 = cvtpk(P[B_+6], P[B_+7]);                                             \
        auto r0 = __builtin_amdgcn_permlane32_swap(a0, b0, false, false); auto r1 = __builtin_amdgcn_permlane32_swap(a1, b1, false, false); \
        v4u w = {r0[0], r1[0], r0[1], r1[1]}; OUT = __builtin_bit_cast(bf16x8, w); } while (0)
__device__ __forceinline__ void finishSM(f32x16& p0, f32x16& p1, float alpha, float& l_reg, bf16x8& pa0, bf16x8& pa1, bf16x8& pa2, bf16x8& pa3) {
#pragma unroll
    for (int r = 0; r < 16; ++r) p1[r] = __builtin_amdgcn_exp2f(p1[r]);
    float ps = 0;
#pragma unroll
    for (int r = 0; r < 16; ++r) ps += p0[r];
#pragma unroll
    for (int r = 0; r < 16; ++r) ps += p1[r];
    ps = half_sum(ps);
    l_reg = l_reg * alpha + ps;
    FA_PK4(p0, 0, pa0); FA_PK4(p0, 8, pa1); FA_PK4(p1, 0, pa2); FA_PK4(p1, 8, pa3);
}
template <int DQK, int KB>
__device__ __forceinline__ void qkt(f32x16& p0, f32x16& p1, LAS const char* lds, int r32, int hi, const bf16x8 (&qr)[DQK / 16]) {
    using G = Geo<DQK>;
    p0 = f32x16{}; p1 = f32x16{};
    LAS const char* kb[4];
#pragma unroll
    for (int dd = 0; dd < 4; ++dd) kb[dd] = lds + OFF_K + KB * G::SHM_K + r32 * G::ROWB + (((2 * dd + hi) ^ G::swz(r32)) << 4);
    bf16x8 b0 = *(LAS const bf16x8*)kb[0], b1 = *(LAS const bf16x8*)(kb[0] + 32 * G::ROWB);
#pragma unroll
    for (int d0 = 0; d0 < G::NKS; ++d0) { bf16x8 n0 = b0, n1 = b1;
        if (d0 + 1 < G::NKS) { LAS const char* a = kb[(d0 + 1) & 3] + ((d0 + 1) >> 2) * 128; n0 = *(LAS const bf16x8*)a; n1 = *(LAS const bf16x8*)(a + 32 * G::ROWB); }
        p0 = __builtin_amdgcn_mfma_f32_32x32x16_bf16(b0, qr[d0], p0, 0, 0, 0);
        p1 = __builtin_amdgcn_mfma_f32_32x32x16_bf16(b1, qr[d0], p1, 0, 0, 0);
        FA_SBAR(); b0 = n0; b1 = n1; }
}
template <int VB>
__device__ __forceinline__ void pv_tile(f32x16 (&o)[4], int vb0, bf16x8 pa0, bf16x8 pa1, bf16x8 pa2, bf16x8 pa3) {
#define FA_TRRD(dst, off) asm volatile("ds_read_b64_tr_b16 %0, %1 offset:%2" : "=&v"(dst) : "v"(vb0), "i"(off) : "memory")
#define FA_PV_D0(d0) do { s16x4 l0, l1, l2, l3, h0, h1, h2, h3; constexpr int b_ = OFF_V + VB * SHM_V + v_rd_off(d0, 0, 0); \
        FA_TRRD(l0, b_); FA_TRRD(h0, b_ + 2048); FA_TRRD(l1, b_ + 4096); FA_TRRD(h1, b_ + 6144); FA_TRRD(l2, b_ + 8192); FA_TRRD(h2, b_ + 10240); FA_TRRD(l3, b_ + 12288); FA_TRRD(h3, b_ + 14336); \
        asm volatile("s_waitcnt lgkmcnt(0)" ::: "memory"); FA_SBAR(); \
        o[d0] = __builtin_amdgcn_mfma_f32_32x32x16_bf16(pa0, (bf16x8){l0[0], l0[1], l0[2], l0[3], h0[0], h0[1], h0[2], h0[3]}, o[d0], 0, 0, 0);   \
        o[d0] = __builtin_amdgcn_mfma_f32_32x32x16_bf16(pa1, (bf16x8){l1[0], l1[1], l1[2], l1[3], h1[0], h1[1], h1[2], h1[3]}, o[d0], 0, 0, 0);   \
        o[d0] = __builtin_amdgcn_mfma_f32_32x32x16_bf16(pa2, (bf16x8){l2[0], l2[1], l2[2], l2[3], h2[0], h2[1], h2[2], h2[3]}, o[d0], 0, 0, 0);   \
        o[d0] = __builtin_amdgcn_mfma_f32_32x32x16_bf16(pa3, (bf16x8){l3[0], l3[1], l3[2], l3[3], h3[0], h3[1], h3[2], h3[3]}, o[d0], 0, 0, 0); } while (0)
    FA_PV_D0(0); FA_PV_D0(1); FA_PV_D0(2); FA_PV_D0(3);
#undef FA_PV_D0
#undef FA_TRRD
}

template <int DQK, int MODE, class Pol>
__device__ __forceinline__ void attend(const Pol& P, LAS char* lds, const bf16x8 (&qr)[DQK / 16], unsigned long long tiles, f32x16 (&o)[4], float& m_reg, float& l_reg, const float il_fin, int tid, int wid, int lane) {
    using G = Geo<DQK>;
    if (tiles == 0ull) return;
    asm volatile("" : "+v"(tid), "+v"(lane));
    const int r32 = lane & 31, hi = lane >> 5;
    int koff[G::NPASS];
#pragma unroll
    for (int p = 0; p < G::NPASS; ++p) { const int L = tid + 512 * p; koff[p] = G::off(L / G::CPR, L % G::CPR); }
    const int sr = tid >> 4, sc = (tid & 15) * 8, vst0 = v_st(sr, sc), vst1 = v_st(32 + sr, sc);
    const int vb0 = (int)(unsigned)(uintptr_t)(lds) + v_rd_base(lane);
    LAS float* al_l = (LAS float*)(lds + OFF_AL) + wid * 64 + 32;
    bf16x8 sk[G::NPASS], sv0, sv1;
#define FA_ISSUE(j) do { _Pragma("unroll") for (int p_ = 0; p_ < G::NPASS; ++p_) sk[p_] = *(const bf16x8*)P.kptr(p_, (j)); \
        if (MODE != 1) { sv0 = *(const bf16x8*)P.vptr(0, (j)); sv1 = *(const bf16x8*)P.vptr(1, (j)); } } while (0)
#define FA_WRITE(bf) do { _Pragma("unroll") for (int p_ = 0; p_ < G::NPASS; ++p_) *(LAS bf16x8*)(lds + OFF_K + (bf) * G::SHM_K + koff[p_]) = sk[p_]; \
        if (MODE != 1) { *(LAS bf16x8*)(lds + OFF_V + (bf) * SHM_V + vst0) = sv0; *(LAS bf16x8*)(lds + OFF_V + (bf) * SHM_V + vst1) = sv1; } } while (0)
    int j = __builtin_ctzll(tiles); tiles &= tiles - 1;
    FA_ISSUE(j); FA_VMW(); FA_WRITE(0); __syncthreads();
#define FA_STEP(BF) do { \
        const int jn = tiles ? __builtin_ctzll(tiles) : -1; tiles &= tiles - 1; \
        if (jn >= 0) FA_ISSUE(jn); \
        FA_SBAR(); \
        if (P.act(j)) { f32x16 p0, p1; bf16x8 pa0, pa1, pa2, pa3; \
            qkt<DQK, BF>(p0, p1, lds, r32, hi, qr); \
            P.mod(p0, p1, j); \
            if (MODE == 0) { float mn, alpha; partialSM(p0, p1, m_reg, mn, alpha); \
                if (__any(alpha < 1.f)) { if (hi == 0) al_l[r32] = alpha; LDS_WAIT(); \
                    _Pragma("unroll") for (int d_ = 0; d_ < 4; ++d_) _Pragma("unroll") for (int r = 0; r < 16; ++r) o[d_][r] *= al_l[crow(r, hi)]; } \
                finishSM(p0, p1, alpha, l_reg, pa0, pa1, pa2, pa3); FA_SBAR(); \
                pv_tile<BF>(o, vb0, pa0, pa1, pa2, pa3); } \
            else if (MODE == 1) { const float pmax = row_max32(p0, p1), mn = fmaxf(m_reg, pmax), mnL = -mn * LOG2E; float ps = 0.f; \
                _Pragma("unroll") for (int r = 0; r < 16; ++r) ps += __builtin_amdgcn_exp2f(fmaf(p0[r], LOG2E, mnL)) + __builtin_amdgcn_exp2f(fmaf(p1[r], LOG2E, mnL)); \
                l_reg = l_reg * __builtin_amdgcn_exp2f((m_reg - mn) * LOG2E) + half_sum(ps); m_reg = mn; } \
            else { const float mnL = -m_reg * LOG2E; \
                _Pragma("unroll") for (int r = 0; r < 16; ++r) { p0[r] = __builtin_amdgcn_exp2f(fmaf(p0[r], LOG2E, mnL)) * il_fin; p1[r] = __builtin_amdgcn_exp2f(fmaf(p1[r], LOG2E, mnL)) * il_fin; } \
                P.post(p0, p1, j); \
                FA_PK4(p0, 0, pa0); FA_PK4(p0, 8, pa1); FA_PK4(p1, 0, pa2); FA_PK4(p1, 8, pa3); FA_SBAR(); \
                pv_tile<BF>(o, vb0, pa0, pa1, pa2, pa3); } } \
        FA_SBAR(); \
        if (jn >= 0) { FA_VMW(); FA_WRITE((BF) ^ 1); } \
        __syncthreads(); j = jn; } while (0)
    for (;;) { FA_STEP(0); if (j < 0) break; FA_STEP(1); if (j < 0) break; }
#undef FA_STEP
#undef FA_ISSUE
#undef FA_WRITE
}

__device__ __forceinline__ void scale_rows(f32x16 (&o)[4], float fac, LAS char* lds, int wid, int r32, int hi) {
    LAS float* li_l = (LAS float*)(lds + OFF_AL) + wid * 64;
    if (hi == 0) li_l[r32] = fac;
    LDS_WAIT();
#pragma unroll
    for (int r = 0; r < 16; ++r) { const float f = li_l[crow(r, hi)];
#pragma unroll
        for (int d0 = 0; d0 < 4; ++d0) o[d0][r] *= f; }
    LDS_WAIT();
}
__device__ __forceinline__ void store_bf16(const f32x16 (&o)[4], bf16* O, size_t ldo, int r32, int hi) {
#pragma unroll
    for (int r = 0; r < 16; ++r) { const int orow = crow(r, hi);
#pragma unroll
        for (int d0 = 0; d0 < 4; ++d0) { const float v = o[d0][r]; const float vn = __shfl_xor(v, 1);
            if ((r32 & 1) == 0) *(unsigned*)(O + (size_t)orow * ldo + d0 * 32 + r32) = cvtpk(v, vn); } }
}
}

struct MlaPol {
    const bf16* kp[3]; long kst[3]; const bf16* vp[2]; int qlo, qm;
    __device__ __forceinline__ const bf16* kptr(int p, int j) const { return kp[p] + (long)j * kst[p]; }
    __device__ __forceinline__ const bf16* vptr(int i, int j) const { return vp[i] + (long)j * (64 * 4096); }
    __device__ __forceinline__ bool act(int j) const { return 64 * j <= qlo + 31; }
    __device__ __forceinline__ void mod(fa::f32x16& p0, fa::f32x16& p1, int j) const { if (64 * j + 63 > qlo) fa::mask_tile(p0, p1, qm - 64 * j, 0x7fffffffu); }
    __device__ __forceinline__ void post(fa::f32x16&, fa::f32x16&, int) const {}
};
__device__ __forceinline__ void ph_mla_fa(const Args& a, const Ctx& c) {
    unsigned char* ws = a.ws; const bf16* PROJ = (const bf16*)(ws + WS_PROJ); const bf16* KVUP = (const bf16*)(ws + WS_KVUP); const bf16* KPE = (const bf16*)(ws + WS_KPE);
    bf16* OMLA = (bf16*)(ws + WS_OMLA); const int tid = c.tid, lane = c.lane, wid = c.wave, r32 = lane & 31, hi = lane >> 5;
    for (int item = blockIdx.x; item < BATCH * 16 * 8; item += c.G) {
        const int pr = item & 7, h = (item >> 3) & 15, b = item >> 7;
        for (int pass = 0; pass < 2; ++pass) { const int qb = pass ? 15 - pr : pr, q0 = 256 * qb;
            MlaPol P;
#pragma unroll
            for (int p = 0; p < 3; ++p) { const int L = tid + 512 * p, row = L / 24, ch = L % 24;
                if (ch < 16) { P.kp[p] = KVUP + (size_t)(b * T + row) * 4096 + h * 128 + ch * 8; P.kst[p] = 64 * 4096; }
                else { P.kp[p] = KPE + (size_t)(b * T + row) * 64 + (ch - 16) * 8; P.kst[p] = 64 * 64; } }
            { const int sr = tid >> 4, sc = (tid & 15) * 8; P.vp[0] = KVUP + (size_t)(b * T + sr) * 4096 + 2048 + h * 128 + sc; P.vp[1] = P.vp[0] + (size_t)32 * 4096; }
            P.qlo = q0 + 32 * wid; P.qm = P.qlo + r32 - 4 * hi;
            fa::bf16x8 qr[12]; const bf16* q = PROJ + (size_t)(b * T + P.qlo + r32) * NCOMBP + OFF_MLA_Q + h * 192 + hi * 8;
#pragma unroll
            for (int d0 = 0; d0 < 12; ++d0) qr[d0] = *(const fa::bf16x8*)(q + d0 * 16);
            fa::f32x16 o[4] = {}; float m_reg = -1e30f, l_reg = 0.f;
            const unsigned long long tiles = (2ull << (4 * qb + 3)) - 1ull;
            fa::attend<192, 0>(P, (LAS char*)c.lds, qr, tiles, o, m_reg, l_reg, 0.f, tid, wid, lane);
            fa::scale_rows(o, l_reg > 0.f ? 1.f / l_reg : 0.f, (LAS char*)c.lds, wid, r32, hi);
            fa::store_bf16(o, OMLA + (size_t)(b * T + P.qlo) * D + h * 128, D, r32, hi);
        }
    }
}

constexpr size_t WS_KCB = WS_SEL + 512 * 1024;
constexpr size_t WS_OACC = 446 * MiB;
constexpr int IMP_LD = 65;
__device__ __forceinline__ float t5_bias(float tab, int dist) {
    const int sq = dist * dist, lg = 39 - __clz(sq), b = dist < 16 ? dist : (lg < 31 ? lg : 31);
    return __builtin_bit_cast(float, __builtin_amdgcn_ds_bpermute(b << 2, __builtin_bit_cast(int, tab)));
}
struct NsaSrc { const bf16* kp[2]; const bf16* vp[2]; long kst, vst; };
struct CmpPol { NsaSrc s; int dq0; float tab; LAS float* imp;
    __device__ __forceinline__ const bf16* kptr(int p, int j) const { return s.kp[p] + (long)j * s.kst; }
    __device__ __forceinline__ const bf16* vptr(int i, int j) const { return s.vp[i] + (long)j * s.vst; }
    __device__ __forceinline__ bool act(int) const { return true; }
    __device__ __forceinline__ void mod(fa::f32x16& p0, fa::f32x16& p1, int j) const { const float NEG = -__builtin_inff(); const int d0 = dq0 - 1024 * j;
#pragma unroll
        for (int r = 0; r < 16; ++r) { const int c = (r & 3) + 8 * (r >> 2), da = d0 - 16 * c, db = da - 512;
            p0[r] = da >= 0 ? p0[r] + t5_bias(tab, da) : NEG; p1[r] = db >= 0 ? p1[r] + t5_bias(tab, db) : NEG; } }
    __device__ __forceinline__ void post(fa::f32x16& p0, fa::f32x16& p1, int j) const {
#pragma unroll
        for (int q4 = 0; q4 < 4; ++q4) { LAS float* a = imp + 16 * j + 2 * q4;
            __hip_atomic_fetch_add(a, (p0[4 * q4] + p0[4 * q4 + 1]) + (p0[4 * q4 + 2] + p0[4 * q4 + 3]), __ATOMIC_RELAXED, __HIP_MEMORY_SCOPE_WORKGROUP);
            __hip_atomic_fetch_add(a + 1, p0[4 * q4 + 3], __ATOMIC_RELAXED, __HIP_MEMORY_SCOPE_WORKGROUP);
            __hip_atomic_fetch_add(a + 8, (p1[4 * q4] + p1[4 * q4 + 1]) + (p1[4 * q4 + 2] + p1[4 * q4 + 3]), __ATOMIC_RELAXED, __HIP_MEMORY_SCOPE_WORKGROUP);
            __hip_atomic_fetch_add(a + 9, p1[4 * q4 + 3], __ATOMIC_RELAXED, __HIP_MEMORY_SCOPE_WORKGROUP); } }
};
__device__ __forceinline__ int t5_bucket_lo(int bk) { const int e = bk - 16, v = 16 << (e >> 1); return (e & 1) ? (int)(((long long)v * 46341 + 32767) >> 15) : v; }
__device__ __forceinline__ int t5_bucket_u(int dist) { const int lg = 39 - __builtin_clz(dist * dist); return dist < 16 ? dist : (lg < 31 ? lg : 31); }
template <bool WIN> struct SwPol { NsaSrc s; int dq0, t0; float tab; unsigned long long sel;
    __device__ __forceinline__ const bf16* kptr(int p, int j) const { return s.kp[p] + (long)j * s.kst; }
    __device__ __forceinline__ const bf16* vptr(int i, int j) const { return s.vp[i] + (long)j * s.vst; }
    __device__ __forceinline__ bool act(int) const { return true; }
    __device__ __forceinline__ void mod(fa::f32x16& p0, fa::f32x16& p1, int j) const { const float NEG = -__builtin_inff(); const int d0 = dq0 - 64 * j;
        const bool on = WIN ? true : (bool)((sel >> j) & 1ull);
        const int dmin = t0 - 64 * j - 63, dmax = t0 + 31 - 64 * j;
        bool fast = false; int B = 0; float b_lo = 0.f, b_hi = 0.f;
        if (dmin >= 16) { const int bk = t5_bucket_u(dmax), bl = t5_bucket_u(dmin);
            if (!WIN || dmax < 512) { if (bk - bl <= 1) { fast = true; B = t5_bucket_lo(bk); b_hi = __builtin_bit_cast(float, __builtin_amdgcn_readlane(__builtin_bit_cast(int, tab), bk)); b_lo = __builtin_bit_cast(float, __builtin_amdgcn_readlane(__builtin_bit_cast(int, tab), bl)); } }
            else if (dmin < 512 && bl == 25) { fast = true; B = 512; b_hi = NEG; b_lo = __builtin_bit_cast(float, __builtin_amdgcn_readlane(__builtin_bit_cast(int, tab), 25)); } }
        if (fast) { const float lo = on ? b_lo : NEG, hi_ = on ? b_hi : NEG; const int th = d0 - B;
#pragma unroll
            for (int r = 0; r < 16; ++r) { const int c = (r & 3) + 8 * (r >> 2); p0[r] += (c <= th ? hi_ : lo); p1[r] += (c + 32 <= th ? hi_ : lo); } }
        else {
#pragma unroll
            for (int r = 0; r < 16; ++r) { const int c = (r & 3) + 8 * (r >> 2), da = d0 - c, db = da - 32;
                const bool va = WIN ? ((unsigned)da < 512u) : (on && da >= 0), vb = WIN ? ((unsigned)db < 512u) : (on && db >= 0);
                p0[r] = va ? p0[r] + t5_bias(tab, da) : NEG; p1[r] = vb ? p1[r] + t5_bias(tab, db) : NEG; } } }
    __device__ __forceinline__ void post(fa::f32x16&, fa::f32x16&, int) const {}
};
typedef SwPol<false> SlcPol; typedef SwPol<true> WinPol;
template <int MODE> __device__ __forceinline__ void oacc_rw(const fa::f32x16 (&o)[4], float* A, bf16* Bo, int r32, int hi) {
    asm volatile("" : "+v"(A), "+v"(Bo), "+v"(r32), "+v"(hi));
#pragma unroll
    for (int r = 0; r < 16; ++r) { const int orow = fa::crow(r, hi);
#pragma unroll
        for (int d0 = 0; d0 < 4; ++d0) { float* p = A + (size_t)orow * D + d0 * 32 + r32; float v = o[d0][r];
            if (MODE == 0) *p = v;
            else if (MODE == 1) *p = *p + v;
            else { v += *p; const float vn = __shfl_xor(v, 1); if ((r32 & 1) == 0) *(unsigned*)(Bo + (size_t)orow * D + d0 * 32 + r32) = fa::cvtpk(v, vn); } } }
}
__device__ __forceinline__ int opaque_i(int x) { asm volatile("" : "+v"(x)); return x; }
__device__ __forceinline__ void nsa_load_q(fa::bf16x8 (&qr)[8], const bf16* prow, int h, int hi) {
#pragma unroll
    for (int d0 = 0; d0 < 8; ++d0) { const v4u w = *(const v4u*)(prow + h * 128 + d0 * 16 + hi * 8); v4u o;
        o.x = fa::cvtpk(lo_bf(w.x) * NSA_SCALE, hi_bf(w.x) * NSA_SCALE); o.y = fa::cvtpk(lo_bf(w.y) * NSA_SCALE, hi_bf(w.y) * NSA_SCALE);
        o.z = fa::cvtpk(lo_bf(w.z) * NSA_SCALE, hi_bf(w.z) * NSA_SCALE); o.w = fa::cvtpk(lo_bf(w.w) * NSA_SCALE, hi_bf(w.w) * NSA_SCALE); qr[d0] = __builtin_bit_cast(fa::bf16x8, o); }
}
__device__ __forceinline__ void ph_nsa_fa(const Args& a, const Ctx& c) {
    unsigned char* ws = a.ws; const bf16* PROJ = (const bf16*)(ws + WS_PROJ); const bf16* KCB = (const bf16*)(ws + WS_KCB); const bf16* VCB = KCB + 1024 * 128;
    const float* relb = a.in[I_RELB]; bf16* ONSA = (bf16*)(ws + WS_ONSA); float* OACC = (float*)(ws + WS_OACC);
    const int wid = c.wave; LAS char* lds = (LAS char*)c.lds;
    LAS float* impT = (LAS float*)(lds + fa::OFF_IMP); LAS unsigned long long* selT = (LAS unsigned long long*)(lds + fa::OFF_SEL);
    for (int k = 0; ; ++k) { int u;
        if (c.G == 256) { if (k >= 2) break; u = k == 0 ? (int)blockIdx.x : 511 - (int)blockIdx.x; } else { u = (int)blockIdx.x + k * c.G; if (u >= 512) break; }
        const int tb = u >> 2, bg = u & 3, b = bg >> 1, g = bg & 1, h = g * 8 + wid, t0 = 32 * tb;
#define NSA_LANE() const int tid = opaque_i(c.tid), lane = tid & 63, r32 = lane & 31, hi = lane >> 5, sr = tid >> 4, sc = (tid & 15) * 8, tq = t0 + r32; \
        const bf16* prow = PROJ + (size_t)(b * T + tq) * NCOMBP; float* orow0 = OACC + (size_t)(b * T + t0) * D + h * 128; (void)sr; (void)sc; (void)orow0; (void)prow
        { NSA_LANE(); for (int i = tid; i < 32 * IMP_LD; i += NTHREADS) impT[i] = 0.f; }
        __syncthreads();
        { NSA_LANE(); fa::bf16x8 qr[8]; nsa_load_q(qr, prow, h, hi);
          CmpPol P; const bf16* kb = KCB + (size_t)(bg * 256) * 128; const bf16* vb = VCB + (size_t)(bg * 256) * 128;
          P.s.kp[0] = kb + sr * 128 + sc; P.s.kp[1] = P.s.kp[0] + 32 * 128; P.s.vp[0] = vb + sr * 128 + sc; P.s.vp[1] = P.s.vp[0] + 32 * 128; P.s.kst = 64 * 128; P.s.vst = 64 * 128;
          P.dq0 = tq - 31 - 64 * hi; P.tab = relb[r32 * 16 + h]; P.imp = impT + r32 * IMP_LD + hi;
          const unsigned long long tiles = (2ull << (t0 >> 10)) - 1ull;
          fa::f32x16 o[4] = {}; float m_c = -1e30f, l_c = 0.f;
          fa::attend<128, 1>(P, lds, qr, tiles, o, m_c, l_c, 0.f, tid, wid, lane);
          const float il = l_c > 0.f ? 1.f / l_c : 0.f;
          fa::attend<128, 2>(P, lds, qr, tiles, o, m_c, l_c, il, tid, wid, lane);
          { NSA_LANE(); fa::scale_rows(o, sigmoidf_(bf2f(prow[OFF_NSA_GATE + h])), lds, wid, r32, hi);
            oacc_rw<0>(o, orow0, nullptr, r32, hi); } }
        __syncthreads();
        { const int lane = opaque_i(c.lane), l16 = lane & 15, tk = 4 * wid + (lane >> 4), t = t0 + tk, cur = t >> 6;
          unsigned kk[4];
#pragma unroll
          for (int i = 0; i < 4; ++i) { const int jb = 4 * l16 + i; const float impv = impT[tk * IMP_LD + jb];
              const bool forced = (jb == 0) | (jb == cur) | (jb == cur - 1), validb = jb <= cur;
              kk[i] = validb ? ((forced ? 0xFFFFFFC0u : (fkey(impv) & ~63u)) | (unsigned)(63 - jb)) : 0u; }
          PEER_CE(kk[0], kk[1]); PEER_CE(kk[2], kk[3]); PEER_CE(kk[0], kk[2]); PEER_CE(kk[1], kk[3]); PEER_CE(kk[1], kk[2]);
          unsigned long long selmask = 0ull;
          for (int r = 0; r < 16; ++r) { const unsigned m = row16_max_u(kk[0]); if (m != 0u) selmask |= 1ull << (63 - (int)(m & 63u)); const bool pop = kk[0] == m;
              kk[0] = pop ? kk[1] : kk[0]; kk[1] = pop ? kk[2] : kk[1]; kk[2] = pop ? kk[3] : kk[2]; kk[3] = pop ? 0u : kk[3]; }
          if (l16 == 0) selT[tk] = selmask; }
        __syncthreads();
        { NSA_LANE(); fa::bf16x8 qr[8]; nsa_load_q(qr, prow, h, hi);
          SlcPol P; const bf16* kb = PROJ + (size_t)(b * T) * NCOMBP + OFF_NSA_KV + 2 * 256 + g * 128;
          P.s.kp[0] = kb + (size_t)sr * NCOMBP + sc; P.s.kp[1] = P.s.kp[0] + (size_t)32 * NCOMBP; P.s.vp[0] = P.s.kp[0] + 256; P.s.vp[1] = P.s.kp[1] + 256; P.s.kst = 64 * NCOMBP; P.s.vst = 64 * NCOMBP;
          P.dq0 = tq - 4 * hi; P.t0 = t0; P.tab = relb[r32 * 16 + h]; P.sel = selT[r32];
          unsigned lo = (unsigned)P.sel, hi32 = (unsigned)(P.sel >> 32);
#pragma unroll
          for (int o_ = 1; o_ < 32; o_ <<= 1) { lo |= __shfl_xor(lo, o_); hi32 |= __shfl_xor(hi32, o_); }
          const unsigned long long tiles = ((unsigned long long)(unsigned)__builtin_amdgcn_readfirstlane((int)hi32) << 32) | (unsigned)__builtin_amdgcn_readfirstlane((int)lo);
          fa::f32x16 o[4] = {}; float m_s = -1e30f, l_s = 0.f;
          fa::attend<128, 0>(P, lds, qr, tiles, o, m_s, l_s, 0.f, tid, wid, lane);
          { NSA_LANE(); const float g1 = sigmoidf_(bf2f(prow[OFF_NSA_GATE + 16 + h]));
            fa::scale_rows(o, l_s > 0.f ? g1 / l_s : 0.f, lds, wid, r32, hi);
            oacc_rw<1>(o, orow0, nullptr, r32, hi); } }
        { NSA_LANE(); fa::bf16x8 qr[8]; nsa_load_q(qr, prow, h, hi);
          WinPol P; const bf16* kb = PROJ + (size_t)(b * T) * NCOMBP + OFF_NSA_KV + 4 * 256 + g * 128;
          P.s.kp[0] = kb + (size_t)sr * NCOMBP + sc; P.s.kp[1] = P.s.kp[0] + (size_t)32 * NCOMBP; P.s.vp[0] = P.s.kp[0] + 256; P.s.vp[1] = P.s.kp[1] + 256; P.s.kst = 64 * NCOMBP; P.s.vst = 64 * NCOMBP;
          P.dq0 = tq - 4 * hi; P.t0 = t0; P.tab = relb[r32 * 16 + h]; P.sel = 0ull;
          const int jlo = t0 >= 511 ? (t0 - 511) >> 6 : 0, jhi = (t0 + 31) >> 6;
          const unsigned long long tiles = ((2ull << jhi) - 1ull) & ~((1ull << jlo) - 1ull);
          fa::f32x16 o[4] = {}; float m_w = -1e30f, l_w = 0.f;
          fa::attend<128, 0>(P, lds, qr, tiles, o, m_w, l_w, 0.f, tid, wid, lane);
          { NSA_LANE(); const float g2 = sigmoidf_(bf2f(prow[OFF_NSA_GATE + 32 + h]));
            fa::scale_rows(o, l_w > 0.f ? g2 / l_w : 0.f, lds, wid, r32, hi);
            oacc_rw<2>(o, orow0, ONSA + (size_t)(b * T + t0) * D + h * 128, r32, hi); } }
        __syncthreads();
#undef NSA_LANE
    }
}

struct MemPol { const bf16* kp[2]; const bf16* vp[2];
    __device__ __forceinline__ const bf16* kptr(int p, int j) const { return kp[p] + (long)j * (64 * 1024); }
    __device__ __forceinline__ const bf16* vptr(int i, int j) const { return vp[i] + (long)j * (64 * 1024); }
    __device__ __forceinline__ bool act(int) const { return true; }
    __device__ __forceinline__ void mod(fa::f32x16&, fa::f32x16&, int) const {}
    __device__ __forceinline__ void post(fa::f32x16&, fa::f32x16&, int) const {}
};
__device__ __forceinline__ void ph_memattn_fa(const Args& a, const Ctx& c) {
    unsigned char* ws = a.ws; const bf16* QM = (const bf16*)(ws + WS_QMEM); const bf16* KV = (const bf16*)(ws + WS_KVMEM); bf16* OM = (bf16*)(ws + WS_OMEM);
    const int wid = c.wave; LAS char* lds = (LAS char*)c.lds;
    for (int u = blockIdx.x; u < BATCH * 4 * 16; u += c.G) { const int qb = u & 15, h = (u >> 4) & 3, b = u >> 6;
        const int tid = opaque_i(c.tid), lane = tid & 63, r32 = lane & 31, hi = lane >> 5, sr = tid >> 4, sc = (tid & 15) * 8, row0 = b * T + 256 * qb + 32 * wid;
        MemPol P; P.kp[0] = KV + (size_t)(b * NMEM + sr) * 1024 + h * 128 + sc; P.kp[1] = P.kp[0] + (size_t)32 * 1024; P.vp[0] = P.kp[0] + 512; P.vp[1] = P.kp[1] + 512;
        fa::bf16x8 qr[8]; const bf16* q = QM + (size_t)(row0 + r32) * 512 + h * 128 + hi * 8;
#pragma unroll
        for (int d0 = 0; d0 < 8; ++d0) { const v4u w = *(const v4u*)(q + d0 * 16); v4u o;
            o.x = fa::cvtpk(lo_bf(w.x) * MEM_SCALE, hi_bf(w.x) * MEM_SCALE); o.y = fa::cvtpk(lo_bf(w.y) * MEM_SCALE, hi_bf(w.y) * MEM_SCALE);
            o.z = fa::cvtpk(lo_bf(w.z) * MEM_SCALE, hi_bf(w.z) * MEM_SCALE); o.w = fa::cvtpk(lo_bf(w.w) * MEM_SCALE, hi_bf(w.w) * MEM_SCALE); qr[d0] = __builtin_bit_cast(fa::bf16x8, o); }
        fa::f32x16 o[4] = {}; float m_reg = -1e30f, l_reg = 0.f;
        fa::attend<128, 0>(P, lds, qr, 0xFull, o, m_reg, l_reg, 0.f, tid, wid, lane);
        fa::scale_rows(o, 1.f / l_reg, lds, wid, r32, hi);
        fa::store_bf16(o, OM + (size_t)row0 * 512 + h * 128, 512, r32, hi);
    }
}
template <int DIM> __device__ __forceinline__ float dot_bf(const LAS float* q, const bf16* k) {
    float s = 0.f;
#pragma unroll 4
    for (int d = 0; d < DIM; d += 8) { const v4u w = *(const v4u*)(k + d); const f32x4 q0 = *(const LAS f32x4*)(q + d), q1 = *(const LAS f32x4*)(q + d + 4);
        s += q0.x * lo_bf(w.x) + q0.y * hi_bf(w.x) + q0.z * lo_bf(w.y) + q0.w * hi_bf(w.y) + q1.x * lo_bf(w.z) + q1.y * hi_bf(w.z) + q1.z * lo_bf(w.w) + q1.w * hi_bf(w.w); }
    return s;
}
template <int DIM> __device__ __forceinline__ float dot_f32(const LAS float* q, const float* k) {
    float s = 0.f;
#pragma unroll 4
    for (int d = 0; d < DIM; d += 4) { const f32x4 w = *(const f32x4*)(k + d); const f32x4 q0 = *(const LAS f32x4*)(q + d); s += q0.x * w.x + q0.y * w.y + q0.z * w.z + q0.w * w.w; }
    return s;
}
struct Soft { float m, l, o0, o1; };
__device__ __forceinline__ void soft_init(Soft& S) { S.m = -1e30f; S.l = 0.f; S.o0 = 0.f; S.o1 = 0.f; }
__device__ __forceinline__ void load2(const bf16* p, float& a, float& b) { const unsigned w = *(const unsigned*)p; a = lo_bf(w); b = hi_bf(w); }
__device__ __forceinline__ void load2(const float* p, float& a, float& b) { a = p[0]; b = p[1]; }
template <class VT> __device__ __forceinline__ void soft_chunk(Soft& S, float s, bool valid, int lane, const VT* vbase, long vstride) {
    const unsigned long long vm = __ballot(valid);
    if (vm == 0ull) return;
    const float cm = wave_max(valid ? s : -1e30f), mn = fmaxf(S.m, cm), sc = expf(S.m - mn), p = valid ? expf(s - mn) : 0.f;
    S.l = S.l * sc + wave_sum(p); S.o0 *= sc; S.o1 *= sc; S.m = mn;
    for (int k = 0; k < 64; ++k) if ((vm >> k) & 1ull) {
        const float pk = __shfl(p, k); float a, b; load2(vbase + (long)k * vstride + 2 * lane, a, b);
        S.o0 += pk * a; S.o1 += pk * b; }
}

struct TrItem { const float* W; bf16* WT; int K, N, row_off, k0, n0; };
__device__ __forceinline__ void tr_load(const TrItem& t, float (&tv)[32], int lane) {
    const int nn = t.n0 + (lane & 31);
#pragma unroll
    for (int i = 0; i < 32; ++i) { const int kk = 2 * i + (lane >> 5); tv[i] = nn < t.N ? __builtin_nontemporal_load(t.W + (size_t)(t.k0 + kk) * t.N + nn) : 0.f; }
}
__device__ __forceinline__ void tr_store(const TrItem& t, const float (&tv)[32], LAS float* scr, int lane) {
#pragma unroll
    for (int i = 0; i < 32; ++i) { const int kk = 2 * i + (lane >> 5); scr[kk * 33 + (lane & 31)] = tv[i]; }
    LDS_WAIT(); asm volatile("" ::: "memory");
    const int c = lane & 7;
#pragma unroll
    for (int j = 0; j < 4; ++j) { const int n = (lane >> 3) + 8 * j; const LAS float* s = scr + (8 * c) * 33 + n;
        v4u o; o.x = pk2(s[0 * 33], s[1 * 33]); o.y = pk2(s[2 * 33], s[3 * 33]); o.z = pk2(s[4 * 33], s[5 * 33]); o.w = pk2(s[6 * 33], s[7 * 33]);
        *(v4u*)(t.WT + (size_t)(t.row_off + t.n0 + n) * t.K + t.k0 + 8 * c) = o; }
    LDS_WAIT(); asm volatile("" ::: "memory");
}
__device__ __forceinline__ void cvt_rows(const float* src, bf16* dst, size_t n8, size_t gt, size_t nt) {
    for (size_t i = gt; i < n8; i += nt) { const f32x4 a = *(const f32x4*)(src + 8 * i), b = *(const f32x4*)(src + 8 * i + 4);
        v4u o; o.x = pk2(a.x, a.y); o.y = pk2(a.z, a.w); o.z = pk2(b.x, b.y); o.w = pk2(b.z, b.w); *(v4u*)(dst + 8 * i) = o; }
}
__device__ __forceinline__ void ph_prologue(const Args& a, const Ctx& c) {
    LAS float* scr = (LAS float*)(c.lds + c.wave * 16384);
    unsigned char* ws = a.ws;
    constexpr int I0 = 32 * 360, I1 = 8 * 64, I2 = 32 * 64, I3 = 32 * 16, I4 = 64 * 8;
    constexpr int NITEMS = I0 + 2 * I1 + 3 * I2 + 3 * I3 + I1 + I2 + 2 * I4;
#define TR_DECODE(t, it_) do { int r_ = (it_); int nblk_; \
        if (r_ < I0) { t.W = a.in[I_WIN]; t.K = D; t.N = NCOMB; t.WT = (bf16*)(ws + WS_W_IN); t.row_off = 0; nblk_ = 360; } else { r_ -= I0; \
        if (r_ < I1) { t.W = a.in[I_WUK]; t.K = 512; t.N = 2048; t.WT = (bf16*)(ws + WS_W_UKV); t.row_off = 0; nblk_ = 64; } else { r_ -= I1; \
        if (r_ < I1) { t.W = a.in[I_WUV]; t.K = 512; t.N = 2048; t.WT = (bf16*)(ws + WS_W_UKV); t.row_off = 2048; nblk_ = 64; } else { r_ -= I1; \
        if (r_ < I2) { t.W = a.in[I_WBN]; t.K = D; t.N = D; t.WT = (bf16*)(ws + WS_W_BN); t.row_off = 0; nblk_ = 64; } else { r_ -= I2; \
        if (r_ < I2) { t.W = a.in[I_WBM]; t.K = D; t.N = D; t.WT = (bf16*)(ws + WS_W_BM); t.row_off = 0; nblk_ = 64; } else { r_ -= I2; \
        if (r_ < I2) { t.W = a.in[I_WMO]; t.K = D; t.N = D; t.WT = (bf16*)(ws + WS_W_MO); t.row_off = 0; nblk_ = 64; } else { r_ -= I2; \
        if (r_ < I3) { t.W = a.in[I_MWQ]; t.K = D; t.N = 512; t.WT = (bf16*)(ws + WS_W_MQ); t.row_off = 0; nblk_ = 16; } else { r_ -= I3; \
        if (r_ < I3) { t.W = a.in[I_MWK]; t.K = D; t.N = 512; t.WT = (bf16*)(ws + WS_W_MKV); t.row_off = 0; nblk_ = 16; } else { r_ -= I3; \
        if (r_ < I3) { t.W = a.in[I_MWV]; t.K = D; t.N = 512; t.WT = (bf16*)(ws + WS_W_MKV); t.row_off = 512; nblk_ = 16; } else { r_ -= I3; \
        if (r_ < I1) { t.W = a.in[I_MWO]; t.K = 512; t.N = D; t.WT = (bf16*)(ws + WS_W_MO2); t.row_off = 0; nblk_ = 64; } else { r_ -= I1; \
        if (r_ < I2) { t.W = a.in[I_PWQ]; t.K = D; t.N = D; t.WT = (bf16*)(ws + WS_W_PQ); t.row_off = 0; nblk_ = 64; } else { r_ -= I2; \
        if (r_ < I4) { t.W = a.in[I_CKW1]; t.K = 4096; t.N = 256; t.WT = (bf16*)(ws + WS_W_C1K); t.row_off = 0; nblk_ = 8; } else { r_ -= I4; \
                       t.W = a.in[I_CVW1]; t.K = 4096; t.N = 256; t.WT = (bf16*)(ws + WS_W_C1V); t.row_off = 0; nblk_ = 8; } } } } } } } } } } } } \
        t.k0 = 64 * (r_ / nblk_); t.n0 = 32 * (r_ % nblk_); } while (0)
    for (int it = c.gw; it < NITEMS; it += 2 * c.ngw) {
        TrItem ta, tb; float va[32], vb[32]; const bool two = it + c.ngw < NITEMS;
        TR_DECODE(ta, it); tr_load(ta, va, c.lane);
        if (two) { TR_DECODE(tb, it + c.ngw); tr_load(tb, vb, c.lane); }
        tr_store(ta, va, scr, c.lane);
        if (two) tr_store(tb, vb, scr, c.lane);
    }
#undef TR_DECODE
    const size_t gt = (size_t)blockIdx.x * NTHREADS + c.tid, nt = (size_t)c.G * NTHREADS;
    cvt_rows(a.in[I_X], (bf16*)(ws + WS_XB), (size_t)NTOK * D / 8, gt, nt);
    cvt_rows(a.in[I_MEM], (bf16*)(ws + WS_MEMB), (size_t)BATCH * NMEM * D / 8, gt, nt);
    { const int kv = c.tid >> 8, j = c.tid & 255; const float* pe = a.in[kv ? I_CVPE : I_CKPE]; const float* w1 = a.in[kv ? I_CVW1 : I_CKW1]; float s = 0.f;
      for (int rr = (int)blockIdx.x; rr < 4096; rr += c.G) s += pe[rr] * w1[(size_t)rr * 256 + j];
      ((float*)(ws + WS_CVECP))[(size_t)blockIdx.x * 512 + c.tid] = s; }
    for (size_t i = gt; i < 65536; i += nt) { const int n = (int)(i >> 8), kk = (int)(i & 255); const float* keys = a.in[I_PKEYS];
        const float v = (n < 128 && kk < 128) ? keys[n * 128 + kk] : ((n >= 128 && kk >= 128) ? keys[16384 + (n - 128) * 128 + (kk - 128)] : 0.f);
        ((bf16*)(ws + WS_KEYB))[i] = (bf16)f2bf(v); }
    for (size_t i = gt; i < 8192; i += nt) { ((bf16*)(ws + WS_CMPA_K))[(size_t)4 * 4096 * 128 + i] = 0; ((bf16*)(ws + WS_CMPA_V))[(size_t)4 * 4096 * 128 + i] = 0; }
}

__device__ __forceinline__ void ph_rowprep(const Args& a, const Ctx& c) {
    unsigned char* ws = a.ws; bf16* PROJ = (bf16*)(ws + WS_PROJ); const int lane = c.lane;
    if (blockIdx.x == 0) { float s = 0.f;
#pragma unroll 32
        for (int w = 0; w < c.G; ++w) s += ((const float*)(ws + WS_CVECP))[(size_t)w * 512 + c.tid];
        ((float*)(ws + WS_CVEC))[c.tid] = s; }
    const float inv = exp2f(-(float)(lane & 31) * (13.287712379549449f / 32.f));
    const float* gk = a.in[I_KVNORM];
    for (int row = c.gw; row < NTOK; row += c.ngw) {
        const int b = row / T, t = row % T; bf16* prow = PROJ + (size_t)row * NCOMBP;
        const float ang = (float)t * inv, cs = cosf(ang), sn = sinf(ang);
        { const v4u w = *(const v4u*)(prow + OFF_MLA_KV + 8 * lane);
          float v[8] = {lo_bf(w.x), hi_bf(w.x), lo_bf(w.y), hi_bf(w.y), lo_bf(w.z), hi_bf(w.z), lo_bf(w.w), hi_bf(w.w)};
          float ss = 0.f;
#pragma unroll
          for (int i = 0; i < 8; ++i) ss += v[i] * v[i];
          const float r = rsqrtf(wave_sum(ss) * (1.f / 512.f) + 1e-6f);
          v4u o; o.x = pk2(v[0] * r * gk[8 * lane], v[1] * r * gk[8 * lane + 1]); o.y = pk2(v[2] * r * gk[8 * lane + 2], v[3] * r * gk[8 * lane + 3]);
          o.z = pk2(v[4] * r * gk[8 * lane + 4], v[5] * r * gk[8 * lane + 5]); o.w = pk2(v[6] * r * gk[8 * lane + 6], v[7] * r * gk[8 * lane + 7]);
          *(v4u*)((bf16*)(ws + WS_CKVN) + (size_t)row * 512 + 8 * lane) = o; }
        if (lane < 32) { const float x1 = bf2f(prow[OFF_MLA_KV + 512 + lane]), x2 = bf2f(prow[OFF_MLA_KV + 512 + 32 + lane]);
          bf16* kp = (bf16*)(ws + WS_KPE) + (size_t)row * 64; kp[lane] = (bf16)f2bf(x1 * cs - x2 * sn); kp[32 + lane] = (bf16)f2bf(x1 * sn + x2 * cs); }
#pragma unroll
        for (int j = 0; j < 8; ++j) { const int p = lane + 64 * j, h = p >> 5, i = p & 31; bf16* q = prow + OFF_MLA_Q + h * 192;
          const float x1 = bf2f(q[128 + i]), x2 = bf2f(q[160 + i]);
          q[128 + i] = (bf16)f2bf((x1 * cs - x2 * sn) * MLA_SCALE); q[160 + i] = (bf16)f2bf((x1 * sn + x2 * cs) * MLA_SCALE); }
#pragma unroll
        for (int j = 0; j < 4; ++j) { const int e = 8 * (lane + 64 * j), h = e >> 7, d = e & 127; bf16* q = prow + OFF_MLA_Q + h * 192 + d;
          const v4u w = *(const v4u*)q; v4u o; o.x = pk2(lo_bf(w.x) * MLA_SCALE, hi_bf(w.x) * MLA_SCALE); o.y = pk2(lo_bf(w.y) * MLA_SCALE, hi_bf(w.y) * MLA_SCALE);
          o.z = pk2(lo_bf(w.z) * MLA_SCALE, hi_bf(w.z) * MLA_SCALE); o.w = pk2(lo_bf(w.w) * MLA_SCALE, hi_bf(w.w) * MLA_SCALE); *(v4u*)q = o; }
        { const int i = lane >> 5, g = (lane >> 4) & 1, ch = lane & 15;
          const v4u w = *(const v4u*)(prow + OFF_NSA_KV + i * 256 + g * 128 + 8 * ch);
          bf16* dst = (bf16*)(ws + (i ? WS_CMPA_V : WS_CMPA_K)) + ((size_t)(b * 2 + g) * T + t) * 128 + 8 * ch; *(v4u*)dst = w; }
    }
}

constexpr size_t WS_H1P = 446 * MiB;
__device__ __forceinline__ void ph_cmp2(const Args& a, const Ctx& c) {
    unsigned char* ws = a.ws; const float* H1P = (const float*)(ws + WS_H1P); const float* cvec = (const float*)(ws + WS_CVEC); bf16* KCB = (bf16*)(ws + WS_KCB);
    LAS float* gl = (LAS float*)c.lds;
    for (int grp = blockIdx.x; grp < 256; grp += c.G) {
        __syncthreads();
#pragma unroll
        for (int i = 0; i < 4; ++i) { const int e = c.tid + 512 * i, rr = e >> 8, j = e & 255, row = grp * 8 + rr, kv = row >> 10, m = row & 1023; float s = cvec[kv * 256 + j];
#pragma unroll
            for (int ks = 0; ks < 8; ++ks) s += H1P[((size_t)(ks * 2 + kv) * 1024 + m) * 256 + j];
            gl[e] = gelu_tanh(s); }
        __syncthreads();
#pragma unroll
        for (int i = 0; i < 2; ++i) { const int e = c.tid + 512 * i, rr = e >> 7, ch = e & 127, row = grp * 8 + rr, kv = row >> 10; const float* w2 = a.in[kv ? I_CVW2 : I_CKW2]; float s = 0.f;
#pragma unroll 8
            for (int j = 0; j < 256; ++j) s += gl[rr * 256 + j] * w2[j * 128 + ch];
            KCB[(size_t)row * 128 + ch] = (bf16)f2bf(s); }
    }
}

__device__ __forceinline__ void ph_nsa(const Args& a, const Ctx& c) {
    unsigned char* ws = a.ws; const bf16* PROJ = (const bf16*)(ws + WS_PROJ); const float* KC = (const float*)(ws + WS_KCVC); const float* VC = KC + 1024 * 128;
    const float* relb = a.in[I_RELB]; bf16* ONSA = (bf16*)(ws + WS_ONSA); const int lane = c.lane;
    LAS float* qs = (LAS float*)(c.lds + c.wave * 8192); LAS float* pl = qs + 256;
    for (int task = c.gw; task < NTOK * 2; task += c.ngw) {
        const int g = task & 1, row = task >> 1, b = row / T, t = row % T; const bf16* prow = PROJ + (size_t)row * NCOMBP;
        const int ncv = t >= 31 ? (t - 31) / 16 + 1 : 0;
        const float* kcb = KC + (size_t)(b * 2 + g) * 256 * 128; const float* vcb = VC + (size_t)(b * 2 + g) * 256 * 128;
        float imp = 0.f;
        for (int hh = 0; hh < 8; ++hh) { const int h = g * 8 + hh;
            qs[lane] = bf2f(prow[h * 128 + lane]) * NSA_SCALE; qs[lane + 64] = bf2f(prow[h * 128 + 64 + lane]) * NSA_SCALE; LDS_WAIT();
            float s[4]; bool v[4]; float mx = -1e30f;
#pragma unroll
            for (int i = 0; i < 4; ++i) { const int n = lane + 64 * i; v[i] = n < ncv; s[i] = -1e30f;
                if (v[i]) s[i] = dot_f32<128>(qs, kcb + (size_t)n * 128) + relb[t5_bucket(t - 16 * n - 31) * 16 + h];
                mx = fmaxf(mx, s[i]); }
            mx = wave_max(mx); float p[4], l = 0.f;
#pragma unroll
            for (int i = 0; i < 4; ++i) { p[i] = v[i] ? expf(s[i] - mx) : 0.f; l += p[i]; }
            l = wave_sum(l); const float il = l > 0.f ? 1.f / l : 0.f;
#pragma unroll
            for (int i = 0; i < 4; ++i) pl[lane + 64 * i] = p[i] * il;
            LDS_WAIT();
#pragma unroll
            for (int n = 4 * lane - 1; n <= 4 * lane + 3; ++n) if (n >= 0 && n < 255) imp += pl[n];
            LDS_WAIT(); }
        const int cur = t >> 6; unsigned long long selmask = 0ull;
        { const bool forced = (lane == 0) | (lane == cur) | (lane == cur - 1), validb = lane <= cur;
          float sc = forced ? 1e4f : (validb ? imp : -1e30f);
          for (int r = 0; r < 16; ++r) { const float m = wave_max(sc); if (!(m > -5e29f)) break;
              const int idx = wave_min_i(sc == m ? lane : 64); selmask |= 1ull << idx; if (lane == idx) sc = -3e30f; } }
        if (lane == 0) ((unsigned long long*)(ws + WS_SEL))[task] = selmask;
        for (int hh = 0; hh < 8; ++hh) { const int h = g * 8 + hh;
            qs[lane] = bf2f(prow[h * 128 + lane]) * NSA_SCALE; qs[lane + 64] = bf2f(prow[h * 128 + 64 + lane]) * NSA_SCALE; LDS_WAIT();
            Soft Sc, Ss, Sw; soft_init(Sc); soft_init(Ss); soft_init(Sw);
            for (int i = 0; i < 4; ++i) { const int n = lane + 64 * i; const bool v = n < ncv; float s = 0.f;
                if (v) s = dot_f32<128>(qs, kcb + (size_t)n * 128) + relb[t5_bucket(t - 16 * n - 31) * 16 + h];
                soft_chunk<float>(Sc, s, v, lane, vcb + (size_t)(64 * i) * 128, 128); }
            for (unsigned long long mm = selmask; mm; mm &= mm - 1) { const int j = __ffsll((long long)mm) - 1, sp = 64 * j + lane; const bool v = sp <= t; float s = 0.f;
                const bf16* kb = PROJ + (size_t)(b * T + 64 * j) * NCOMBP + OFF_NSA_KV + 2 * 256 + g * 128;
                if (v) s = dot_bf<128>(qs, kb + (size_t)lane * NCOMBP) + relb[t5_bucket(t - sp) * 16 + h];
                soft_chunk<bf16>(Ss, s, v, lane, kb + 256, NCOMBP); }
            for (int cc = 0; cc < 8; ++cc) { const int s0 = t - 511 + 64 * cc, sp = s0 + lane; const bool v = sp >= 0; float s = 0.f;
                const bf16* kb = PROJ + ((long)(b * T) + s0) * NCOMBP + OFF_NSA_KV + 4 * 256 + g * 128;
                if (v) s = dot_bf<128>(qs, kb + (long)lane * NCOMBP) + relb[t5_bucket(t - sp) * 16 + h];
                soft_chunk<bf16>(Sw, s, v, lane, kb + 256, NCOMBP); }
            const float g0 = sigmoidf_(bf2f(prow[OFF_NSA_GATE + h])), g1 = sigmoidf_(bf2f(prow[OFF_NSA_GATE + 16 + h])), g2 = sigmoidf_(bf2f(prow[OFF_NSA_GATE + 32 + h]));
            const float ic = Sc.l > 0.f ? g0 / Sc.l : 0.f, is = Ss.l > 0.f ? g1 / Ss.l : 0.f, iw = Sw.l > 0.f ? g2 / Sw.l : 0.f;
            *(unsigned*)(ONSA + (size_t)row * D + h * 128 + 2 * lane) = pk2(Sc.o0 * ic + Ss.o0 * is + Sw.o0 * iw, Sc.o1 * ic + Ss.o1 * is + Sw.o1 * iw);
            LDS_WAIT(); }
    }
}

__device__ __forceinline__ void ph_mla(const Args& a, const Ctx& c) {
    unsigned char* ws = a.ws; const bf16* PROJ = (const bf16*)(ws + WS_PROJ); const bf16* KVUP = (const bf16*)(ws + WS_KVUP); const bf16* KPE = (const bf16*)(ws + WS_KPE);
    bf16* OMLA = (bf16*)(ws + WS_OMLA); const int lane = c.lane; LAS float* qs = (LAS float*)(c.lds + c.wave * 8192);
    for (int task = c.gw; task < NTOK * 16; task += c.ngw) {
        const int h = task & 15, row = task >> 4, b = row / T, t = row % T; const bf16* q = PROJ + (size_t)row * NCOMBP + OFF_MLA_Q + h * 192;
        qs[lane] = bf2f(q[lane]); qs[lane + 64] = bf2f(q[lane + 64]); qs[lane + 128] = bf2f(q[lane + 128]); LDS_WAIT();
        Soft S; soft_init(S);
        for (int cc = 0; cc <= (t >> 6); ++cc) { const int sp = 64 * cc + lane; const bool v = sp <= t; float s = 0.f;
            const bf16* kb = KVUP + (size_t)(b * T + 64 * cc) * 4096 + h * 128;
            if (v) s = dot_bf<128>(qs, kb + (size_t)lane * 4096) + dot_bf<64>(qs + 128, KPE + (size_t)(b * T + sp) * 64);
            soft_chunk<bf16>(S, s, v, lane, kb + 2048, 4096); }
        const float il = S.l > 0.f ? 1.f / S.l : 0.f;
        *(unsigned*)(OMLA + (size_t)row * D + h * 128 + 2 * lane) = pk2(S.o0 * il, S.o1 * il);
        LDS_WAIT();
    }
}

__device__ __forceinline__ void ph_merge(const Args& a, const Ctx& c) {
    unsigned char* ws = a.ws; const bf16* PROJ = (const bf16*)(ws + WS_PROJ); const bf16* YN = (const bf16*)(ws + WS_YN); const bf16* YM = (const bf16*)(ws + WS_YM); bf16* MG = (bf16*)(ws + WS_MERGED);
    const size_t gt = (size_t)blockIdx.x * NTHREADS + c.tid, nt = (size_t)c.G * NTHREADS;
    for (size_t i = gt; i < (size_t)NTOK * D / 8; i += nt) { const size_t row = i / (D / 8); const int col = (int)(i % (D / 8)) * 8;
        const v4u g0 = *(const v4u*)(PROJ + row * NCOMBP + OFF_MERGE + col), g1 = *(const v4u*)(PROJ + row * NCOMBP + OFF_MERGE + D + col), yn = *(const v4u*)(YN + row * D + col), ym = *(const v4u*)(YM + row * D + col);
        v4u o;
#define MRG(f) pk2(sigmoidf_(lo_bf(g0.f)) * lo_bf(yn.f) + sigmoidf_(lo_bf(g1.f)) * lo_bf(ym.f), sigmoidf_(hi_bf(g0.f)) * hi_bf(yn.f) + sigmoidf_(hi_bf(g1.f)) * hi_bf(ym.f))
        o.x = MRG(x); o.y = MRG(y); o.z = MRG(z); o.w = MRG(w);
#undef MRG
        *(v4u*)(MG + row * D + col) = o; }
}

__device__ __forceinline__ void ln_rows_store(f32x4 (&v)[8], const float* gam, const float* bet, float* outf, bf16* outb, int lane) {
    float s = 0.f;
#pragma unroll
    for (int j = 0; j < 8; ++j) s += (v[j].x + v[j].y) + (v[j].z + v[j].w);
    const float mean = wave_sum_u(s) * (1.f / D); float s2 = 0.f;
#pragma unroll
    for (int j = 0; j < 8; ++j) { v[j] = v[j] - mean; s2 += (v[j].x * v[j].x + v[j].y * v[j].y) + (v[j].z * v[j].z + v[j].w * v[j].w); }
    const float rstd = rsqrtf(wave_sum_u(s2) * (1.f / D) + 1e-5f);
#pragma unroll
    for (int j = 0; j < 8; ++j) { const int e = 4 * lane + 256 * j; const f32x4 gg = *(const f32x4*)(gam + e), bb = *(const f32x4*)(bet + e); const f32x4 o = v[j] * rstd * gg + bb;
        *(f32x4*)(outf + e) = o;
        if (outb) { uint2 w; w.x = pk2(o.x, o.y); w.y = pk2(o.z, o.w); *(uint2*)(outb + e) = w; } }
}
__device__ __forceinline__ void ph_ln(const Ctx& c, const float* xin, const float* z, const float* gam, const float* bet, float* outf, bf16* outb) {
    for (int row = c.gw; row < NTOK; row += c.ngw) { f32x4 v[8];
#pragma unroll
        for (int j = 0; j < 8; ++j) { const size_t e = (size_t)row * D + 4 * c.lane + 256 * j; v[j] = *(const f32x4*)(xin + e) * ALPHA + *(const f32x4*)(z + e); }
        ln_rows_store(v, gam, bet, outf + (size_t)row * D, outb + (size_t)row * D, c.lane); }
}

__device__ __forceinline__ void ph_memattn(const Args& a, const Ctx& c) {
    unsigned char* ws = a.ws; const bf16* QM = (const bf16*)(ws + WS_QMEM); const bf16* KV = (const bf16*)(ws + WS_KVMEM); bf16* OM = (bf16*)(ws + WS_OMEM);
    const int lane = c.lane; LAS float* qs = (LAS float*)(c.lds + c.wave * 8192);
    for (int task = c.gw; task < NTOK * 4; task += c.ngw) { const int h = task & 3, row = task >> 2, b = row / T; const bf16* q = QM + (size_t)row * 512 + h * 128;
        qs[lane] = bf2f(q[lane]) * MEM_SCALE; qs[lane + 64] = bf2f(q[lane + 64]) * MEM_SCALE; LDS_WAIT();
        Soft S; soft_init(S);
        for (int cc = 0; cc < 4; ++cc) { const bf16* kb = KV + (size_t)(b * NMEM + 64 * cc) * 1024 + h * 128;
            const float s = dot_bf<128>(qs, kb + (size_t)lane * 1024); soft_chunk<bf16>(S, s, true, lane, kb + 512, 1024); }
        const float il = 1.f / S.l;
        *(unsigned*)(OM + (size_t)row * 512 + h * 128 + 2 * lane) = pk2(S.o0 * il, S.o1 * il);
        LDS_WAIT(); }
}

__device__ __forceinline__ void top16_of128(float x0, float x1, LAS float* vs, LAS int* is, int lane) {
    for (int r = 0; r < 16; ++r) { const float m = wave_max(fmaxf(x0, x1));
        const int idx = wave_min_i(x0 == m ? lane : (x1 == m ? lane + 64 : 1 << 20));
        if (lane == 0) { vs[r] = m; is[r] = idx; }
        if (idx == lane) x0 = -__builtin_inff(); if (idx == lane + 64) x1 = -__builtin_inff(); }
}
__device__ __forceinline__ void ph_peer_select(const Args& a, const Ctx& c) {
    unsigned char* ws = a.ws; const float* PQ = (const float*)(ws + WS_PQ); const float* keys = a.in[I_PKEYS]; int* PIDX = (int*)(ws + WS_PIDX); float* PGATE = (float*)(ws + WS_PGATE);
    const int lane = c.lane; LAS float* qs = (LAS float*)(c.lds + c.wave * 8192); LAS float* v1 = qs + 256; LAS int* i1 = (LAS int*)(qs + 272); LAS float* v2 = qs + 288; LAS int* i2 = (LAS int*)(qs + 304);
    for (int task = c.gw; task < NTOK * 8; task += c.ngw) { const int hh = task & 7, tok = task >> 3; const float* q = PQ + (size_t)tok * D + hh * 256;
#pragma unroll
        for (int i = 0; i < 4; ++i) qs[lane + 64 * i] = q[lane + 64 * i];
        LDS_WAIT();
        const float a0 = dot_f32<128>(qs, keys + (size_t)lane * 128), a1 = dot_f32<128>(qs, keys + (size_t)(lane + 64) * 128);
        const float b0 = dot_f32<128>(qs + 128, keys + (size_t)(128 + lane) * 128), b1 = dot_f32<128>(qs + 128, keys + (size_t)(128 + lane + 64) * 128);
        top16_of128(a0, a1, v1, i1, lane); top16_of128(b0, b1, v2, i2, lane); LDS_WAIT();
        float cv[4];
#pragma unroll
        for (int k = 0; k < 4; ++k) { const int f = 4 * lane + k; cv[k] = v1[f >> 4] + v2[f & 15]; }
        float top_s = 0.f; int flat = 0;
        for (int r = 0; r < 16; ++r) { const float m = wave_max(fmaxf(fmaxf(cv[0], cv[1]), fmaxf(cv[2], cv[3])));
            int cand = 1 << 20;
#pragma unroll
            for (int k = 3; k >= 0; --k) if (cv[k] == m) cand = 4 * lane + k;
            const int idx = wave_min_i(cand);
            if (lane == r) { top_s = m; flat = idx; }
#pragma unroll
            for (int k = 0; k < 4; ++k) if (idx == 4 * lane + k) cv[k] = -__builtin_inff(); }
        const float mx = __shfl(top_s, 0); const float e = lane < 16 ? expf(top_s - mx) : 0.f; const float l = wave_sum(e);
        if (lane < 16) { PIDX[(size_t)tok * 128 + hh * 16 + lane] = i1[flat >> 4] * 128 + i2[flat & 15]; PGATE[(size_t)tok * 128 + hh * 16 + lane] = e / l; }
        LDS_WAIT(); }
}

__device__ const unsigned char PEER_CAND[64] = {0,1,2,3,4,5,6,7,8,9,10,11,12,13,14,15,16,17,18,19,20,21,22,23,32,33,34,35,36,48,49,50,51,64,65,66,80,81,96,97,112,113,128,144,160,176,192,208,224,240,
                                                255,255,255,255,255,255,255,255,255,255,255,255,255,255};
__device__ __forceinline__ unsigned top16_of_row8(unsigned (&k)[8], int l16) {
    PEER_CE(k[0], k[1]); PEER_CE(k[2], k[3]); PEER_CE(k[4], k[5]); PEER_CE(k[6], k[7]); PEER_CE(k[0], k[2]); PEER_CE(k[1], k[3]); PEER_CE(k[4], k[6]); PEER_CE(k[5], k[7]);
    PEER_CE(k[1], k[2]); PEER_CE(k[5], k[6]); PEER_CE(k[0], k[4]); PEER_CE(k[1], k[5]); PEER_CE(k[2], k[6]); PEER_CE(k[3], k[7]); PEER_CE(k[2], k[4]); PEER_CE(k[3], k[5]);
    PEER_CE(k[1], k[2]); PEER_CE(k[3], k[4]); PEER_CE(k[5], k[6]);
    unsigned res = 0u;
    for (int t = 0; t < 16; ++t) { const unsigned m = row16_max_u(k[0]); res = l16 == t ? m : res; const bool pop = k[0] == m;
        k[0] = pop ? k[1] : k[0]; k[1] = pop ? k[2] : k[1]; k[2] = pop ? k[3] : k[2]; k[3] = pop ? k[4] : k[3]; k[4] = pop ? k[5] : k[4]; k[5] = pop ? k[6] : k[5]; k[6] = pop ? k[7] : k[6]; k[7] = pop ? 0u : k[7]; }
    return res;
}
__device__ __forceinline__ void ph_peer_select2(const Args& a, const Ctx& c) {
    unsigned char* ws = a.ws; const float* S = (const float*)(ws + WS_S); int* PIDX = (int*)(ws + WS_PIDX); float* PGATE = (float*)(ws + WS_PGATE);
    const int lane = c.lane, l16 = lane & 15, rq = lane >> 4, rowbase = lane & 48;
    for (int it = c.gw; it < NTOK * 2; it += c.ngw) { const int R = 4 * it + rq; const float* s = S + (size_t)R * 256 + 8 * l16;
        const f32x4 x0 = *(const f32x4*)s, x1 = *(const f32x4*)(s + 4), y0 = *(const f32x4*)(s + 128), y1 = *(const f32x4*)(s + 132);
        unsigned k[8]; const unsigned ib = 127u - 8u * (unsigned)l16;
        k[0] = (fkey(x0.x) & ~127u) | ib; k[1] = (fkey(x0.y) & ~127u) | (ib - 1); k[2] = (fkey(x0.z) & ~127u) | (ib - 2); k[3] = (fkey(x0.w) & ~127u) | (ib - 3);
        k[4] = (fkey(x1.x) & ~127u) | (ib - 4); k[5] = (fkey(x1.y) & ~127u) | (ib - 5); k[6] = (fkey(x1.z) & ~127u) | (ib - 6); k[7] = (fkey(x1.w) & ~127u) | (ib - 7);
        const unsigned r1 = top16_of_row8(k, l16);
        k[0] = (fkey(y0.x) & ~127u) | ib; k[1] = (fkey(y0.y) & ~127u) | (ib - 1); k[2] = (fkey(y0.z) & ~127u) | (ib - 2); k[3] = (fkey(y0.w) & ~127u) | (ib - 3);
        k[4] = (fkey(y1.x) & ~127u) | (ib - 4); k[5] = (fkey(y1.y) & ~127u) | (ib - 5); k[6] = (fkey(y1.z) & ~127u) | (ib - 6); k[7] = (fkey(y1.w) & ~127u) | (ib - 7);
        const unsigned r2 = top16_of_row8(k, l16);
        unsigned ck[4];
#pragma unroll
        for (int si = 0; si < 4; ++si) { const int ci = 4 * l16 + si; const unsigned flat = PEER_CAND[ci];
            const unsigned ka = (unsigned)__builtin_amdgcn_ds_bpermute((rowbase + (int)(flat >> 4)) << 2, (int)r1), kb = (unsigned)__builtin_amdgcn_ds_bpermute((rowbase + (int)(flat & 15u)) << 2, (int)r2);
            const float sum = funkey(ka & ~127u) + funkey(kb & ~127u);
            ck[si] = ci < 50 ? ((fkey(sum) & ~255u) | (255u - flat)) : 0u; }
        PEER_CE(ck[0], ck[1]); PEER_CE(ck[2], ck[3]); PEER_CE(ck[0], ck[2]); PEER_CE(ck[1], ck[3]); PEER_CE(ck[1], ck[2]);
        unsigned rf = 0u;
        for (int t = 0; t < 16; ++t) { const unsigned m = row16_max_u(ck[0]); rf = l16 == t ? m : rf; const bool pop = ck[0] == m;
            ck[0] = pop ? ck[1] : ck[0]; ck[1] = pop ? ck[2] : ck[1]; ck[2] = pop ? ck[3] : ck[2]; ck[3] = pop ? 0u : ck[3]; }
        const unsigned flat = 255u - (rf & 255u); const float ts = funkey(rf & ~255u), mx = funkey(row16_max_u(rf) & ~255u);
        const unsigned ka = (unsigned)__builtin_amdgcn_ds_bpermute((rowbase + (int)(flat >> 4)) << 2, (int)r1), kb = (unsigned)__builtin_amdgcn_ds_bpermute((rowbase + (int)(flat & 15u)) << 2, (int)r2);
        const float ex = expf(ts - mx), den = row16_sum_f(ex);
        PIDX[(size_t)R * 16 + l16] = (int)((127u - (ka & 127u)) * 128u + (127u - (kb & 127u))); PGATE[(size_t)R * 16 + l16] = ex / den; }
}

constexpr size_t WS_U8 = 1 * MiB, WS_USC = 33 * MiB, WS_V8 = 478 * MiB;
__device__ __forceinline__ void peer_convert(const Args& a, int gw, int ngw, int lane) {
    unsigned char* ws = a.ws; float* SC = (float*)(ws + WS_USC);
    for (int r = gw; r < 2 * 16384; r += ngw) { const int which = r >> 14, e = r & 16383; const float* src = a.in[which ? I_PV : I_PU] + (size_t)e * D;
        f32x4 v[8]; float am = 0.f;
#pragma unroll
        for (int j = 0; j < 8; ++j) { v[j] = __builtin_nontemporal_load((const f32x4*)(src + 4 * lane + 256 * j)); am = fmaxf(am, fmaxf(fmaxf(fabsf(v[j].x), fabsf(v[j].y)), fmaxf(fabsf(v[j].z), fabsf(v[j].w)))); }
        am = wave_max(am); const float s = am > 0.f ? am * (1.f / 127.f) : 1.f, is = 1.f / s;
        unsigned* dst = (unsigned*)(ws + (which ? WS_V8 : WS_U8) + (size_t)e * D); int bs = 0;
#pragma unroll
        for (int j = 0; j < 8; ++j) { const int q0 = (int)rintf(v[j].x * is) + 128, q1 = (int)rintf(v[j].y * is) + 128, q2 = (int)rintf(v[j].z * is) + 128, q3 = (int)rintf(v[j].w * is) + 128;
            dst[lane + 64 * j] = (unsigned)q0 | ((unsigned)q1 << 8) | ((unsigned)q2 << 16) | ((unsigned)q3 << 24); bs += (q0 + q1) + (q2 + q3); }
        bs = wave_sum_i(bs);
        if (lane == 0) { SC[r] = s; ((int*)(SC + 32768))[r] = bs; } }
}
#define PEER_DOT4(bw_, xj) (((float)((bw_) & 0xffu) * lo_bf((xj).x) + (float)(((bw_) >> 8) & 0xffu) * hi_bf((xj).x)) + ((float)(((bw_) >> 16) & 0xffu) * lo_bf((xj).y) + (float)((bw_) >> 24) * hi_bf((xj).y)))
struct PeerStream { int e0, e1; float g0, g1; int ch; unsigned long long m0, m1; };
__device__ __forceinline__ void peer_take(PeerStream& S, int& e, float& g) {
    while (!(S.m0 | S.m1)) { ++S.ch; S.m0 = __ballot((S.e0 >> 9) == S.ch); S.m1 = __ballot((S.e1 >> 9) == S.ch); }
    if (S.m0) { const int bt = __builtin_ctzll(S.m0); S.m0 &= S.m0 - 1; e = __builtin_amdgcn_readlane(S.e0, bt); g = __builtin_bit_cast(float, __builtin_amdgcn_readlane(__builtin_bit_cast(int, S.g0), bt)); }
    else { const int bt = __builtin_ctzll(S.m1); S.m1 &= S.m1 - 1; e = __builtin_amdgcn_readlane(S.e1, bt); g = __builtin_bit_cast(float, __builtin_amdgcn_readlane(__builtin_bit_cast(int, S.g1), bt)); }
}
__device__ __forceinline__ void peer_batch(const unsigned* U8, const unsigned* V8, const float* SC, const unsigned (&xq)[8], f32x4 (&acc)[8], float& csum, int xoff, float sxq, PeerStream& S, int lane) {
    int e[4]; float g[4], d[4]; unsigned ub[4][8]; unsigned di[4];
#pragma unroll
    for (int i = 0; i < 4; ++i) { peer_take(S, e[i], g[i]);
#pragma unroll
        for (int j = 0; j < 8; ++j) ub[i][j] = U8[(size_t)e[i] * 512 + lane + 64 * j]; }
#pragma unroll
    for (int i = 0; i < 4; ++i) { unsigned s = 0u;
#pragma unroll
        for (int j = 0; j < 8; ++j) s = __builtin_amdgcn_udot4(ub[i][j], xq[j], s, false);
        di[i] = s; }
#pragma unroll
    for (int i = 0; i < 4; ++i) { const int tot = wave_sum_i((int)di[i]) - 128 * ((const int*)(SC + 32768))[e[i]] + xoff;
        const float h = (float)tot * (SC[e[i]] * sxq); d[i] = g[i] * gelu_tanh(h) * SC[16384 + e[i]]; csum += d[i];
#pragma unroll
        for (int j = 0; j < 8; ++j) ub[i][j] = V8[(size_t)e[i] * 512 + lane + 64 * j]; }
#pragma unroll
    for (int i = 0; i < 4; ++i)
#pragma unroll
        for (int j = 0; j < 8; ++j) { const unsigned w = ub[i][j];
            acc[j].x += d[i] * (float)(w & 0xffu); acc[j].y += d[i] * (float)((w >> 8) & 0xffu); acc[j].z += d[i] * (float)((w >> 16) & 0xffu); acc[j].w += d[i] * (float)(w >> 24); }
}
__device__ __forceinline__ void ph_peer_ffn(const Args& a, const Ctx& c) {
    unsigned char* ws = a.ws; const float* X2 = (const float*)(ws + WS_X2); const int* PIDX = (const int*)(ws + WS_PIDX); const float* PGATE = (const float*)(ws + WS_PGATE);
    const unsigned* U8 = (const unsigned*)(ws + WS_U8); const unsigned* V8 = (const unsigned*)(ws + WS_V8); const float* SC = (const float*)(ws + WS_USC);
    for (int ta = c.gw; ta < NTOK; ta += c.ngw) { const int lane = opaque_i(c.lane); unsigned xq[8]; f32x4 aa[8]; float ca = 0.f, am = 0.f; int xs = 0;
        { f32x4 xv[8];
#pragma unroll
          for (int j = 0; j < 8; ++j) { xv[j] = *(const f32x4*)(X2 + (size_t)ta * D + 4 * lane + 256 * j); am = fmaxf(am, fmaxf(fmaxf(fabsf(xv[j].x), fabsf(xv[j].y)), fmaxf(fabsf(xv[j].z), fabsf(xv[j].w)))); }
          am = wave_max_u(am); const float isx = am > 0.f ? 127.f / am : 0.f;
#pragma unroll
          for (int j = 0; j < 8; ++j) { const int q0 = (int)rintf(xv[j].x * isx) + 128, q1 = (int)rintf(xv[j].y * isx) + 128, q2 = (int)rintf(xv[j].z * isx) + 128, q3 = (int)rintf(xv[j].w * isx) + 128;
              xq[j] = (unsigned)q0 | ((unsigned)q1 << 8) | ((unsigned)q2 << 16) | ((unsigned)q3 << 24); xs += (q0 + q1) + (q2 + q3); aa[j] = (f32x4){0.f, 0.f, 0.f, 0.f}; } }
        const float sxq = am * (1.f / 127.f); const int xoff = 128 * 128 * 2048 - 128 * wave_sum_i(xs);
        PeerStream sa; sa.e0 = PIDX[(size_t)ta * 128 + lane]; sa.e1 = PIDX[(size_t)ta * 128 + 64 + lane]; sa.g0 = PGATE[(size_t)ta * 128 + lane]; sa.g1 = PGATE[(size_t)ta * 128 + 64 + lane];
        sa.ch = -1; sa.m0 = 0ull; sa.m1 = 0ull;
        for (int st = 0; st < 32; ++st) peer_batch(U8, V8, SC, xq, aa, ca, xoff, sxq, sa, lane);
        const float offa = ca * 128.f;
#pragma unroll
        for (int j = 0; j < 8; ++j) aa[j] = aa[j] - offa + *(const f32x4*)(X2 + (size_t)ta * D + 4 * lane + 256 * j) * ALPHA;
        ln_rows_store(aa, a.in[I_LN3G], a.in[I_LN3B], a.out + (size_t)ta * D, nullptr, lane); }
}

struct PairOrder { pg8::StaticOrder so;
    __device__ bool next(int i, pg8::Unit& u) const { pg8::Unit t; if (!so.next(i >> 1, t)) return false; const int w = i & 1; u.pm = t.pm + 32 * w; u.pn = t.pn + 8 * w; return true; }
    __device__ __forceinline__ void a_ready(const pg8::Unit&) const {}
    __device__ __forceinline__ void done(const pg8::Unit&) const {} };
struct EpiMerge {
    static constexpr bool PERM = true, AFTER_DRAIN = false;
    bf16* O; const bf16* PROJ;
    __device__ __forceinline__ void operator()(const pg8::f32x4 (&acc)[2][2][4][2], const pg8::Unit& u, int wr, int wc, int fr, int fq) const {
        const int w = u.pm >> 5, row0 = (u.pm & 31) * 256 + wr * 64 + fr, col0 = (u.pn & 7) * 256 + wc * 32 + 8 * fq;
#pragma unroll
        for (int ai = 0; ai < 2; ++ai)
#pragma unroll
            for (int m = 0; m < 4; ++m) { const size_t row = (size_t)(row0 + ai * 128 + m * 16); bf16* rowp = O + row * D + col0; const bf16* gp = PROJ + row * NCOMBP + OFF_MERGE + w * D + col0;
#pragma unroll
                for (int bj = 0; bj < 2; ++bj) { const v4u gw = *(const v4u*)(gp + bj * 128); const pg8::f32x4 a0 = acc[ai][bj][m][0], a1 = acc[ai][bj][m][1];
                    float v[8] = {sigmoid_fast(lo_bf(gw.x)) * a0[0], sigmoid_fast(hi_bf(gw.x)) * a0[1], sigmoid_fast(lo_bf(gw.y)) * a0[2], sigmoid_fast(hi_bf(gw.y)) * a0[3],
                                  sigmoid_fast(lo_bf(gw.z)) * a1[0], sigmoid_fast(hi_bf(gw.z)) * a1[1], sigmoid_fast(lo_bf(gw.w)) * a1[2], sigmoid_fast(hi_bf(gw.w)) * a1[3]};
                    if (w) { const v4u pw = *(const v4u*)(rowp + bj * 128); v[0] += lo_bf(pw.x); v[1] += hi_bf(pw.x); v[2] += lo_bf(pw.y); v[3] += hi_bf(pw.y); v[4] += lo_bf(pw.z); v[5] += hi_bf(pw.z); v[6] += lo_bf(pw.w); v[7] += hi_bf(pw.w); }
                    v4u o; o.x = pg8::cvt_pk_bf16(v[0], v[1]); o.y = pg8::cvt_pk_bf16(v[2], v[3]); o.z = pg8::cvt_pk_bf16(v[4], v[5]); o.w = pg8::cvt_pk_bf16(v[6], v[7]);
                    *(v4u*)(rowp + bj * 128) = o; } }
    }
};

struct OneUnit { int pm, pn; bool has;
    __device__ bool next(int i, pg8::Unit& u) const { if (i != 0 || !has) return false; u.pm = pm; u.pn = pn; return true; }
    __device__ __forceinline__ void a_ready(const pg8::Unit&) const {}
    __device__ __forceinline__ void done(const pg8::Unit&) const {} };

constexpr int N_PHASES = 19;
__global__ void __launch_bounds__(NTHREADS, 2) fwd(Args args) {
    extern __shared__ __attribute__((aligned(16))) unsigned char lds_raw[];
    Ctx c; c.lds = (LAS unsigned char*)lds_raw; c.tid = threadIdx.x; c.lane = c.tid & 63; c.wave = __builtin_amdgcn_readfirstlane(c.tid >> 6);
    c.G = gridDim.x; c.gw = blockIdx.x * NWAVES + c.wave; c.ngw = c.G * NWAVES;
    volatile LAS unsigned* MISC = (volatile LAS unsigned*)(c.lds + MISC_OFF);
    unsigned char* ws = args.ws; unsigned* ctl = (unsigned*)(ws + WS_CTL);
    for (int u = c.tid; u < (LDS_BYTES - LDSCTL_OFF) / 4; u += NTHREADS) ((LAS unsigned*)(c.lds + LDSCTL_OFF))[u] = 0u;
    __syncthreads();
    XcdBarrier bar; bar.bar = ctl + CW_BAR; bar.x = 0; bar.st = nullptr;
    if (N_LAUNCHES == 1) bar = xcd_barrier_post(ctl + CW_BAR, MISC + 8);
    const int lo = args.ph_lo, hi = args.ph_hi;
#define IN(k) (lo <= (k) && (k) < hi)
#define SEAM(k) do { if (N_LAUNCHES == 1 && IN(k) && IN((k) + 1)) xcd_barrier(bar); } while (0)
    LAS unsigned char* ring = c.lds;
    const int bx = (int)blockIdx.x;

    if (IN(0)) { ph_prologue(args, c); } SEAM(0);
    if (IN(1)) {
        { pg8::Gemm g{(const bf16*)(ws + WS_XB), (const bf16*)(ws + WS_W_IN), NTOK, NCOMBP, D, D, D}; pg8::StaticOrder S; S.init(NTOK, NCOMBP, c.G, bx);
          pg8::EpiBf16<0> E{(bf16*)(ws + WS_PROJ), NCOMBP, nullptr, 0, 0, 1.f}; pg8::gemm_phase<pg8::EpiBf16<0>, pg8::StaticOrder, true, true>(ring, g, S, E); }
        { pg8::Gemm g{(const bf16*)(ws + WS_MEMB), (const bf16*)(ws + WS_W_MKV), BATCH * NMEM, 1024, D, D, D}; pg8::StaticOrder S; S.init(BATCH * NMEM, 1024, c.G, bx);
          pg8::EpiBf16<0> E{(bf16*)(ws + WS_KVMEM), 1024, nullptr, 0, 0, 1.f}; pg8::gemm_phase<pg8::EpiBf16<0>, pg8::StaticOrder, true, true>(ring, g, S, E); }
    } SEAM(1);
    if (IN(2)) { ph_rowprep(args, c); } SEAM(2);
    if (IN(3)) {
        { pg8::Gemm g{(const bf16*)(ws + WS_CKVN), (const bf16*)(ws + WS_W_UKV), NTOK, 4096, 512, 512, 512}; pg8::StaticOrder S; S.init(NTOK, 4096, c.G, bx);
          pg8::EpiBf16<0> E{(bf16*)(ws + WS_KVUP), 4096, nullptr, 0, 0, 1.f}; pg8::gemm_phase<pg8::EpiBf16<0>, pg8::StaticOrder, true, true>(ring, g, S, E); }
        { const int kv = (bx >> 5) & 1, ks = (bx >> 2) & 7; OneUnit S{bx & 3, 0, bx < 64};
          pg8::Gemm g{(const bf16*)(ws + (kv ? WS_CMPA_V : WS_CMPA_K)) + ks * 512, (const bf16*)(ws + (kv ? WS_W_C1V : WS_W_C1K)) + ks * 512, 1024, 256, 512, 2048, 4096};
          pg8::EpiF32 E{(float*)(ws + WS_H1P) + (size_t)(ks * 2 + kv) * 1024 * 256, 256, nullptr}; pg8::gemm_phase<pg8::EpiF32, OneUnit, false, true>(ring, g, S, E); }
    } SEAM(3);
    if (IN(4)) { ph_cmp2(args, c); } SEAM(4);
    if (IN(5)) { ph_nsa_fa(args, c); } SEAM(5);
    if (IN(6)) { ph_mla_fa(args, c); } SEAM(6);
    if (IN(7)) {
        static_assert(WS_OMLA == WS_ONSA + (size_t)NTOK * D * 2 && WS_W_BM == WS_W_BN + (size_t)D * D * 2, "stacked operands of the fused branch projection");
        pg8::Gemm g{(const bf16*)(ws + WS_ONSA), (const bf16*)(ws + WS_W_BN), 2 * NTOK, 2 * D, D, D, D}; PairOrder S; S.so.init(NTOK, D, c.G, bx);
        EpiMerge E{(bf16*)(ws + WS_MERGED), (const bf16*)(ws + WS_PROJ)}; pg8::gemm_phase<EpiMerge, PairOrder, true, true>(ring, g, S, E);
    }
    if (IN(8)) { } SEAM(8);
    if (IN(9)) { pg8::Gemm g{(const bf16*)(ws + WS_MERGED), (const bf16*)(ws + WS_W_MO), NTOK, D, D, D, D}; pg8::StaticOrder S; S.init(NTOK, D, c.G, bx);
        pg8::EpiF32 E{(float*)(ws + WS_Z), D, nullptr}; pg8::gemm_phase<pg8::EpiF32, pg8::StaticOrder, true, true>(ring, g, S, E); } SEAM(9);
    if (IN(10)) { ph_ln(c, args.in[I_X], (const float*)(ws + WS_Z), args.in[I_LN1G], args.in[I_LN1B], (float*)(ws + WS_X1), (bf16*)(ws + WS_X1B)); } SEAM(10);
    if (IN(11)) { pg8::Gemm g{(const bf16*)(ws + WS_X1B), (const bf16*)(ws + WS_W_MQ), NTOK, 512, D, D, D}; pg8::StaticOrder S; S.init(NTOK, 512, c.G, bx);
        pg8::EpiBf16<0> E{(bf16*)(ws + WS_QMEM), 512, nullptr, 0, 0, 1.f}; pg8::gemm_phase<pg8::EpiBf16<0>, pg8::StaticOrder, true, true>(ring, g, S, E);
        if (c.G > 64) { if (bx >= 64) peer_convert(args, (bx - 64) * NWAVES + c.wave, (c.G - 64) * NWAVES, c.lane); } else peer_convert(args, c.gw, c.ngw, c.lane); } SEAM(11);
    if (IN(12)) { ph_memattn_fa(args, c); } SEAM(12);
    if (IN(13)) { pg8::Gemm g{(const bf16*)(ws + WS_OMEM), (const bf16*)(ws + WS_W_MO2), NTOK, D, 512, 512, 512}; pg8::StaticOrder S; S.init(NTOK, D, c.G, bx);
        pg8::EpiF32 E{(float*)(ws + WS_Z), D, nullptr}; pg8::gemm_phase<pg8::EpiF32, pg8::StaticOrder, true, true>(ring, g, S, E); } SEAM(13);
    if (IN(14)) { ph_ln(c, (const float*)(ws + WS_X1), (const float*)(ws + WS_Z), args.in[I_LN2G], args.in[I_LN2B], (float*)(ws + WS_X2), (bf16*)(ws + WS_X2B)); } SEAM(14);
    if (IN(15)) { pg8::Gemm g{(const bf16*)(ws + WS_X2B), (const bf16*)(ws + WS_W_PQ), NTOK, D, D, D, D}; pg8::StaticOrder S; S.init(NTOK, D, c.G, bx);
        pg8::EpiBf16<0> E{(bf16*)(ws + WS_PQB), D, nullptr, 0, 0, 1.f}; pg8::gemm_phase<pg8::EpiBf16<0>, pg8::StaticOrder, true, true>(ring, g, S, E); } SEAM(15);
    if (IN(16)) {
        pg8::Gemm g{(const bf16*)(ws + WS_PQB), (const bf16*)(ws + WS_KEYB), NTOK * 8, 256, 256, 256, 256}; pg8::StaticOrder S; S.init(NTOK * 8, 256, c.G, bx);
        pg8::EpiF32 E{(float*)(ws + WS_S), 256, nullptr}; pg8::gemm_phase<pg8::EpiF32, pg8::StaticOrder, true, true>(ring, g, S, E); } SEAM(16);
    if (IN(17)) { ph_peer_select2(args, c); } SEAM(17);
    if (IN(18)) { ph_peer_ffn(args, c); }
#undef IN
#undef SEAM
}

extern "C" void kernel_launch(void* const* d_in, const int* in_sizes, int n_in, void* d_out, int out_size, void* d_ws, size_t ws_size, hipStream_t stream) {
    static int grid = 0;
    if (grid == 0) {
        if (n_in != N_IN || in_sizes[0] != NTOK * D || out_size != NTOK * D || ws_size < WS_END) { fprintf(stderr, "kernel_launch: unexpected shapes (n_in %d, in0 %d, out %d, ws %zu)\n", n_in, n_in > 0 ? in_sizes[0] : -1, out_size, ws_size); grid = -1; return; }
        int dev = 0, cus = 0, per_cu = 0;
        if (hipGetDevice(&dev) != hipSuccess || hipDeviceGetAttribute(&cus, hipDeviceAttributeMultiprocessorCount, dev) != hipSuccess) { grid = -1; return; }
        if (hipFuncSetAttribute((const void*)fwd, hipFuncAttributeMaxDynamicSharedMemorySize, LDS_BYTES) != hipSuccess) { fprintf(stderr, "kernel_launch: hipFuncSetAttribute failed\n"); grid = -1; return; }
        if (hipOccupancyMaxActiveBlocksPerMultiprocessor(&per_cu, (const void*)fwd, NTHREADS, LDS_BYTES) != hipSuccess || per_cu < 1) fprintf(stderr, "kernel_launch: occupancy query reports %d\n", per_cu);
        (void)hipGetLastError();
        grid = cus;
    }
    if (grid < 0) return;
    (void)hipMemsetAsync((char*)d_ws + WS_CTL, 0, CTL_ZERO_BYTES, stream);
    Args a{};
    for (int i = 0; i < N_IN; ++i) a.in[i] = (const float*)d_in[i];
    a.out = (float*)d_out; a.ws = (unsigned char*)d_ws;
    if (N_LAUNCHES == 1) { a.ph_lo = 0; a.ph_hi = N_PHASES; hipLaunchKernelGGL(fwd, dim3(grid), dim3(NTHREADS), LDS_BYTES, stream, a); }
    else for (int p = 0; p < N_PHASES; ++p) { a.ph_lo = p; a.ph_hi = p + 1; hipLaunchKernelGGL(fwd, dim3(grid), dim3(NTHREADS), LDS_BYTES, stream, a); }
    const hipError_t le = hipPeekAtLastError();
    if (le != hipSuccess) fprintf(stderr, "kernel_launch: launch failed: %s\n", hipGetErrorName(le));
}
```

```cpp
#include <hip/hip_runtime.h>
#include <cstdio>
#include <cstdint>
#ifndef N_LAUNCHES
#define N_LAUNCHES 1
#endif
namespace pg8 {
#define PG8_LAS __attribute__((address_space(3)))
typedef unsigned short bf16_t;
typedef short bf16x8 __attribute__((ext_vector_type(8)));
typedef float f32x4 __attribute__((ext_vector_type(4)));
typedef unsigned u32x4 __attribute__((ext_vector_type(4)));
constexpr int BM = 256, BK = 64, HALF = 128, HTB = HALF * BK * 2  , STAGE_BYTES = 8 * HTB, NXCD = 8, WGM = 8;

__host__ __device__ __forceinline__ int lds_byte(int r, int c) { const int st = (r >> 4) * 2 + (c >> 5), rr = r & 15, cc = c & 31, ob = rr * 64 + cc * 2; return st * 1024 + (ob ^ (((ob >> 9) & 1) << 5)); }
__host__ __device__ __forceinline__ void stage_rc(int b, int& R, int& C) { const int st = b / 1024, sb = b % 1024, swz = sb ^ (((sb >> 9) & 1) << 5); R = (st >> 1) * 16 + swz / 64; C = (st & 1) * 32 + (swz % 64) / 2; }
__host__ __device__ __forceinline__ int perm32(int rho) { const int n = rho >> 4, i = rho & 15; return 8 * (i >> 2) + 4 * n + (i & 3); }

struct Unit { int pm, pn; };
struct Gemm { const bf16_t* A; const bf16_t* Bt; int M, N, K, lda, ldb; };

struct StaticOrder {
    int nM, nN, nwg, G, c;
    __host__ __device__ void init(int M, int N, int G_, int c_) { nM = M / BM; nN = N / BM; nwg = nM * nN; G = G_; c = c_; }
    __host__ __device__ bool next(int i, Unit& u) const {
        const long L = (long)i * G + c; if (L >= nwg) return false;
        int wgid = (int)L; { const int q = nwg / NXCD, r = nwg % NXCD, xcd = wgid % NXCD, off = wgid / NXCD; wgid = (xcd < r ? xcd * (q + 1) : r * (q + 1) + (xcd - r) * q) + off; }
        const int nig = WGM * nN, gid = wgid / nig, fm = gid * WGM, gsz = (nM - fm) < WGM ? (nM - fm) : WGM;
        u.pm = fm + ((wgid % nig) % gsz); u.pn = (wgid % nig) / gsz; return true;
    }
    __device__ __forceinline__ void a_ready(const Unit&) const {}
    __device__ __forceinline__ void done(const Unit&) const {}
};

__device__ __forceinline__ unsigned cvt_pk_bf16(float lo, float hi) { unsigned r; asm volatile("v_cvt_pk_bf16_f32 %0, %1, %2" : "=v"(r) : "v"(lo), "v"(hi)); return r; }
typedef float f32x2 __attribute__((ext_vector_type(2)));
__device__ __forceinline__ f32x2 gelu_pk(f32x2 v) {
    const f32x2 av = __builtin_elementwise_abs(v), d = av * 0.2316418882f + 1.0f;
    f32x2 t; t.x = __builtin_amdgcn_rcpf(d.x); t.y = __builtin_amdgcn_rcpf(d.y);
    f32x2 q = t * 0.5307027145f + (-0.7265760135f); q = q * t + 0.7107068705f; q = q * t + (-0.142248368f); q = q * t + 0.127414796f; q = q * t;
    const f32x2 s = (v * v) * (-0.72134752044f);
    f32x2 e; e.x = __builtin_amdgcn_exp2f(s.x); e.y = __builtin_amdgcn_exp2f(s.y);
    const f32x2 m = v * (q * e), r = v - m;
    f32x2 o; o.x = v.x < 0.f ? m.x : r.x; o.y = v.y < 0.f ? m.y : r.y; return o;
}

template <int ACT  > struct EpiBf16 {
    static constexpr bool PERM = true, AFTER_DRAIN = false; static_assert(ACT == 0 || ACT == 1, "EpiBf16: ACT is 0 (none) or 1 (gelu_pk)");
    bf16_t* O; int ldc; const float* bias; int split_cols; size_t split_stride; float scale0;
    __device__ __forceinline__ void operator()(const f32x4 (&acc)[2][2][4][2], const Unit& u, int wr, int wc, int fr, int fq) const {
        const int row0 = u.pm * BM + wr * 64 + fr; int colt = u.pn * BM; bf16_t* base = O;
        float sc = 1.f; if (split_cols) { const int t = colt / split_cols; base += (size_t)t * split_stride; colt -= t * split_cols; if (t == 0) sc = scale0; }
        const int col0 = colt + wc * 32 + 8 * fq, bcol0 = u.pn * BM + wc * 32 + 8 * fq;
        f32x4 bv[2][2];
#pragma unroll
        for (int bj = 0; bj < 2; ++bj)
#pragma unroll
            for (int n = 0; n < 2; ++n) bv[bj][n] = bias ? *(const f32x4*)(bias + bcol0 + bj * HALF + 4 * n) : (f32x4){0.f, 0.f, 0.f, 0.f};
#pragma unroll
        for (int ai = 0; ai < 2; ++ai)
#pragma unroll
            for (int m = 0; m < 4; ++m) { bf16_t* rowp = base + (size_t)(row0 + ai * HALF + m * 16) * ldc + col0;
#pragma unroll
                for (int bj = 0; bj < 2; ++bj) { f32x4 v0 = acc[ai][bj][m][0] + bv[bj][0], v1 = acc[ai][bj][m][1] + bv[bj][1];
                    if (ACT == 1) { f32x2 a = gelu_pk((f32x2){v0[0], v0[1]}), b = gelu_pk((f32x2){v0[2], v0[3]}), c = gelu_pk((f32x2){v1[0], v1[1]}), d = gelu_pk((f32x2){v1[2], v1[3]});
                        v0 = (f32x4){a.x, a.y, b.x, b.y}; v1 = (f32x4){c.x, c.y, d.x, d.y}; }
                    v0 = v0 * sc; v1 = v1 * sc; u32x4 w; w.x = cvt_pk_bf16(v0[0], v0[1]); w.y = cvt_pk_bf16(v0[2], v0[3]); w.z = cvt_pk_bf16(v1[0], v1[1]); w.w = cvt_pk_bf16(v1[2], v1[3]);
                    *(u32x4*)(rowp + bj * HALF) = w; } }
    }
};
struct EpiF32 {
    static constexpr bool PERM = false, AFTER_DRAIN = false;
    float* C; int ldc; const float* bias;
    __device__ __forceinline__ void operator()(const f32x4 (&acc)[2][2][4][2], const Unit& u, int wr, int wc, int fr, int fq) const {
        const int row0 = u.pm * BM + wr * 64 + fr, col0 = u.pn * BM + wc * 32 + 4 * fq;
        f32x4 bv[2][2];
#pragma unroll
        for (int bj = 0; bj < 2; ++bj)
#pragma unroll
            for (int n = 0; n < 2; ++n) bv[bj][n] = bias ? *(const f32x4*)(bias + col0 + bj * HALF + n * 16) : (f32x4){0.f, 0.f, 0.f, 0.f};
#pragma unroll
        for (int ai = 0; ai < 2; ++ai)
#pragma unroll
            for (int m = 0; m < 4; ++m) { float* rowp = C + (size_t)(row0 + ai * HALF + m * 16) * ldc + col0;
#pragma unroll
                for (int bj = 0; bj < 2; ++bj)
#pragma unroll
                    for (int n = 0; n < 2; ++n) *(f32x4*)(rowp + bj * HALF + n * 16) = acc[ai][bj][m][n] + bv[bj][n]; }
    }
};
template <class Epi, class Sched, bool ALIGN_EPI = false, bool SP2 = false>
__device__ __forceinline__ void gemm_phase(PG8_LAS unsigned char* lds, const Gemm g, const Sched& S, const Epi& E) {
    const int tid = threadIdx.x, wid = __builtin_amdgcn_readfirstlane(tid >> 6), lane = tid & 63, wr = wid >> 2, wc = wid & 3, fr = lane & 15, fq = lane >> 4;
    const int K = g.K, nt = K / BK;
    unsigned voffA[2], voffB[2];
#pragma unroll
    for (int i = 0; i < 2; ++i) { int R, C; stage_rc(tid * 16 + i * 8192, R, C); const int Rb = Epi::PERM ? ((R & ~31) + perm32(R & 31)) : R;
        voffA[i] = (unsigned)(R * g.lda + C) * 2u; voffB[i] = (unsigned)(Rb * g.ldb + C) * 2u; }
    const size_t kstep = (size_t)(BK * 2);
    const size_t hstepA = (size_t)HALF * g.lda * 2, hstepB = (size_t)HALF * g.ldb * 2;
    const size_t tstepA = 2 * hstepA, tstepB = 2 * hstepB;
    const unsigned ldsw = (unsigned)wid * 1024u;
    const int aoff = lds_byte(wr * 64 + fr, fq * 8), boff = lds_byte(wc * 32 + fr, fq * 8);
#define PG8_SA(b, h) (((b) * 2 + (h)) * HTB)
#define PG8_SB(b, h) ((4 + (b) * 2 + (h)) * HTB)
#define PG8_STAGE(bufoff, gbase, voff) do { _Pragma("unroll") for (int _i = 0; _i < 2; ++_i) \
        __builtin_amdgcn_global_load_lds((const unsigned*)((const char*)(gbase) + (voff)[_i]), (PG8_LAS unsigned*)(lds + (bufoff) + ldsw + _i * 8192), 16, 0, 0); } while (0)
#define PG8_LDA(dst, b, h) do { _Pragma("unroll") for (int m = 0; m < 4; ++m) _Pragma("unroll") for (int k = 0; k < 2; ++k) dst[m][k] = *(const PG8_LAS bf16x8*)(lds + PG8_SA(b, h) + aoff + m * 2048 + k * 1024); } while (0)
#define PG8_LDB(dst, b, h) do { _Pragma("unroll") for (int n = 0; n < 2; ++n) _Pragma("unroll") for (int k = 0; k < 2; ++k) dst[n][k] = *(const PG8_LAS bf16x8*)(lds + PG8_SB(b, h) + boff + n * 2048 + k * 1024); } while (0)
#define PG8_MMA(ai, bj, At, Bt) do { __builtin_amdgcn_s_setprio(1); _Pragma("unroll") for (int m = 0; m < 4; ++m) _Pragma("unroll") for (int n = 0; n < 2; ++n) _Pragma("unroll") for (int k = 0; k < 2; ++k) \
        acc[ai][bj][m][n] = __builtin_amdgcn_mfma_f32_16x16x32_bf16(Bt[n][k], At[m][k], acc[ai][bj][m][n], 0, 0, 0); __builtin_amdgcn_s_setprio(0); } while (0)
#define PG8_WAIT_V(n) asm volatile("s_waitcnt vmcnt(" #n ")" ::: "memory")
#define PG8_WAIT_L(n) asm volatile("s_waitcnt lgkmcnt(" #n ")" ::: "memory")
#define PG8_BAR __builtin_amdgcn_s_barrier()
#define PG8_SCHED __builtin_amdgcn_sched_barrier(0)
    Unit cur, nxt; int ui = 0;
    if (!S.next(0, cur)) return;
    f32x4 acc[2][2][4][2];
#pragma unroll
    for (int a = 0; a < 2; ++a)
#pragma unroll
        for (int b = 0; b < 2; ++b)
#pragma unroll
            for (int m = 0; m < 4; ++m)
#pragma unroll
                for (int n = 0; n < 2; ++n) acc[a][b][m][n] = (f32x4){0.f, 0.f, 0.f, 0.f};
    bf16x8 At[4][2], B0[2][2], B1[2][2];
    const char* cA = (const char*)g.A + (size_t)cur.pm * tstepA; const char* cB = (const char*)g.Bt + (size_t)cur.pn * tstepB;
    S.a_ready(cur);
    if constexpr (SP2) {
        PG8_STAGE(PG8_SB(0, 0), cB, voffB); PG8_STAGE(PG8_SB(0, 1), cB + hstepB, voffB); PG8_STAGE(PG8_SA(0, 0), cA, voffA); PG8_STAGE(PG8_SA(0, 1), cA + hstepA, voffA);
        if (wr == 1) PG8_BAR;
        PG8_WAIT_V(2); PG8_BAR;
        PG8_STAGE(PG8_SB(1, 0), cB + kstep, voffB); PG8_STAGE(PG8_SA(1, 0), cA + kstep, voffA); PG8_STAGE(PG8_SB(1, 1), cB + hstepB + kstep, voffB);
        PG8_WAIT_V(6); PG8_BAR;
    } else {
        PG8_STAGE(PG8_SB(0, 0), cB, voffB); PG8_STAGE(PG8_SA(0, 0), cA, voffA); PG8_STAGE(PG8_SB(0, 1), cB + hstepB, voffB); PG8_STAGE(PG8_SA(0, 1), cA + hstepA, voffA);
        if (wr == 1) PG8_BAR;
        PG8_WAIT_V(4); PG8_BAR;
        PG8_STAGE(PG8_SB(1, 0), cB + kstep, voffB); PG8_STAGE(PG8_SA(1, 0), cA + kstep, voffA); PG8_STAGE(PG8_SB(1, 1), cB + hstepB + kstep, voffB);
        PG8_WAIT_V(6); PG8_BAR;
    }
    for (;;) {
        const bool has_next = S.next(ui + 1, nxt);
        const char* nA = has_next ? (const char*)g.A + (size_t)nxt.pm * tstepA : cA; const char* nB = has_next ? (const char*)g.Bt + (size_t)nxt.pn * tstepB : cB;
        for (int t = 0; t < nt; t += 2) {
            const bool last = (t == nt - 2);
            const char* a1 = cA + (size_t)(t + 1) * kstep;
            const char* a2 = last ? nA : cA + (size_t)(t + 2) * kstep; const char* b2 = last ? nB : cB + (size_t)(t + 2) * kstep;
            const char* a3 = a2 + kstep; const char* b3 = b2 + kstep;
            if (last && has_next) S.a_ready(nxt);
            if constexpr (SP2) {
            PG8_LDB(B0, 0, 0); PG8_LDB(B1, 0, 1); PG8_SCHED; PG8_LDA(At, 0, 0); PG8_STAGE(PG8_SA(1, 1), a1 + hstepA, voffA);
            PG8_WAIT_V(8); PG8_WAIT_L(0); PG8_BAR; PG8_MMA(0, 0, At, B0); PG8_MMA(0, 1, At, B1); PG8_BAR; PG8_SCHED;
            PG8_LDA(At, 0, 1); PG8_STAGE(PG8_SB(0, 0), b2, voffB); PG8_STAGE(PG8_SB(0, 1), b2 + hstepB, voffB); PG8_STAGE(PG8_SA(0, 0), a2, voffA);
            PG8_WAIT_V(8); PG8_WAIT_L(0); PG8_BAR; PG8_MMA(1, 0, At, B0); PG8_MMA(1, 1, At, B1); PG8_BAR; PG8_SCHED;
            PG8_LDB(B0, 1, 0); PG8_LDB(B1, 1, 1); PG8_SCHED; PG8_LDA(At, 1, 0); PG8_STAGE(PG8_SA(0, 1), a2 + hstepA, voffA);
            PG8_WAIT_V(8); PG8_WAIT_L(0); PG8_BAR; PG8_MMA(0, 0, At, B0); PG8_MMA(0, 1, At, B1); PG8_BAR; PG8_SCHED;
            PG8_LDA(At, 1, 1); PG8_STAGE(PG8_SB(1, 0), b3, voffB); PG8_STAGE(PG8_SB(1, 1), b3 + hstepB, voffB); PG8_STAGE(PG8_SA(1, 0), a3, voffA);
            PG8_WAIT_V(8); PG8_WAIT_L(0); PG8_BAR; PG8_MMA(1, 0, At, B0); PG8_MMA(1, 1, At, B1); PG8_BAR; PG8_SCHED;
            } else {
            PG8_LDB(B0, 0, 0); PG8_SCHED; PG8_LDA(At, 0, 0); PG8_STAGE(PG8_SA(1, 1), a1 + hstepA, voffA);
            PG8_WAIT_L(8); PG8_BAR; PG8_WAIT_L(0); PG8_MMA(0, 0, At, B0); PG8_BAR; PG8_SCHED;
            PG8_LDB(B1, 0, 1); PG8_STAGE(PG8_SB(0, 0), b2, voffB);
            PG8_BAR; PG8_WAIT_L(0); PG8_MMA(0, 1, At, B1); PG8_BAR;
            PG8_LDA(At, 0, 1); PG8_STAGE(PG8_SA(0, 0), a2, voffA);
            PG8_BAR; PG8_WAIT_L(0); PG8_MMA(1, 0, At, B0); PG8_BAR; PG8_SCHED;
            PG8_STAGE(PG8_SB(0, 1), b2 + hstepB, voffB);
            PG8_WAIT_V(6); PG8_BAR; PG8_MMA(1, 1, At, B1); PG8_BAR;
            PG8_LDB(B0, 1, 0); PG8_SCHED; PG8_LDA(At, 1, 0); PG8_STAGE(PG8_SA(0, 1), a2 + hstepA, voffA);
            PG8_WAIT_L(8); PG8_BAR; PG8_WAIT_L(0); PG8_MMA(0, 0, At, B0); PG8_BAR; PG8_SCHED;
            PG8_LDB(B1, 1, 1); PG8_STAGE(PG8_SB(1, 0), b3, voffB);
            PG8_BAR; PG8_WAIT_L(0); PG8_MMA(0, 1, At, B1); PG8_BAR;
            PG8_LDA(At, 1, 1); PG8_STAGE(PG8_SA(1, 0), a3, voffA);
            PG8_BAR; PG8_WAIT_L(0); PG8_MMA(1, 0, At, B0); PG8_BAR; PG8_SCHED;
            PG8_STAGE(PG8_SB(1, 1), b3 + hstepB, voffB);
            PG8_WAIT_V(6); PG8_BAR; PG8_MMA(1, 1, At, B1); PG8_BAR;
            }
        }
        if constexpr (ALIGN_EPI) { if (wr == 0) PG8_BAR; }
        if constexpr (!Epi::AFTER_DRAIN) { E(acc, cur, wr, wc, fr, fq); S.done(cur); }
        if (!has_next) break;
#pragma unroll
        for (int a = 0; a < 2; ++a)
#pragma unroll
            for (int b = 0; b < 2; ++b)
#pragma unroll
                for (int m = 0; m < 4; ++m)
#pragma unroll
                    for (int n = 0; n < 2; ++n) acc[a][b][m][n] = (f32x4){0.f, 0.f, 0.f, 0.f};
        cur = nxt; cA = nA; cB = nB; ++ui;
        if constexpr (ALIGN_EPI) { if (wr == 1) PG8_BAR; }
    }
    PG8_WAIT_V(0);
    if constexpr (!ALIGN_EPI) { if (wr == 0) PG8_BAR; }
    PG8_BAR;
    if constexpr (Epi::AFTER_DRAIN) { E.fused(acc, cur, wr, wc, fr, fq, lds, wid, lane); S.done(cur); }
#undef PG8_SA
#undef PG8_SB
#undef PG8_STAGE
#undef PG8_LDA
#undef PG8_LDB
#undef PG8_MMA
#undef PG8_WAIT_V
#undef PG8_WAIT_L
#undef PG8_BAR
#undef PG8_SCHED
}
}

constexpr int BATCH = 2, T = 4096, D = 2048, NTOK = BATCH * T, NMEM = 256;
constexpr int NCOMB = 11376, NCOMBP = 11520;
constexpr int OFF_NSA_KV = 2048, OFF_NSA_GATE = 3584, OFF_MLA_Q = 3632, OFF_MLA_KV = 6704, OFF_MERGE = 7280;
constexpr float ALPHA = 1.189207115002721f;
constexpr float NSA_SCALE = 0.08838834764831845f, MLA_SCALE = 0.07216878364870323f, MEM_SCALE = 0.08838834764831845f;
enum { I_X = 0, I_MEM, I_RELB, I_WIN, I_CKPE, I_CKW1, I_CKW2, I_CVPE, I_CVW1, I_CVW2, I_KVNORM, I_WUK, I_WUV, I_WBN, I_WBM, I_WMO, I_LN1G, I_LN1B,
       I_MWQ, I_MWK, I_MWV, I_MWO, I_LN2G, I_LN2B, I_PWQ, I_PKEYS, I_PU, I_PV, I_LN3G, I_LN3B, N_IN };

constexpr size_t MiB = 1u << 20;
constexpr size_t WS_CTL = 0, CTL_ZERO_BYTES = 1 * MiB;
constexpr size_t WS_W_IN = 1 * MiB, WS_W_UKV = 46 * MiB, WS_W_BN = 50 * MiB, WS_W_BM = 58 * MiB, WS_W_MO = 66 * MiB, WS_W_MQ = 74 * MiB, WS_W_MKV = 76 * MiB, WS_W_MO2 = 80 * MiB,
                 WS_W_PQ = 82 * MiB, WS_W_C1K = 90 * MiB, WS_W_C1V = 92 * MiB;
constexpr size_t WS_CVEC = 94 * MiB, WS_CVECP = 94 * MiB + 4096  , WS_KCVC = 95 * MiB, WS_H1 = 96 * MiB, WS_SEL = 98 * MiB, WS_KVMEM = 99 * MiB, WS_MEMB = 100 * MiB, WS_KPE = 102 * MiB;
constexpr size_t WS_PROJ = 106 * MiB;
constexpr size_t WS_X1 = 106 * MiB, WS_X2 = 170 * MiB, WS_X1B = 234 * MiB, WS_QMEM = 266 * MiB, WS_OMEM = 274 * MiB;
constexpr size_t WS_KVUP = 286 * MiB, WS_Z = 286 * MiB;
constexpr size_t WS_XB = 350 * MiB, WS_ONSA = 350 * MiB, WS_X2B = 350 * MiB;
constexpr size_t WS_OMLA = 382 * MiB, WS_PQ = 382 * MiB;
constexpr size_t WS_CKVN = 414 * MiB, WS_CMPA_K = 422 * MiB, WS_CMPA_V = 422 * MiB + 4 * MiB + 65536, WS_YN = 414 * MiB;
constexpr size_t WS_YM = 446 * MiB, WS_PIDX = 446 * MiB, WS_PGATE = 450 * MiB;
constexpr size_t WS_MERGED = 478 * MiB, WS_END = 512 * MiB;
constexpr size_t WS_S = 106 * MiB, WS_KEYB = 103 * MiB, WS_PQB = 382 * MiB;
constexpr size_t WS_ROPE = 104 * MiB;
constexpr int CW_BAR = 4096;

constexpr int RING_BYTES = 131072, LDSCTL_OFF = RING_BYTES, MISC_OFF = LDSCTL_OFF + 320, LDS_BYTES = 147456;
constexpr int NWAVES = 8, NTHREADS = 512;

#define LAS __attribute__((address_space(3)))
typedef unsigned short bf16;
typedef unsigned v4u __attribute__((ext_vector_type(4)));
typedef float f32x4 __attribute__((ext_vector_type(4)));
#define LDS_WAIT() asm volatile("s_waitcnt lgkmcnt(0)" ::: "memory")

__device__ __forceinline__ unsigned f2bf(float f) { unsigned u = __builtin_bit_cast(unsigned, f); return (u + 0x7fffu + ((u >> 16) & 1u)) >> 16; }
__device__ __forceinline__ unsigned pk2(float lo, float hi) { return f2bf(lo) | (f2bf(hi) << 16); }
__device__ __forceinline__ float bf2f(bf16 h) { return __builtin_bit_cast(float, (unsigned)h << 16); }
__device__ __forceinline__ float lo_bf(unsigned w) { return __builtin_bit_cast(float, w << 16); }
__device__ __forceinline__ float hi_bf(unsigned w) { return __builtin_bit_cast(float, w & 0xffff0000u); }
__device__ __forceinline__ float wave_sum(float v) {
#pragma unroll
    for (int o = 1; o < 64; o <<= 1) v += __shfl_xor(v, o);
    return v;
}
__device__ __forceinline__ float wave_max(float v) {
#pragma unroll
    for (int o = 1; o < 64; o <<= 1) v = fmaxf(v, __shfl_xor(v, o));
    return v;
}
__device__ __forceinline__ int wave_min_i(int v) {
#pragma unroll
    for (int o = 1; o < 64; o <<= 1) { const int w = __shfl_xor(v, o); v = w < v ? w : v; }
    return v;
}
__device__ __forceinline__ float sigmoidf_(float x) { return 1.f / (1.f + expf(-x)); }
__device__ __forceinline__ float sigmoid_fast(float x) { return __builtin_amdgcn_rcpf(1.f + __builtin_amdgcn_exp2f(-1.4426950408889634f * x)); }
__device__ __forceinline__ float gelu_tanh(float x) { return 0.5f * x * (1.f + tanhf(0.7978845608028654f * (x + 0.044715f * x * x * x))); }
__device__ __forceinline__ int t5_bucket(int dist) {
    if (dist < 16) return dist;
    const int b = 8 + (31 - __clz(dist * dist));
    return b < 31 ? b : 31;
}

#define XB_TMO      128
#define XB_XCNT(j)  (256  + 64 * (j))
#define XB_XSUB(j)  (1280 + 64 * (j))
#define XB_XGEN(j)  (2304 + 64 * (j))
#define XB_TOP      3328
#define XB_TOPGEN   3392
#define XCD_BAR_WORDS 3456
#define XB_SPIN_CAP (1u << 18)

__device__ __forceinline__ unsigned xb_ld(unsigned* p)              { return __hip_atomic_load(p, __ATOMIC_RELAXED, __HIP_MEMORY_SCOPE_AGENT); }
__device__ __forceinline__ unsigned xb_add(unsigned* p, unsigned v) { return __hip_atomic_fetch_add(p, v, __ATOMIC_RELAXED, __HIP_MEMORY_SCOPE_AGENT); }
__device__ __forceinline__ unsigned xb_xcc_id() { return (unsigned)__builtin_amdgcn_s_getreg((3 << 11) | 20) & 0xFu; }
#define XB_SPIN(cond, bar) do { unsigned _sp = 0; while (cond) { __builtin_amdgcn_s_sleep(1); \
    if ((++_sp & 255u) == 0u) { if (xb_ld(&(bar)[XB_TMO])) break; if (_sp > XB_SPIN_CAP) { atomicAdd(&(bar)[XB_TMO], 1u); break; } } } } while (0)

struct XcdBarrier {
    unsigned* bar; unsigned x;
    volatile LAS unsigned* st;
};

__device__ __forceinline__ XcdBarrier xcd_barrier_post(unsigned* bar, volatile LAS unsigned* st) {
    XcdBarrier b; b.bar = bar; b.x = xb_xcc_id(); b.st = st;
    if (threadIdx.x == 0) (void)xb_add(&bar[XB_XCNT(b.x)], 1u);
    return b;
}
__device__ __forceinline__ void xcd_barrier_complete(unsigned* bar, unsigned x, unsigned& nloc, unsigned& nx) {
    const unsigned G = gridDim.x * gridDim.y * gridDim.z;
    unsigned sum, cnt, mine, sp = 0u;
    for (;;) {
        sum = 0u; cnt = 0u; mine = 0u;
#pragma unroll
        for (unsigned j = 0; j < 16; ++j) { const unsigned c = xb_ld(&bar[XB_XCNT(j)]); sum += c; cnt += (c > 0u) ? 1u : 0u; mine = (j == x) ? c : mine; }
        if (sum == G) break;
        __builtin_amdgcn_s_sleep(1);
        if ((++sp & 255u) == 0u) { if (xb_ld(&bar[XB_TMO])) break; if (sp > XB_SPIN_CAP) { atomicAdd(&bar[XB_TMO], 1u); break; } }
    }
    nloc = mine > 0u ? mine : 1u; nx = cnt > 0u ? cnt : 1u;
}

__device__ __forceinline__ void xcd_barrier(const XcdBarrier& b) {
    asm volatile("s_waitcnt vmcnt(0)" ::: "memory");
    __syncthreads();
    if (threadIdx.x == 0) {
        unsigned* bar = b.bar;
        __builtin_amdgcn_s_waitcnt(0);
        unsigned nloc = b.st[0], nx = b.st[1];
        if (nloc == 0u) { xcd_barrier_complete(bar, b.x, nloc, nx); b.st[0] = nloc; b.st[1] = nx; }
        const unsigned old = xb_add(&bar[XB_XSUB(b.x)], 1u);
        const unsigned gen = old / nloc;
        if (old + 1u == (gen + 1u) * nloc) {
            __builtin_amdgcn_fence(__ATOMIC_RELEASE, "agent");
            asm volatile("s_waitcnt vmcnt(0)" ::: "memory");
            const unsigned og = xb_add(&bar[XB_TOP], 1u);
            const unsigned tg = og / nx;
            if (og + 1u == (tg + 1u) * nx) xb_add(&bar[XB_TOPGEN], 1u);
            else XB_SPIN(xb_ld(&bar[XB_TOPGEN]) == tg, bar);
            __builtin_amdgcn_fence(__ATOMIC_ACQUIRE, "agent");
            xb_add(&bar[XB_XGEN(b.x)], 1u);
            asm volatile("s_waitcnt vmcnt(0)" ::: "memory");
        } else {
            XB_SPIN(xb_ld(&bar[XB_XGEN(b.x)]) == gen, bar);
            __builtin_amdgcn_fence(__ATOMIC_ACQUIRE, "agent");
            asm volatile("s_waitcnt vmcnt(0)" ::: "memory");
        }
    }
    __syncthreads();
}

struct Args { const float* in[N_IN]; float* out; unsigned char* ws; int ph_lo, ph_hi; };
struct Ctx { LAS unsigned char* lds; int tid, lane, wave, gw, ngw, G; };


__device__ __forceinline__ unsigned fkey(float x) { const unsigned u = __float_as_uint(x); return u ^ ((unsigned)((int)u >> 31) | 0x80000000u); }
__device__ __forceinline__ float funkey(unsigned k) { return __uint_as_float((k & 0x80000000u) ? (k ^ 0x80000000u) : ~k); }
template <int CTRL> __device__ __forceinline__ unsigned dppu(unsigned v) { return (unsigned)__builtin_amdgcn_update_dpp((int)v, (int)v, CTRL, 0xF, 0xF, false); }
__device__ __forceinline__ unsigned row16_max_u(unsigned v) {
    unsigned t = dppu<0xB1>(v); v = v > t ? v : t; t = dppu<0x4E>(v); v = v > t ? v : t; t = dppu<0x141>(v); v = v > t ? v : t; t = dppu<0x140>(v); v = v > t ? v : t; return v; }
__device__ __forceinline__ float row16_sum_f(float v) {
    v += __uint_as_float(dppu<0xB1>(__float_as_uint(v))); v += __uint_as_float(dppu<0x4E>(__float_as_uint(v))); v += __uint_as_float(dppu<0x141>(__float_as_uint(v))); v += __uint_as_float(dppu<0x140>(__float_as_uint(v))); return v; }
#define PEER_CE(x, y) do { const unsigned hi_ = (x) > (y) ? (x) : (y), lo_ = (x) > (y) ? (y) : (x); (x) = hi_; (y) = lo_; } while (0)
__device__ __forceinline__ float wave_sum_u(float v) {
    v = row16_sum_f(v);
    const float s0 = __builtin_bit_cast(float, __builtin_amdgcn_readlane(__builtin_bit_cast(int, v), 0)), s1 = __builtin_bit_cast(float, __builtin_amdgcn_readlane(__builtin_bit_cast(int, v), 16));
    const float s2 = __builtin_bit_cast(float, __builtin_amdgcn_readlane(__builtin_bit_cast(int, v), 32)), s3 = __builtin_bit_cast(float, __builtin_amdgcn_readlane(__builtin_bit_cast(int, v), 48));
    return (s0 + s1) + (s2 + s3);
}
__device__ __forceinline__ int wave_sum_i(int v) {
    v += (int)dppu<0xB1>((unsigned)v); v += (int)dppu<0x4E>((unsigned)v); v += (int)dppu<0x141>((unsigned)v); v += (int)dppu<0x140>((unsigned)v);
    return (__builtin_amdgcn_readlane(v, 0) + __builtin_amdgcn_readlane(v, 16)) + (__builtin_amdgcn_readlane(v, 32) + __builtin_amdgcn_readlane(v, 48));
}
__device__ __forceinline__ float wave_max_u(float v) {
    unsigned k = row16_max_u(fkey(v));
    const unsigned a = (unsigned)__builtin_amdgcn_readlane((int)k, 0), b = (unsigned)__builtin_amdgcn_readlane((int)k, 16), c2 = (unsigned)__builtin_amdgcn_readlane((int)k, 32), d = (unsigned)__builtin_amdgcn_readlane((int)k, 48);
    const unsigned m1 = a > b ? a : b, m2 = c2 > d ? c2 : d; return funkey(m1 > m2 ? m1 : m2);
}

namespace fa {
typedef short bf16x8 __attribute__((ext_vector_type(8)));
typedef short s16x4 __attribute__((ext_vector_type(4)));
typedef float f32x16 __attribute__((ext_vector_type(16)));
#define FA_SBAR() __builtin_amdgcn_sched_barrier(0)
#define FA_VMW() asm volatile("s_waitcnt vmcnt(0)" ::: "memory")
constexpr int SHM_V = 16384, OFF_V = 0, OFF_K = 2 * SHM_V, OFF_AL = OFF_K + 2 * 24576, OFF_IMP = OFF_AL + 2048, OFF_SEL = OFF_IMP + 8448, LDS_END = OFF_SEL + 256;
static_assert(LDS_END <= RING_BYTES, "attention LDS map");
constexpr float LOG2E = 1.4426950408889634f, THR = 8.f;

__device__ __forceinline__ int v_st(int k, int c) { const int kk = (k & ~0xC) | ((k & 4) << 1) | ((k & 8) >> 1); return ((kk >> 3) * 4 + (c >> 5)) * 512 + ((kk & 7) * 32 + (c & 31)) * 2; }
__device__ __forceinline__ int v_rd_base(int lane) { return ((lane & 3) << 3) | (((lane >> 2) & 3) << 6) | (((lane >> 4) & 1) << 5) | (((lane >> 5) & 1) << 8); }
constexpr int v_rd_off(int d0, int ks, int half) { return d0 * 512 + ks * 4096 + half * 2048; }
__device__ __forceinline__ int crow(int r, int hi) { return (r & 3) + 8 * (r >> 2) + 4 * hi; }
__device__ __forceinline__ unsigned cvtpk(float lo, float hi) { unsigned r; asm volatile("v_cvt_pk_bf16_f32 %0, %1, %2" : "=v"(r) : "v"(lo), "v"(hi)); return r; }

template <int DQK> struct Geo {
    static constexpr int CPR = DQK / 8, ROWB = DQK * 2, SHM_K = 64 * ROWB, NPASS = SHM_K / 8192, NKS = DQK / 16;
    __device__ static __forceinline__ int swz(int row) { return DQK == 128 ? (row & 7) : ((row >> 1) & 7); }
    __device__ static __forceinline__ int off(int row, int chunk) { return row * ROWB + ((chunk ^ swz(row)) << 4); }
};

__device__ __forceinline__ void mask_tile(f32x16& p0, f32x16& p1, int dq, unsigned W) {
    const float NEG = -__builtin_inff();
#pragma unroll
    for (int r = 0; r < 16; ++r) { const int c = (r & 3) + 8 * (r >> 2);
        if ((unsigned)(dq - c) >= W) p0[r] = NEG;
        if ((unsigned)(dq - c - 32) >= W) p1[r] = NEG; }
}
__device__ __forceinline__ float half_max(float v) { auto rr = __builtin_amdgcn_permlane32_swap(__float_as_uint(v), __float_as_uint(v), false, false); return fmaxf(__uint_as_float(rr[0]), __uint_as_float(rr[1])); }
__device__ __forceinline__ float half_sum(float v) { auto rr = __builtin_amdgcn_permlane32_swap(__float_as_uint(v), __float_as_uint(v), false, false); return __uint_as_float(rr[0]) + __uint_as_float(rr[1]); }
__device__ __forceinline__ float row_max32(const f32x16& p0, const f32x16& p1) {
    float pmax = p0[0];
#pragma unroll
    for (int r = 1; r < 16; ++r) pmax = fmaxf(pmax, p0[r]);
#pragma unroll
    for (int r = 0; r < 16; ++r) pmax = fmaxf(pmax, p1[r]);
    return half_max(pmax);
}
__device__ __forceinline__ void partialSM(f32x16& p0, f32x16& p1, float& m_reg, float& mn, float& alpha) {
    const float pmax = row_max32(p0, p1);
    if (__builtin_expect(__all((pmax - m_reg) <= THR), 1)) { mn = m_reg; alpha = 1.f; }
    else { mn = fmaxf(m_reg, pmax); alpha = __builtin_amdgcn_exp2f((m_reg - mn) * LOG2E); m_reg = mn; }
    const float mnL = -mn * LOG2E;
#pragma unroll
    for (int r = 0; r < 16; ++r) p0[r] = fmaf(p0[r], LOG2E, mnL);
#pragma unroll
    for (int r = 0; r < 16; ++r) p1[r] = fmaf(p1[r], LOG2E, mnL);
#pragma unroll
    for (int r = 0; r < 16; ++r) p0[r] = __builtin_amdgcn_exp2f(p0[r]);
}
#define FA_PK4(P, B_, OUT) do { unsigned a0 = cvtpk(P[B_+0], P[B_+1]), a1 = cvtpk(P[B_+2], P[B_+3]);                          \
        unsigned b0 = cvtpk(P[B_+4], P[B_+5]), b1 = cvtpk(P[B_+6], P[B_+7]);                                             \
        auto r0 = __builtin_amdgcn_permlane32_swap(a0, b0, false, false); auto r1 = __builtin_amdgcn_permlane32_swap(a1, b1, false, false); \
        v4u w = {r0[0], r1[0], r0[1], r1[1]}; OUT = __builtin_bit_cast(bf16x8, w); } while (0)
__device__ __forceinline__ void finishSM(f32x16& p0, f32x16& p1, float alpha, float& l_reg, bf16x8& pa0, bf16x8& pa1, bf16x8& pa2, bf16x8& pa3) {
#pragma unroll
    for (int r = 0; r < 16; ++r) p1[r] = __builtin_amdgcn_exp2f(p1[r]);
    float ps = 0;
#pragma unroll
    for (int r = 0; r < 16; ++r) ps += p0[r];
#pragma unroll
    for (int r = 0; r < 16; ++r) ps += p1[r];
    ps = half_sum(ps);
    l_reg = l_reg * alpha + ps;
    FA_PK4(p0, 0, pa0); FA_PK4(p0, 8, pa1); FA_PK4(p1, 0, pa2); FA_PK4(p1, 8, pa3);
}
template <int DQK, int KB>
__device__ __forceinline__ void qkt(f32x16& p0, f32x16& p1, LAS const char* lds, int r32, int hi, const bf16x8 (&qr)[DQK / 16]) {
    using G = Geo<DQK>;
    p0 = f32x16{}; p1 = f32x16{};
    LAS const char* kb[4];
#pragma unroll
    for (int dd = 0; dd < 4; ++dd) kb[dd] = lds + OFF_K + KB * G::SHM_K + r32 * G::ROWB + (((2 * dd + hi) ^ G::swz(r32)) << 4);
    bf16x8 b0 = *(LAS const bf16x8*)kb[0], b1 = *(LAS const bf16x8*)(kb[0] + 32 * G::ROWB);
#pragma unroll
    for (int d0 = 0; d0 < G::NKS; ++d0) { bf16x8 n0 = b0, n1 = b1;
        if (d0 + 1 < G::NKS) { LAS const char* a = kb[(d0 + 1) & 3] + ((d0 + 1) >> 2) * 128; n0 = *(LAS const bf16x8*)a; n1 = *(LAS const bf16x8*)(a + 32 * G::ROWB); }
        p0 = __builtin_amdgcn_mfma_f32_32x32x16_bf16(b0, qr[d0], p0, 0, 0, 0);
        p1 = __builtin_amdgcn_mfma_f32_32x32x16_bf16(b1, qr[d0], p1, 0, 0, 0);
        FA_SBAR(); b0 = n0; b1 = n1; }
}
template <int VB>
__device__ __forceinline__ void pv_tile(f32x16 (&o)[4], int vb0, bf16x8 pa0, bf16x8 pa1, bf16x8 pa2, bf16x8 pa3) {
#define FA_TRRD(dst, off) asm volatile("ds_read_b64_tr_b16 %0, %1 offset:%2" : "=&v"(dst) : "v"(vb0), "i"(off) : "memory")
#define FA_PV_D0(d0) do { s16x4 l0, l1, l2, l3, h0, h1, h2, h3; constexpr int b_ = OFF_V + VB * SHM_V + v_rd_off(d0, 0, 0); \
        FA_TRRD(l0, b_); FA_TRRD(h0, b_ + 2048); FA_TRRD(l1, b_ + 4096); FA_TRRD(h1, b_ + 6144); FA_TRRD(l2, b_ + 8192); FA_TRRD(h2, b_ + 10240); FA_TRRD(l3, b_ + 12288); FA_TRRD(h3, b_ + 14336); \
        asm volatile("s_waitcnt lgkmcnt(0)" ::: "memory"); FA_SBAR(); \
        o[d0] = __builtin_amdgcn_mfma_f32_32x32x16_bf16(pa0, (bf16x8){l0[0], l0[1], l0[2], l0[3], h0[0], h0[1], h0[2], h0[3]}, o[d0], 0, 0, 0);   \
        o[d0] = __builtin_amdgcn_mfma_f32_32x32x16_bf16(pa1, (bf16x8){l1[0], l1[1], l1[2], l1[3], h1[0], h1[1], h1[2], h1[3]}, o[d0], 0, 0, 0);   \
        o[d0] = __builtin_amdgcn_mfma_f32_32x32x16_bf16(pa2, (bf16x8){l2[0], l2[1], l2[2], l2[3], h2[0], h2[1], h2[2], h2[3]}, o[d0], 0, 0, 0);   \
        o[d0] = __builtin_amdgcn_mfma_f32_32x32x16_bf16(pa3, (bf16x8){l3[0], l3[1], l3[2], l3[3], h3[0], h3[1], h3[2], h3[3]}, o[d0], 0, 0, 0); } while (0)
    FA_PV_D0(0); FA_PV_D0(1); FA_PV_D0(2); FA_PV_D0(3);
#undef FA_PV_D0
#undef FA_TRRD
}

template <int DQK, int MODE, class Pol>
__device__ __forceinline__ void attend(const Pol& P, LAS char* lds, const bf16x8 (&qr)[DQK / 16], unsigned long long tiles, f32x16 (&o)[4], float& m_reg, float& l_reg, const float il_fin, int tid, int wid, int lane) {
    using G = Geo<DQK>;
    if (tiles == 0ull) return;
    asm volatile("" : "+v"(tid), "+v"(lane));
    const int r32 = lane & 31, hi = lane >> 5;
    int koff[G::NPASS];
#pragma unroll
    for (int p = 0; p < G::NPASS; ++p) { const int L = tid + 512 * p; koff[p] = G::off(L / G::CPR, L % G::CPR); }
    const int sr = tid >> 4, sc = (tid & 15) * 8, vst0 = v_st(sr, sc), vst1 = v_st(32 + sr, sc);
    const int vb0 = (int)(unsigned)(uintptr_t)(lds) + v_rd_base(lane);
    LAS float* al_l = (LAS float*)(lds + OFF_AL) + wid * 64 + 32;
    bf16x8 sk[G::NPASS], sv0, sv1;
#define FA_ISSUE(j) do { _Pragma("unroll") for (int p_ = 0; p_ < G::NPASS; ++p_) sk[p_] = *(const bf16x8*)P.kptr(p_, (j)); \
        if (MODE != 1) { sv0 = *(const bf16x8*)P.vptr(0, (j)); sv1 = *(const bf16x8*)P.vptr(1, (j)); } } while (0)
#define FA_WRITE(bf) do { _Pragma("unroll") for (int p_ = 0; p_ < G::NPASS; ++p_) *(LAS bf16x8*)(lds + OFF_K + (bf) * G::SHM_K + koff[p_]) = sk[p_]; \
        if (MODE != 1) { *(LAS bf16x8*)(lds + OFF_V + (bf) * SHM_V + vst0) = sv0; *(LAS bf16x8*)(lds + OFF_V + (bf) * SHM_V + vst1) = sv1; } } while (0)
    int j = __builtin_ctzll(tiles); tiles &= tiles - 1;
    FA_ISSUE(j); FA_VMW(); FA_WRITE(0); __syncthreads();
#define FA_STEP(BF) do { \
        const int jn = tiles ? __builtin_ctzll(tiles) : -1; tiles &= tiles - 1; \
        if (jn >= 0) FA_ISSUE(jn); \
        FA_SBAR(); \
        if (P.act(j)) { f32x16 p0, p1; bf16x8 pa0, pa1, pa2, pa3; \
            qkt<DQK, BF>(p0, p1, lds, r32, hi, qr); \
            P.mod(p0, p1, j); \
            if (MODE == 0) { float mn, alpha; partialSM(p0, p1, m_reg, mn, alpha); \
                if (__any(alpha < 1.f)) { if (hi == 0) al_l[r32] = alpha; LDS_WAIT(); \
                    _Pragma("unroll") for (int d_ = 0; d_ < 4; ++d_) _Pragma("unroll") for (int r = 0; r < 16; ++r) o[d_][r] *= al_l[crow(r, hi)]; } \
                finishSM(p0, p1, alpha, l_reg, pa0, pa1, pa2, pa3); FA_SBAR(); \
                pv_tile<BF>(o, vb0, pa0, pa1, pa2, pa3); } \
            else if (MODE == 1) { const float pmax = row_max32(p0, p1), mn = fmaxf(m_reg, pmax), mnL = -mn * LOG2E; float ps = 0.f; \
                _Pragma("unroll") for (int r = 0; r < 16; ++r) ps += __builtin_amdgcn_exp2f(fmaf(p0[r], LOG2E, mnL)) + __builtin_amdgcn_exp2f(fmaf(p1[r], LOG2E, mnL)); \
                l_reg = l_reg * __builtin_amdgcn_exp2f((m_reg - mn) * LOG2E) + half_sum(ps); m_reg = mn; } \
            else { const float mnL = -m_reg * LOG2E; \
                _Pragma("unroll") for (int r = 0; r < 16; ++r) { p0[r] = __builtin_amdgcn_exp2f(fmaf(p0[r], LOG2E, mnL)) * il_fin; p1[r] = __builtin_amdgcn_exp2f(fmaf(p1[r], LOG2E, mnL)) * il_fin; } \
                P.post(p0, p1, j); \
                FA_PK4(p0, 0, pa0); FA_PK4(p0, 8, pa1); FA_PK4(p1, 0, pa2); FA_PK4(p1, 8, pa3); FA_SBAR(); \
                pv_tile<BF>(o, vb0, pa0, pa1, pa2, pa3); } } \
        FA_SBAR(); \
        if (jn >= 0) { FA_VMW(); FA_WRITE((BF) ^ 1); } \
        __syncthreads(); j = jn; } while (0)
    for (;;) { FA_STEP(0); if (j < 0) break; FA_STEP(1); if (j < 0) break; }
#undef FA_STEP
#undef FA_ISSUE
#undef FA_WRITE
}

__device__ __forceinline__ void scale_rows(f32x16 (&o)[4], float fac, LAS char* lds, int wid, int r32, int hi) {
    LAS float* li_l = (LAS float*)(lds + OFF_AL) + wid * 64;
    if (hi == 0) li_l[r32] = fac;
    LDS_WAIT();
#pragma unroll
    for (int r = 0; r < 16; ++r) { const float f = li_l[crow(r, hi)];
#pragma unroll
        for (int d0 = 0; d0 < 4; ++d0) o[d0][r] *= f; }
    LDS_WAIT();
}
__device__ __forceinline__ void store_bf16(const f32x16 (&o)[4], bf16* O, size_t ldo, int r32, int hi) {
#pragma unroll
    for (int r = 0; r < 16; ++r) { const int orow = crow(r, hi);
#pragma unroll
        for (int d0 = 0; d0 < 4; ++d0) { const float v = o[d0][r]; const float vn = __shfl_xor(v, 1);
            if ((r32 & 1) == 0) *(unsigned*)(O + (size_t)orow * ldo + d0 * 32 + r32) = cvtpk(v, vn); } }
}
}

struct MlaPol {
    const bf16* kp[3]; long kst[3]; const bf16* vp[2]; int qlo, qm;
    __device__ __forceinline__ const bf16* kptr(int p, int j) const { return kp[p] + (long)j * kst[p]; }
    __device__ __forceinline__ const bf16* vptr(int i, int j) const { return vp[i] + (long)j * (64 * 4096); }
    __device__ __forceinline__ bool act(int j) const { return 64 * j <= qlo + 31; }
    __device__ __forceinline__ void mod(fa::f32x16& p0, fa::f32x16& p1, int j) const { if (64 * j + 63 > qlo) fa::mask_tile(p0, p1, qm - 64 * j, 0x7fffffffu); }
    __device__ __forceinline__ void post(fa::f32x16&, fa::f32x16&, int) const {}
};
__device__ __forceinline__ void ph_mla_fa(const Args& a, const Ctx& c) {
    unsigned char* ws = a.ws; const bf16* PROJ = (const bf16*)(ws + WS_PROJ); const bf16* KVUP = (const bf16*)(ws + WS_KVUP); const bf16* KPE = (const bf16*)(ws + WS_KPE);
    bf16* OMLA = (bf16*)(ws + WS_OMLA); const int tid = c.tid, lane = c.lane, wid = c.wave, r32 = lane & 31, hi = lane >> 5;
    for (int item = blockIdx.x; item < BATCH * 16 * 8; item += c.G) {
        const int pr = item & 7, h = (item >> 3) & 15, b = item >> 7;
        for (int pass = 0; pass < 2; ++pass) { const int qb = pass ? 15 - pr : pr, q0 = 256 * qb;
            MlaPol P;
#pragma unroll
            for (int p = 0; p < 3; ++p) { const int L = tid + 512 * p, row = L / 24, ch = L % 24;
                if (ch < 16) { P.kp[p] = KVUP + (size_t)(b * T + row) * 4096 + h * 128 + ch * 8; P.kst[p] = 64 * 4096; }
                else { P.kp[p] = KPE + (size_t)(b * T + row) * 64 + (ch - 16) * 8; P.kst[p] = 64 * 64; } }
            { const int sr = tid >> 4, sc = (tid & 15) * 8; P.vp[0] = KVUP + (size_t)(b * T + sr) * 4096 + 2048 + h * 128 + sc; P.vp[1] = P.vp[0] + (size_t)32 * 4096; }
            P.qlo = q0 + 32 * wid; P.qm = P.qlo + r32 - 4 * hi;
            fa::bf16x8 qr[12]; const bf16* q = PROJ + (size_t)(b * T + P.qlo + r32) * NCOMBP + OFF_MLA_Q + h * 192 + hi * 8;
#pragma unroll
            for (int d0 = 0; d0 < 8; ++d0) { const v4u w = *(const v4u*)(q + d0 * 16); v4u o;
                o.x = fa::cvtpk(lo_bf(w.x) * MLA_SCALE, hi_bf(w.x) * MLA_SCALE); o.y = fa::cvtpk(lo_bf(w.y) * MLA_SCALE, hi_bf(w.y) * MLA_SCALE);
                o.z = fa::cvtpk(lo_bf(w.z) * MLA_SCALE, hi_bf(w.z) * MLA_SCALE); o.w = fa::cvtpk(lo_bf(w.w) * MLA_SCALE, hi_bf(w.w) * MLA_SCALE); qr[d0] = __builtin_bit_cast(fa::bf16x8, o); }
#pragma unroll
            for (int dd = 0; dd < 2; ++dd) {
                const v4u w1 = *(const v4u*)(q + (8 + dd) * 16), w2 = *(const v4u*)(q + (10 + dd) * 16);
                const f32x4* cs = (const f32x4*)((const float2*)(ws + WS_ROPE) + (size_t)(P.qlo + r32) * 32 + 16 * dd + 8 * hi);
                const f32x4 c0 = cs[0], c1 = cs[1], c2 = cs[2], c3 = cs[3];
                const float x1[8] = {lo_bf(w1.x), hi_bf(w1.x), lo_bf(w1.y), hi_bf(w1.y), lo_bf(w1.z), hi_bf(w1.z), lo_bf(w1.w), hi_bf(w1.w)};
                const float x2[8] = {lo_bf(w2.x), hi_bf(w2.x), lo_bf(w2.y), hi_bf(w2.y), lo_bf(w2.z), hi_bf(w2.z), lo_bf(w2.w), hi_bf(w2.w)};
                const float cc[8] = {c0.x, c0.z, c1.x, c1.z, c2.x, c2.z, c3.x, c3.z}, sn[8] = {c0.y, c0.w, c1.y, c1.w, c2.y, c2.w, c3.y, c3.w};
                float y1[8], y2[8];
#pragma unroll
                for (int j = 0; j < 8; ++j) { y1[j] = (x1[j] * cc[j] - x2[j] * sn[j]) * MLA_SCALE; y2[j] = (x1[j] * sn[j] + x2[j] * cc[j]) * MLA_SCALE; }
                v4u o1, o2; o1.x = fa::cvtpk(y1[0], y1[1]); o1.y = fa::cvtpk(y1[2], y1[3]); o1.z = fa::cvtpk(y1[4], y1[5]); o1.w = fa::cvtpk(y1[6], y1[7]);
                o2.x = fa::cvtpk(y2[0], y2[1]); o2.y = fa::cvtpk(y2[2], y2[3]); o2.z = fa::cvtpk(y2[4], y2[5]); o2.w = fa::cvtpk(y2[6], y2[7]);
                qr[8 + dd] = __builtin_bit_cast(fa::bf16x8, o1); qr[10 + dd] = __builtin_bit_cast(fa::bf16x8, o2); }
            fa::f32x16 o[4] = {}; float m_reg = -1e30f, l_reg = 0.f;
            const unsigned long long tiles = (2ull << (4 * qb + 3)) - 1ull;
            fa::attend<192, 0>(P, (LAS char*)c.lds, qr, tiles, o, m_reg, l_reg, 0.f, tid, wid, lane);
            fa::scale_rows(o, l_reg > 0.f ? 1.f / l_reg : 0.f, (LAS char*)c.lds, wid, r32, hi);
            fa::store_bf16(o, OMLA + (size_t)(b * T + P.qlo) * D + h * 128, D, r32, hi);
        }
    }
}

constexpr size_t WS_KCB = WS_SEL + 512 * 1024;
constexpr size_t WS_OACC = 446 * MiB;
constexpr int IMP_LD = 65;
__device__ __forceinline__ float t5_bias(float tab, int dist) {
    const int sq = dist * dist, lg = 39 - __clz(sq), b = dist < 16 ? dist : (lg < 31 ? lg : 31);
    return __builtin_bit_cast(float, __builtin_amdgcn_ds_bpermute(b << 2, __builtin_bit_cast(int, tab)));
}
struct NsaSrc { const bf16* kp[2]; const bf16* vp[2]; long kst, vst; };
struct CmpPol { NsaSrc s; int dq0; float tab; LAS unsigned* imp;
    __device__ __forceinline__ const bf16* kptr(int p, int j) const { return s.kp[p] + (long)j * s.kst; }
    __device__ __forceinline__ const bf16* vptr(int i, int j) const { return s.vp[i] + (long)j * s.vst; }
    __device__ __forceinline__ bool act(int) const { return true; }
    __device__ __forceinline__ void mod(fa::f32x16& p0, fa::f32x16& p1, int j) const { const float NEG = -__builtin_inff(); const int d0 = dq0 - 1024 * j;
#pragma unroll
        for (int r = 0; r < 16; ++r) { const int c = (r & 3) + 8 * (r >> 2), da = d0 - 16 * c, db = da - 512;
            p0[r] = da >= 0 ? p0[r] + t5_bias(tab, da) : NEG; p1[r] = db >= 0 ? p1[r] + t5_bias(tab, db) : NEG; } }
    __device__ __forceinline__ void post(fa::f32x16& p0, fa::f32x16& p1, int j) const {
#pragma unroll
        for (int q4 = 0; q4 < 4; ++q4) { LAS unsigned* a = imp + 16 * j + 2 * q4;
            __hip_atomic_fetch_add(a, (unsigned)(((p0[4 * q4] + p0[4 * q4 + 1]) + (p0[4 * q4 + 2] + p0[4 * q4 + 3])) * 16777216.f + 0.5f), __ATOMIC_RELAXED, __HIP_MEMORY_SCOPE_WORKGROUP);
            __hip_atomic_fetch_add(a + 1, (unsigned)(p0[4 * q4 + 3] * 16777216.f + 0.5f), __ATOMIC_RELAXED, __HIP_MEMORY_SCOPE_WORKGROUP);
            __hip_atomic_fetch_add(a + 8, (unsigned)(((p1[4 * q4] + p1[4 * q4 + 1]) + (p1[4 * q4 + 2] + p1[4 * q4 + 3])) * 16777216.f + 0.5f), __ATOMIC_RELAXED, __HIP_MEMORY_SCOPE_WORKGROUP);
            __hip_atomic_fetch_add(a + 9, (unsigned)(p1[4 * q4 + 3] * 16777216.f + 0.5f), __ATOMIC_RELAXED, __HIP_MEMORY_SCOPE_WORKGROUP); } }
};
__device__ __forceinline__ int t5_bucket_lo(int bk) { const int e = bk - 16, v = 16 << (e >> 1); return (e & 1) ? (int)(((long long)v * 46341 + 32767) >> 15) : v; }
__device__ __forceinline__ int t5_bucket_u(int dist) { const int lg = 39 - __builtin_clz(dist * dist); return dist < 16 ? dist : (lg < 31 ? lg : 31); }
template <bool WIN> struct SwPol { NsaSrc s; int dq0, t0; float tab; unsigned long long sel;
    __device__ __forceinline__ const bf16* kptr(int p, int j) const { return s.kp[p] + (long)j * s.kst; }
    __device__ __forceinline__ const bf16* vptr(int i, int j) const { return s.vp[i] + (long)j * s.vst; }
    __device__ __forceinline__ bool act(int) const { return true; }
    __device__ __forceinline__ void mod(fa::f32x16& p0, fa::f32x16& p1, int j) const { const float NEG = -__builtin_inff(); const int d0 = dq0 - 64 * j;
        const bool on = WIN ? true : (bool)((sel >> j) & 1ull);
        const int dmin = t0 - 64 * j - 63, dmax = t0 + 31 - 64 * j;
        bool fast = false; int B = 0; float b_lo = 0.f, b_hi = 0.f;
        if (dmin >= 16) { const int bk = t5_bucket_u(dmax), bl = t5_bucket_u(dmin);
            if (!WIN || dmax < 512) { if (bk - bl <= 1) { fast = true; B = t5_bucket_lo(bk); b_hi = __builtin_bit_cast(float, __builtin_amdgcn_readlane(__builtin_bit_cast(int, tab), bk)); b_lo = __builtin_bit_cast(float, __builtin_amdgcn_readlane(__builtin_bit_cast(int, tab), bl)); } }
            else if (dmin < 512 && bl == 25) { fast = true; B = 512; b_hi = NEG; b_lo = __builtin_bit_cast(float, __builtin_amdgcn_readlane(__builtin_bit_cast(int, tab), 25)); } }
        if (fast) { const float lo = on ? b_lo : NEG, hi_ = on ? b_hi : NEG; const int th = d0 - B;
#pragma unroll
            for (int r = 0; r < 16; ++r) { const int c = (r & 3) + 8 * (r >> 2); p0[r] += (c <= th ? hi_ : lo); p1[r] += (c + 32 <= th ? hi_ : lo); } }
        else {
#pragma unroll
            for (int r = 0; r < 16; ++r) { const int c = (r & 3) + 8 * (r >> 2), da = d0 - c, db = da - 32;
                const bool va = WIN ? ((unsigned)da < 512u) : (on && da >= 0), vb = WIN ? ((unsigned)db < 512u) : (on && db >= 0);
                p0[r] = va ? p0[r] + t5_bias(tab, da) : NEG; p1[r] = vb ? p1[r] + t5_bias(tab, db) : NEG; } } }
    __device__ __forceinline__ void post(fa::f32x16&, fa::f32x16&, int) const {}
};
typedef SwPol<false> SlcPol; typedef SwPol<true> WinPol;
template <int MODE> __device__ __forceinline__ void oacc_rw(const fa::f32x16 (&o)[4], float* A, bf16* Bo, int r32, int hi) {
    asm volatile("" : "+v"(A), "+v"(Bo), "+v"(r32), "+v"(hi));
#pragma unroll
    for (int r = 0; r < 16; ++r) { const int orow = fa::crow(r, hi);
#pragma unroll
        for (int d0 = 0; d0 < 4; ++d0) { float* p = A + (size_t)orow * D + d0 * 32 + r32; float v = o[d0][r];
            if (MODE == 0) *p = v;
            else if (MODE == 1) *p = *p + v;
            else { v += *p; const float vn = __shfl_xor(v, 1); if ((r32 & 1) == 0) *(unsigned*)(Bo + (size_t)orow * D + d0 * 32 + r32) = fa::cvtpk(v, vn); } } }
}
__device__ __forceinline__ int opaque_i(int x) { asm volatile("" : "+v"(x)); return x; }
__device__ __forceinline__ void nsa_load_q(fa::bf16x8 (&qr)[8], const bf16* prow, int h, int hi) {
#pragma unroll
    for (int d0 = 0; d0 < 8; ++d0) { const v4u w = *(const v4u*)(prow + h * 128 + d0 * 16 + hi * 8); v4u o;
        o.x = fa::cvtpk(lo_bf(w.x) * NSA_SCALE, hi_bf(w.x) * NSA_SCALE); o.y = fa::cvtpk(lo_bf(w.y) * NSA_SCALE, hi_bf(w.y) * NSA_SCALE);
        o.z = fa::cvtpk(lo_bf(w.z) * NSA_SCALE, hi_bf(w.z) * NSA_SCALE); o.w = fa::cvtpk(lo_bf(w.w) * NSA_SCALE, hi_bf(w.w) * NSA_SCALE); qr[d0] = __builtin_bit_cast(fa::bf16x8, o); }
}
__device__ __forceinline__ void ph_nsa_fa(const Args& a, const Ctx& c) {
    unsigned char* ws = a.ws; const bf16* PROJ = (const bf16*)(ws + WS_PROJ); const bf16* KCB = (const bf16*)(ws + WS_KCB); const bf16* VCB = KCB + 1024 * 128;
    const float* relb = a.in[I_RELB]; bf16* ONSA = (bf16*)(ws + WS_ONSA); float* OACC = (float*)(ws + WS_OACC);
    const int wid = c.wave; LAS char* lds = (LAS char*)c.lds;
    LAS unsigned* impT = (LAS unsigned*)(lds + fa::OFF_IMP); LAS unsigned long long* selT = (LAS unsigned long long*)(lds + fa::OFF_SEL);
    for (int k = 0; ; ++k) { int u;
        if (c.G == 256) { if (k >= 2) break; u = k == 0 ? (int)blockIdx.x : 511 - (int)blockIdx.x; } else { u = (int)blockIdx.x + k * c.G; if (u >= 512) break; }
        const int tb = u >> 2, bg = u & 3, b = bg >> 1, g = bg & 1, h = g * 8 + wid, t0 = 32 * tb;
#define NSA_LANE() const int tid = opaque_i(c.tid), lane = tid & 63, r32 = lane & 31, hi = lane >> 5, sr = tid >> 4, sc = (tid & 15) * 8, tq = t0 + r32; \
        const bf16* prow = PROJ + (size_t)(b * T + tq) * NCOMBP; float* orow0 = OACC + (size_t)(b * T + t0) * D + h * 128; (void)sr; (void)sc; (void)orow0; (void)prow
        { NSA_LANE(); for (int i = tid; i < 32 * IMP_LD; i += NTHREADS) impT[i] = 0u; }
        __syncthreads();
        { NSA_LANE(); fa::bf16x8 qr[8]; nsa_load_q(qr, prow, h, hi);
          CmpPol P; const bf16* kb = KCB + (size_t)(bg * 256) * 128; const bf16* vb = VCB + (size_t)(bg * 256) * 128;
          P.s.kp[0] = kb + sr * 128 + sc; P.s.kp[1] = P.s.kp[0] + 32 * 128; P.s.vp[0] = vb + sr * 128 + sc; P.s.vp[1] = P.s.vp[0] + 32 * 128; P.s.kst = 64 * 128; P.s.vst = 64 * 128;
          P.dq0 = tq - 31 - 64 * hi; P.tab = relb[r32 * 16 + h]; P.imp = impT + r32 * IMP_LD + hi;
          const unsigned long long tiles = (2ull << (t0 >> 10)) - 1ull;
          fa::f32x16 o[4] = {}; float m_c = -1e30f, l_c = 0.f;
          fa::attend<128, 1>(P, lds, qr, tiles, o, m_c, l_c, 0.f, tid, wid, lane);
          const float il = l_c > 0.f ? 1.f / l_c : 0.f;
          fa::attend<128, 2>(P, lds, qr, tiles, o, m_c, l_c, il, tid, wid, lane);
          { NSA_LANE(); fa::scale_rows(o, sigmoidf_(bf2f(prow[OFF_NSA_GATE + h])), lds, wid, r32, hi);
            oacc_rw<0>(o, orow0, nullptr, r32, hi); } }
        __syncthreads();
        { const int lane = opaque_i(c.lane), l16 = lane & 15, tk = 4 * wid + (lane >> 4), t = t0 + tk, cur = t >> 6;
          unsigned kk[4];
#pragma unroll
          for (int i = 0; i < 4; ++i) { const int jb = 4 * l16 + i; const unsigned impv = impT[tk * IMP_LD + jb];
              const bool forced = (jb == 0) | (jb == cur) | (jb == cur - 1), validb = jb <= cur;
              kk[i] = validb ? ((forced ? 0xFFFFFFC0u : (0x80000000u | ((impv << 3) & 0x7FFFFFC0u))) | (unsigned)(63 - jb)) : 0u; }
          PEER_CE(kk[0], kk[1]); PEER_CE(kk[2], kk[3]); PEER_CE(kk[0], kk[2]); PEER_CE(kk[1], kk[3]); PEER_CE(kk[1], kk[2]);
          unsigned long long selmask = 0ull;
          for (int r = 0; r < 16; ++r) { const unsigned m = row16_max_u(kk[0]); if (m != 0u) selmask |= 1ull << (63 - (int)(m & 63u)); const bool pop = kk[0] == m;
              kk[0] = pop ? kk[1] : kk[0]; kk[1] = pop ? kk[2] : kk[1]; kk[2] = pop ? kk[3] : kk[2]; kk[3] = pop ? 0u : kk[3]; }
          if (l16 == 0) selT[tk] = selmask; }
        __syncthreads();
        { NSA_LANE(); fa::bf16x8 qr[8]; nsa_load_q(qr, prow, h, hi);
          SlcPol P; const bf16* kb = PROJ + (size_t)(b * T) * NCOMBP + OFF_NSA_KV + 2 * 256 + g * 128;
          P.s.kp[0] = kb + (size_t)sr * NCOMBP + sc; P.s.kp[1] = P.s.kp[0] + (size_t)32 * NCOMBP; P.s.vp[0] = P.s.kp[0] + 256; P.s.vp[1] = P.s.kp[1] + 256; P.s.kst = 64 * NCOMBP; P.s.vst = 64 * NCOMBP;
          P.dq0 = tq - 4 * hi; P.t0 = t0; P.tab = relb[r32 * 16 + h]; P.sel = selT[r32];
          unsigned lo = (unsigned)P.sel, hi32 = (unsigned)(P.sel >> 32);
#pragma unroll
          for (int o_ = 1; o_ < 32; o_ <<= 1) { lo |= __shfl_xor(lo, o_); hi32 |= __shfl_xor(hi32, o_); }
          const unsigned long long tiles = ((unsigned long long)(unsigned)__builtin_amdgcn_readfirstlane((int)hi32) << 32) | (unsigned)__builtin_amdgcn_readfirstlane((int)lo);
          fa::f32x16 o[4] = {}; float m_s = -1e30f, l_s = 0.f;
          fa::attend<128, 0>(P, lds, qr, tiles, o, m_s, l_s, 0.f, tid, wid, lane);
          { NSA_LANE(); const float g1 = sigmoidf_(bf2f(prow[OFF_NSA_GATE + 16 + h]));
            fa::scale_rows(o, l_s > 0.f ? g1 / l_s : 0.f, lds, wid, r32, hi);
            oacc_rw<1>(o, orow0, nullptr, r32, hi); } }
        { NSA_LANE(); fa::bf16x8 qr[8]; nsa_load_q(qr, prow, h, hi);
          WinPol P; const bf16* kb = PROJ + (size_t)(b * T) * NCOMBP + OFF_NSA_KV + 4 * 256 + g * 128;
          P.s.kp[0] = kb + (size_t)sr * NCOMBP + sc; P.s.kp[1] = P.s.kp[0] + (size_t)32 * NCOMBP; P.s.vp[0] = P.s.kp[0] + 256; P.s.vp[1] = P.s.kp[1] + 256; P.s.kst = 64 * NCOMBP; P.s.vst = 64 * NCOMBP;
          P.dq0 = tq - 4 * hi; P.t0 = t0; P.tab = relb[r32 * 16 + h]; P.sel = 0ull;
          const int jlo = t0 >= 511 ? (t0 - 511) >> 6 : 0, jhi = (t0 + 31) >> 6;
          const unsigned long long tiles = ((2ull << jhi) - 1ull) & ~((1ull << jlo) - 1ull);
          fa::f32x16 o[4] = {}; float m_w = -1e30f, l_w = 0.f;
          fa::attend<128, 0>(P, lds, qr, tiles, o, m_w, l_w, 0.f, tid, wid, lane);
          { NSA_LANE(); const float g2 = sigmoidf_(bf2f(prow[OFF_NSA_GATE + 32 + h]));
            fa::scale_rows(o, l_w > 0.f ? g2 / l_w : 0.f, lds, wid, r32, hi);
            oacc_rw<2>(o, orow0, ONSA + (size_t)(b * T + t0) * D + h * 128, r32, hi); } }
        __syncthreads();
#undef NSA_LANE
    }
}

struct MemPol { const bf16* kp[2]; const bf16* vp[2];
    __device__ __forceinline__ const bf16* kptr(int p, int j) const { return kp[p] + (long)j * (64 * 1024); }
    __device__ __forceinline__ const bf16* vptr(int i, int j) const { return vp[i] + (long)j * (64 * 1024); }
    __device__ __forceinline__ bool act(int) const { return true; }
    __device__ __forceinline__ void mod(fa::f32x16&, fa::f32x16&, int) const {}
    __device__ __forceinline__ void post(fa::f32x16&, fa::f32x16&, int) const {}
};
__device__ __forceinline__ void ph_memattn_fa(const Args& a, const Ctx& c) {
    unsigned char* ws = a.ws; const bf16* QM = (const bf16*)(ws + WS_QMEM); const bf16* KV = (const bf16*)(ws + WS_KVMEM); bf16* OM = (bf16*)(ws + WS_OMEM);
    const int wid = c.wave; LAS char* lds = (LAS char*)c.lds;
    for (int u = blockIdx.x; u < BATCH * 4 * 16; u += c.G) { const int qb = u & 15, h = (u >> 4) & 3, b = u >> 6;
        const int tid = opaque_i(c.tid), lane = tid & 63, r32 = lane & 31, hi = lane >> 5, sr = tid >> 4, sc = (tid & 15) * 8, row0 = b * T + 256 * qb + 32 * wid;
        MemPol P; P.kp[0] = KV + (size_t)(b * NMEM + sr) * 1024 + h * 128 + sc; P.kp[1] = P.kp[0] + (size_t)32 * 1024; P.vp[0] = P.kp[0] + 512; P.vp[1] = P.kp[1] + 512;
        fa::bf16x8 qr[8]; const bf16* q = QM + (size_t)(row0 + r32) * 512 + h * 128 + hi * 8;
#pragma unroll
        for (int d0 = 0; d0 < 8; ++d0) { const v4u w = *(const v4u*)(q + d0 * 16); v4u o;
            o.x = fa::cvtpk(lo_bf(w.x) * MEM_SCALE, hi_bf(w.x) * MEM_SCALE); o.y = fa::cvtpk(lo_bf(w.y) * MEM_SCALE, hi_bf(w.y) * MEM_SCALE);
            o.z = fa::cvtpk(lo_bf(w.z) * MEM_SCALE, hi_bf(w.z) * MEM_SCALE); o.w = fa::cvtpk(lo_bf(w.w) * MEM_SCALE, hi_bf(w.w) * MEM_SCALE); qr[d0] = __builtin_bit_cast(fa::bf16x8, o); }
        fa::f32x16 o[4] = {}; float m_reg = -1e30f, l_reg = 0.f;
        fa::attend<128, 0>(P, lds, qr, 0xFull, o, m_reg, l_reg, 0.f, tid, wid, lane);
        fa::scale_rows(o, 1.f / l_reg, lds, wid, r32, hi);
        fa::store_bf16(o, OM + (size_t)row0 * 512 + h * 128, 512, r32, hi);
    }
}
template <int DIM> __device__ __forceinline__ float dot_bf(const LAS float* q, const bf16* k) {
    float s = 0.f;
#pragma unroll 4
    for (int d = 0; d < DIM; d += 8) { const v4u w = *(const v4u*)(k + d); const f32x4 q0 = *(const LAS f32x4*)(q + d), q1 = *(const LAS f32x4*)(q + d + 4);
        s += q0.x * lo_bf(w.x) + q0.y * hi_bf(w.x) + q0.z * lo_bf(w.y) + q0.w * hi_bf(w.y) + q1.x * lo_bf(w.z) + q1.y * hi_bf(w.z) + q1.z * lo_bf(w.w) + q1.w * hi_bf(w.w); }
    return s;
}
template <int DIM> __device__ __forceinline__ float dot_f32(const LAS float* q, const float* k) {
    float s = 0.f;
#pragma unroll 4
    for (int d = 0; d < DIM; d += 4) { const f32x4 w = *(const f32x4*)(k + d); const f32x4 q0 = *(const LAS f32x4*)(q + d); s += q0.x * w.x + q0.y * w.y + q0.z * w.z + q0.w * w.w; }
    return s;
}
struct Soft { float m, l, o0, o1; };
__device__ __forceinline__ void soft_init(Soft& S) { S.m = -1e30f; S.l = 0.f; S.o0 = 0.f; S.o1 = 0.f; }
__device__ __forceinline__ void load2(const bf16* p, float& a, float& b) { const unsigned w = *(const unsigned*)p; a = lo_bf(w); b = hi_bf(w); }
__device__ __forceinline__ void load2(const float* p, float& a, float& b) { a = p[0]; b = p[1]; }
template <class VT> __device__ __forceinline__ void soft_chunk(Soft& S, float s, bool valid, int lane, const VT* vbase, long vstride) {
    const unsigned long long vm = __ballot(valid);
    if (vm == 0ull) return;
    const float cm = wave_max(valid ? s : -1e30f), mn = fmaxf(S.m, cm), sc = expf(S.m - mn), p = valid ? expf(s - mn) : 0.f;
    S.l = S.l * sc + wave_sum(p); S.o0 *= sc; S.o1 *= sc; S.m = mn;
    for (int k = 0; k < 64; ++k) if ((vm >> k) & 1ull) {
        const float pk = __shfl(p, k); float a, b; load2(vbase + (long)k * vstride + 2 * lane, a, b);
        S.o0 += pk * a; S.o1 += pk * b; }
}

struct TrItem { const float* W; bf16* WT; int K, N, row_off, k0, n0; };
__device__ __forceinline__ void tr_load(const TrItem& t, float (&tv)[32], int lane) {
    const int nn = t.n0 + (lane & 31);
#pragma unroll
    for (int i = 0; i < 32; ++i) { const int kk = 2 * i + (lane >> 5); tv[i] = nn < t.N ? __builtin_nontemporal_load(t.W + (size_t)(t.k0 + kk) * t.N + nn) : 0.f; }
}
__device__ __forceinline__ void tr_store(const TrItem& t, const float (&tv)[32], LAS float* scr, int lane) {
#pragma unroll
    for (int i = 0; i < 32; ++i) { const int kk = 2 * i + (lane >> 5); scr[kk * 33 + (lane & 31)] = tv[i]; }
    LDS_WAIT(); asm volatile("" ::: "memory");
    const int c = lane & 7;
#pragma unroll
    for (int j = 0; j < 4; ++j) { const int n = (lane >> 3) + 8 * j; const LAS float* s = scr + (8 * c) * 33 + n;
        v4u o; o.x = pk2(s[0 * 33], s[1 * 33]); o.y = pk2(s[2 * 33], s[3 * 33]); o.z = pk2(s[4 * 33], s[5 * 33]); o.w = pk2(s[6 * 33], s[7 * 33]);
        *(v4u*)(t.WT + (size_t)(t.row_off + t.n0 + n) * t.K + t.k0 + 8 * c) = o; }
    LDS_WAIT(); asm volatile("" ::: "memory");
}
__device__ __forceinline__ void cvt_rows(const float* src, bf16* dst, size_t n8, size_t gt, size_t nt) {
    for (size_t i = gt; i < n8; i += nt) { const f32x4 a = *(const f32x4*)(src + 8 * i), b = *(const f32x4*)(src + 8 * i + 4);
        v4u o; o.x = pk2(a.x, a.y); o.y = pk2(a.z, a.w); o.z = pk2(b.x, b.y); o.w = pk2(b.z, b.w); *(v4u*)(dst + 8 * i) = o; }
}
__device__ __forceinline__ void ph_prologue(const Args& a, const Ctx& c) {
    LAS float* scr = (LAS float*)(c.lds + c.wave * 16384);
    unsigned char* ws = a.ws;
    constexpr int I0 = 32 * 360, I1 = 8 * 64, I2 = 32 * 64, I3 = 32 * 16, I4 = 64 * 8;
    constexpr int NITEMS = I0 + 2 * I1 + 3 * I2 + 3 * I3 + I1 + I2 + 2 * I4;
#define TR_DECODE(t, it_) do { int r_ = (it_); int nblk_; \
        if (r_ < I0) { t.W = a.in[I_WIN]; t.K = D; t.N = NCOMB; t.WT = (bf16*)(ws + WS_W_IN); t.row_off = 0; nblk_ = 360; } else { r_ -= I0; \
        if (r_ < I1) { t.W = a.in[I_WUK]; t.K = 512; t.N = 2048; t.WT = (bf16*)(ws + WS_W_UKV); t.row_off = 0; nblk_ = 64; } else { r_ -= I1; \
        if (r_ < I1) { t.W = a.in[I_WUV]; t.K = 512; t.N = 2048; t.WT = (bf16*)(ws + WS_W_UKV); t.row_off = 2048; nblk_ = 64; } else { r_ -= I1; \
        if (r_ < I2) { t.W = a.in[I_WBN]; t.K = D; t.N = D; t.WT = (bf16*)(ws + WS_W_BN); t.row_off = 0; nblk_ = 64; } else { r_ -= I2; \
        if (r_ < I2) { t.W = a.in[I_WBM]; t.K = D; t.N = D; t.WT = (bf16*)(ws + WS_W_BM); t.row_off = 0; nblk_ = 64; } else { r_ -= I2; \
        if (r_ < I2) { t.W = a.in[I_WMO]; t.K = D; t.N = D; t.WT = (bf16*)(ws + WS_W_MO); t.row_off = 0; nblk_ = 64; } else { r_ -= I2; \
        if (r_ < I3) { t.W = a.in[I_MWQ]; t.K = D; t.N = 512; t.WT = (bf16*)(ws + WS_W_MQ); t.row_off = 0; nblk_ = 16; } else { r_ -= I3; \
        if (r_ < I3) { t.W = a.in[I_MWK]; t.K = D; t.N = 512; t.WT = (bf16*)(ws + WS_W_MKV); t.row_off = 0; nblk_ = 16; } else { r_ -= I3; \
        if (r_ < I3) { t.W = a.in[I_MWV]; t.K = D; t.N = 512; t.WT = (bf16*)(ws + WS_W_MKV); t.row_off = 512; nblk_ = 16; } else { r_ -= I3; \
        if (r_ < I1) { t.W = a.in[I_MWO]; t.K = 512; t.N = D; t.WT = (bf16*)(ws + WS_W_MO2); t.row_off = 0; nblk_ = 64; } else { r_ -= I1; \
        if (r_ < I2) { t.W = a.in[I_PWQ]; t.K = D; t.N = D; t.WT = (bf16*)(ws + WS_W_PQ); t.row_off = 0; nblk_ = 64; } else { r_ -= I2; \
        if (r_ < I4) { t.W = a.in[I_CKW1]; t.K = 4096; t.N = 256; t.WT = (bf16*)(ws + WS_W_C1K); t.row_off = 0; nblk_ = 8; } else { r_ -= I4; \
                       t.W = a.in[I_CVW1]; t.K = 4096; t.N = 256; t.WT = (bf16*)(ws + WS_W_C1V); t.row_off = 0; nblk_ = 8; } } } } } } } } } } } } \
        t.k0 = 64 * (r_ / nblk_); t.n0 = 32 * (r_ % nblk_); } while (0)
    for (int it = c.gw; it < NITEMS; it += 2 * c.ngw) {
        TrItem ta, tb; float va[32], vb[32]; const bool two = it + c.ngw < NITEMS;
        TR_DECODE(ta, it); tr_load(ta, va, c.lane);
        if (two) { TR_DECODE(tb, it + c.ngw); tr_load(tb, vb, c.lane); }
        tr_store(ta, va, scr, c.lane);
        if (two) tr_store(tb, vb, scr, c.lane);
    }
#undef TR_DECODE
    const size_t gt = (size_t)blockIdx.x * NTHREADS + c.tid, nt = (size_t)c.G * NTHREADS;
    cvt_rows(a.in[I_X], (bf16*)(ws + WS_XB), (size_t)NTOK * D / 8, gt, nt);
    cvt_rows(a.in[I_MEM], (bf16*)(ws + WS_MEMB), (size_t)BATCH * NMEM * D / 8, gt, nt);
    { const int kv = c.tid >> 8, j = c.tid & 255; const float* pe = a.in[kv ? I_CVPE : I_CKPE]; const float* w1 = a.in[kv ? I_CVW1 : I_CKW1]; float s = 0.f;
      for (int rr = (int)blockIdx.x; rr < 4096; rr += c.G) s += pe[rr] * w1[(size_t)rr * 256 + j];
      ((float*)(ws + WS_CVECP))[(size_t)blockIdx.x * 512 + c.tid] = s; }
    for (size_t i = gt; i < (size_t)T * 32; i += nt) { const int t = (int)(i >> 5), fi = (int)(i & 31); const float ang = (float)t * exp2f(-(float)fi * (13.287712379549449f / 32.f));
        ((float2*)(ws + WS_ROPE))[i] = make_float2(cosf(ang), sinf(ang)); }
    for (size_t i = gt; i < 65536; i += nt) { const int n = (int)(i >> 8), kk = (int)(i & 255); const float* keys = a.in[I_PKEYS];
        const float v = (n < 128 && kk < 128) ? keys[n * 128 + kk] : ((n >= 128 && kk >= 128) ? keys[16384 + (n - 128) * 128 + (kk - 128)] : 0.f);
        ((bf16*)(ws + WS_KEYB))[i] = (bf16)f2bf(v); }
    for (size_t i = gt; i < 8192; i += nt) { ((bf16*)(ws + WS_CMPA_K))[(size_t)4 * 4096 * 128 + i] = 0; ((bf16*)(ws + WS_CMPA_V))[(size_t)4 * 4096 * 128 + i] = 0; }
}

__device__ __forceinline__ void ph_rowprep(const Args& a, const Ctx& c) {
    unsigned char* ws = a.ws; const bf16* PROJ = (const bf16*)(ws + WS_PROJ); const int lane = c.lane;
    if (blockIdx.x == 0) { float s = 0.f;
#pragma unroll 32
        for (int w = 0; w < c.G; ++w) s += ((const float*)(ws + WS_CVECP))[(size_t)w * 512 + c.tid];
        ((float*)(ws + WS_CVEC))[c.tid] = s; }
    const float* gk = a.in[I_KVNORM]; const float2* rope = (const float2*)(ws + WS_ROPE);
    for (int row = c.gw; row < NTOK; row += c.ngw) {
        const int b = row / T, t = row % T; const bf16* prow = PROJ + (size_t)row * NCOMBP;
        { const v4u w = *(const v4u*)(prow + OFF_MLA_KV + 8 * lane);
          float v[8] = {lo_bf(w.x), hi_bf(w.x), lo_bf(w.y), hi_bf(w.y), lo_bf(w.z), hi_bf(w.z), lo_bf(w.w), hi_bf(w.w)};
          float ss = 0.f;
#pragma unroll
          for (int i = 0; i < 8; ++i) ss += v[i] * v[i];
          const float r = rsqrtf(wave_sum_u(ss) * (1.f / 512.f) + 1e-6f);
          v4u o; o.x = pk2(v[0] * r * gk[8 * lane], v[1] * r * gk[8 * lane + 1]); o.y = pk2(v[2] * r * gk[8 * lane + 2], v[3] * r * gk[8 * lane + 3]);
          o.z = pk2(v[4] * r * gk[8 * lane + 4], v[5] * r * gk[8 * lane + 5]); o.w = pk2(v[6] * r * gk[8 * lane + 6], v[7] * r * gk[8 * lane + 7]);
          *(v4u*)((bf16*)(ws + WS_CKVN) + (size_t)row * 512 + 8 * lane) = o; }
        if (lane < 32) { const float2 cs = rope[t * 32 + lane]; const float x1 = bf2f(prow[OFF_MLA_KV + 512 + lane]), x2 = bf2f(prow[OFF_MLA_KV + 512 + 32 + lane]);
          bf16* kp = (bf16*)(ws + WS_KPE) + (size_t)row * 64; kp[lane] = (bf16)f2bf(x1 * cs.x - x2 * cs.y); kp[32 + lane] = (bf16)f2bf(x1 * cs.y + x2 * cs.x); }
        { const int i = lane >> 5, g = (lane >> 4) & 1, ch = lane & 15;
          const v4u w = *(const v4u*)(prow + OFF_NSA_KV + i * 256 + g * 128 + 8 * ch);
          bf16* dst = (bf16*)(ws + (i ? WS_CMPA_V : WS_CMPA_K)) + ((size_t)(b * 2 + g) * T + t) * 128 + 8 * ch; *(v4u*)dst = w; }
    }
}

constexpr size_t WS_H1P = 446 * MiB;
__device__ __forceinline__ void ph_cmp2(const Args& a, const Ctx& c) {
    unsigned char* ws = a.ws; const float* H1P = (const float*)(ws + WS_H1P); const float* cvec = (const float*)(ws + WS_CVEC); bf16* KCB = (bf16*)(ws + WS_KCB);
    LAS float* gl = (LAS float*)c.lds;
    for (int grp = blockIdx.x; grp < 256; grp += c.G) {
        __syncthreads();
#pragma unroll
        for (int i = 0; i < 4; ++i) { const int e = c.tid + 512 * i, rr = e >> 8, j = e & 255, row = grp * 8 + rr, kv = row >> 10, m = row & 1023; float s = cvec[kv * 256 + j];
#pragma unroll
            for (int ks = 0; ks < 8; ++ks) s += H1P[((size_t)(ks * 2 + kv) * 1024 + m) * 256 + j];
            gl[e] = gelu_tanh(s); }
        __syncthreads();
#pragma unroll
        for (int i = 0; i < 2; ++i) { const int e = c.tid + 512 * i, rr = e >> 7, ch = e & 127, row = grp * 8 + rr, kv = row >> 10; const float* w2 = a.in[kv ? I_CVW2 : I_CKW2]; float s = 0.f;
#pragma unroll 8
            for (int j = 0; j < 256; ++j) s += gl[rr * 256 + j] * w2[j * 128 + ch];
            KCB[(size_t)row * 128 + ch] = (bf16)f2bf(s); }
    }
}

__device__ __forceinline__ void ph_nsa(const Args& a, const Ctx& c) {
    unsigned char* ws = a.ws; const bf16* PROJ = (const bf16*)(ws + WS_PROJ); const float* KC = (const float*)(ws + WS_KCVC); const float* VC = KC + 1024 * 128;
    const float* relb = a.in[I_RELB]; bf16* ONSA = (bf16*)(ws + WS_ONSA); const int lane = c.lane;
    LAS float* qs = (LAS float*)(c.lds + c.wave * 8192); LAS float* pl = qs + 256;
    for (int task = c.gw; task < NTOK * 2; task += c.ngw) {
        const int g = task & 1, row = task >> 1, b = row / T, t = row % T; const bf16* prow = PROJ + (size_t)row * NCOMBP;
        const int ncv = t >= 31 ? (t - 31) / 16 + 1 : 0;
        const float* kcb = KC + (size_t)(b * 2 + g) * 256 * 128; const float* vcb = VC + (size_t)(b * 2 + g) * 256 * 128;
        float imp = 0.f;
        for (int hh = 0; hh < 8; ++hh) { const int h = g * 8 + hh;
            qs[lane] = bf2f(prow[h * 128 + lane]) * NSA_SCALE; qs[lane + 64] = bf2f(prow[h * 128 + 64 + lane]) * NSA_SCALE; LDS_WAIT();
            float s[4]; bool v[4]; float mx = -1e30f;
#pragma unroll
            for (int i = 0; i < 4; ++i) { const int n = lane + 64 * i; v[i] = n < ncv; s[i] = -1e30f;
                if (v[i]) s[i] = dot_f32<128>(qs, kcb + (size_t)n * 128) + relb[t5_bucket(t - 16 * n - 31) * 16 + h];
                mx = fmaxf(mx, s[i]); }
            mx = wave_max(mx); float p[4], l = 0.f;
#pragma unroll
            for (int i = 0; i < 4; ++i) { p[i] = v[i] ? expf(s[i] - mx) : 0.f; l += p[i]; }
            l = wave_sum(l); const float il = l > 0.f ? 1.f / l : 0.f;
#pragma unroll
            for (int i = 0; i < 4; ++i) pl[lane + 64 * i] = p[i] * il;
            LDS_WAIT();
#pragma unroll
            for (int n = 4 * lane - 1; n <= 4 * lane + 3; ++n) if (n >= 0 && n < 255) imp += pl[n];
            LDS_WAIT(); }
        const int cur = t >> 6; unsigned long long selmask = 0ull;
        { const bool forced = (lane == 0) | (lane == cur) | (lane == cur - 1), validb = lane <= cur;
          float sc = forced ? 1e4f : (validb ? imp : -1e30f);
          for (int r = 0; r < 16; ++r) { const float m = wave_max(sc); if (!(m > -5e29f)) break;
              const int idx = wave_min_i(sc == m ? lane : 64); selmask |= 1ull << idx; if (lane == idx) sc = -3e30f; } }
        if (lane == 0) ((unsigned long long*)(ws + WS_SEL))[task] = selmask;
        for (int hh = 0; hh < 8; ++hh) { const int h = g * 8 + hh;
            qs[lane] = bf2f(prow[h * 128 + lane]) * NSA_SCALE; qs[lane + 64] = bf2f(prow[h * 128 + 64 + lane]) * NSA_SCALE; LDS_WAIT();
            Soft Sc, Ss, Sw; soft_init(Sc); soft_init(Ss); soft_init(Sw);
            for (int i = 0; i < 4; ++i) { const int n = lane + 64 * i; const bool v = n < ncv; float s = 0.f;
                if (v) s = dot_f32<128>(qs, kcb + (size_t)n * 128) + relb[t5_bucket(t - 16 * n - 31) * 16 + h];
                soft_chunk<float>(Sc, s, v, lane, vcb + (size_t)(64 * i) * 128, 128); }
            for (unsigned long long mm = selmask; mm; mm &= mm - 1) { const int j = __ffsll((long long)mm) - 1, sp = 64 * j + lane; const bool v = sp <= t; float s = 0.f;
                const bf16* kb = PROJ + (size_t)(b * T + 64 * j) * NCOMBP + OFF_NSA_KV + 2 * 256 + g * 128;
                if (v) s = dot_bf<128>(qs, kb + (size_t)lane * NCOMBP) + relb[t5_bucket(t - sp) * 16 + h];
                soft_chunk<bf16>(Ss, s, v, lane, kb + 256, NCOMBP); }
            for (int cc = 0; cc < 8; ++cc) { const int s0 = t - 511 + 64 * cc, sp = s0 + lane; const bool v = sp >= 0; float s = 0.f;
                const bf16* kb = PROJ + ((long)(b * T) + s0) * NCOMBP + OFF_NSA_KV + 4 * 256 + g * 128;
                if (v) s = dot_bf<128>(qs, kb + (long)lane * NCOMBP) + relb[t5_bucket(t - sp) * 16 + h];
                soft_chunk<bf16>(Sw, s, v, lane, kb + 256, NCOMBP); }
            const float g0 = sigmoidf_(bf2f(prow[OFF_NSA_GATE + h])), g1 = sigmoidf_(bf2f(prow[OFF_NSA_GATE + 16 + h])), g2 = sigmoidf_(bf2f(prow[OFF_NSA_GATE + 32 + h]));
            const float ic = Sc.l > 0.f ? g0 / Sc.l : 0.f, is = Ss.l > 0.f ? g1 / Ss.l : 0.f, iw = Sw.l > 0.f ? g2 / Sw.l : 0.f;
            *(unsigned*)(ONSA + (size_t)row * D + h * 128 + 2 * lane) = pk2(Sc.o0 * ic + Ss.o0 * is + Sw.o0 * iw, Sc.o1 * ic + Ss.o1 * is + Sw.o1 * iw);
            LDS_WAIT(); }
    }
}

__device__ __forceinline__ void ph_mla(const Args& a, const Ctx& c) {
    unsigned char* ws = a.ws; const bf16* PROJ = (const bf16*)(ws + WS_PROJ); const bf16* KVUP = (const bf16*)(ws + WS_KVUP); const bf16* KPE = (const bf16*)(ws + WS_KPE);
    bf16* OMLA = (bf16*)(ws + WS_OMLA); const int lane = c.lane; LAS float* qs = (LAS float*)(c.lds + c.wave * 8192);
    for (int task = c.gw; task < NTOK * 16; task += c.ngw) {
        const int h = task & 15, row = task >> 4, b = row / T, t = row % T; const bf16* q = PROJ + (size_t)row * NCOMBP + OFF_MLA_Q + h * 192;
        qs[lane] = bf2f(q[lane]); qs[lane + 64] = bf2f(q[lane + 64]); qs[lane + 128] = bf2f(q[lane + 128]); LDS_WAIT();
        Soft S; soft_init(S);
        for (int cc = 0; cc <= (t >> 6); ++cc) { const int sp = 64 * cc + lane; const bool v = sp <= t; float s = 0.f;
            const bf16* kb = KVUP + (size_t)(b * T + 64 * cc) * 4096 + h * 128;
            if (v) s = dot_bf<128>(qs, kb + (size_t)lane * 4096) + dot_bf<64>(qs + 128, KPE + (size_t)(b * T + sp) * 64);
            soft_chunk<bf16>(S, s, v, lane, kb + 2048, 4096); }
        const float il = S.l > 0.f ? 1.f / S.l : 0.f;
        *(unsigned*)(OMLA + (size_t)row * D + h * 128 + 2 * lane) = pk2(S.o0 * il, S.o1 * il);
        LDS_WAIT();
    }
}

__device__ __forceinline__ void ph_merge(const Args& a, const Ctx& c) {
    unsigned char* ws = a.ws; const bf16* PROJ = (const bf16*)(ws + WS_PROJ); const bf16* YN = (const bf16*)(ws + WS_YN); const bf16* YM = (const bf16*)(ws + WS_YM); bf16* MG = (bf16*)(ws + WS_MERGED);
    const size_t gt = (size_t)blockIdx.x * NTHREADS + c.tid, nt = (size_t)c.G * NTHREADS;
    for (size_t i = gt; i < (size_t)NTOK * D / 8; i += nt) { const size_t row = i / (D / 8); const int col = (int)(i % (D / 8)) * 8;
        const v4u g0 = *(const v4u*)(PROJ + row * NCOMBP + OFF_MERGE + col), g1 = *(const v4u*)(PROJ + row * NCOMBP + OFF_MERGE + D + col), yn = *(const v4u*)(YN + row * D + col), ym = *(const v4u*)(YM + row * D + col);
        v4u o;
#define MRG(f) pk2(sigmoidf_(lo_bf(g0.f)) * lo_bf(yn.f) + sigmoidf_(lo_bf(g1.f)) * lo_bf(ym.f), sigmoidf_(hi_bf(g0.f)) * hi_bf(yn.f) + sigmoidf_(hi_bf(g1.f)) * hi_bf(ym.f))
        o.x = MRG(x); o.y = MRG(y); o.z = MRG(z); o.w = MRG(w);
#undef MRG
        *(v4u*)(MG + row * D + col) = o; }
}

__device__ __forceinline__ void ln_rows_store(f32x4 (&v)[8], const float* gam, const float* bet, float* outf, bf16* outb, int lane) {
    float s = 0.f;
#pragma unroll
    for (int j = 0; j < 8; ++j) s += (v[j].x + v[j].y) + (v[j].z + v[j].w);
    const float mean = wave_sum_u(s) * (1.f / D); float s2 = 0.f;
#pragma unroll
    for (int j = 0; j < 8; ++j) { v[j] = v[j] - mean; s2 += (v[j].x * v[j].x + v[j].y * v[j].y) + (v[j].z * v[j].z + v[j].w * v[j].w); }
    const float rstd = rsqrtf(wave_sum_u(s2) * (1.f / D) + 1e-5f);
#pragma unroll
    for (int j = 0; j < 8; ++j) { const int e = 4 * lane + 256 * j; const f32x4 gg = *(const f32x4*)(gam + e), bb = *(const f32x4*)(bet + e); const f32x4 o = v[j] * rstd * gg + bb;
        if (outf) *(f32x4*)(outf + e) = o;
        if (outb) { uint2 w; w.x = pk2(o.x, o.y); w.y = pk2(o.z, o.w); *(uint2*)(outb + e) = w; } }
}
template <class TX> __device__ __forceinline__ void ph_ln(const Ctx& c, const TX* xin, const bf16* z, const float* gam, const float* bet, bf16* outb) {
    for (int row = c.gw; row < NTOK; row += c.ngw) { f32x4 v[8];
#pragma unroll
        for (int j = 0; j < 8; ++j) { const size_t e = (size_t)row * D + 4 * c.lane + 256 * j; const uint2 zw = *(const uint2*)(z + e); f32x4 xr;
            if constexpr (sizeof(TX) == 4) xr = *(const f32x4*)(xin + e); else { const uint2 xw = *(const uint2*)(xin + e); xr = (f32x4){lo_bf(xw.x), hi_bf(xw.x), lo_bf(xw.y), hi_bf(xw.y)}; }
            v[j] = xr * ALPHA + (f32x4){lo_bf(zw.x), hi_bf(zw.x), lo_bf(zw.y), hi_bf(zw.y)}; }
        ln_rows_store(v, gam, bet, nullptr, outb + (size_t)row * D, c.lane); }
}

__device__ __forceinline__ void ph_memattn(const Args& a, const Ctx& c) {
    unsigned char* ws = a.ws; const bf16* QM = (const bf16*)(ws + WS_QMEM); const bf16* KV = (const bf16*)(ws + WS_KVMEM); bf16* OM = (bf16*)(ws + WS_OMEM);
    const int lane = c.lane; LAS float* qs = (LAS float*)(c.lds + c.wave * 8192);
    for (int task = c.gw; task < NTOK * 4; task += c.ngw) { const int h = task & 3, row = task >> 2, b = row / T; const bf16* q = QM + (size_t)row * 512 + h * 128;
        qs[lane] = bf2f(q[lane]) * MEM_SCALE; qs[lane + 64] = bf2f(q[lane + 64]) * MEM_SCALE; LDS_WAIT();
        Soft S; soft_init(S);
        for (int cc = 0; cc < 4; ++cc) { const bf16* kb = KV + (size_t)(b * NMEM + 64 * cc) * 1024 + h * 128;
            const float s = dot_bf<128>(qs, kb + (size_t)lane * 1024); soft_chunk<bf16>(S, s, true, lane, kb + 512, 1024); }
        const float il = 1.f / S.l;
        *(unsigned*)(OM + (size_t)row * 512 + h * 128 + 2 * lane) = pk2(S.o0 * il, S.o1 * il);
        LDS_WAIT(); }
}

__device__ __forceinline__ void top16_of128(float x0, float x1, LAS float* vs, LAS int* is, int lane) {
    for (int r = 0; r < 16; ++r) { const float m = wave_max(fmaxf(x0, x1));
        const int idx = wave_min_i(x0 == m ? lane : (x1 == m ? lane + 64 : 1 << 20));
        if (lane == 0) { vs[r] = m; is[r] = idx; }
        if (idx == lane) x0 = -__builtin_inff(); if (idx == lane + 64) x1 = -__builtin_inff(); }
}
__device__ __forceinline__ void ph_peer_select(const Args& a, const Ctx& c) {
    unsigned char* ws = a.ws; const float* PQ = (const float*)(ws + WS_PQ); const float* keys = a.in[I_PKEYS]; int* PIDX = (int*)(ws + WS_PIDX); float* PGATE = (float*)(ws + WS_PGATE);
    const int lane = c.lane; LAS float* qs = (LAS float*)(c.lds + c.wave * 8192); LAS float* v1 = qs + 256; LAS int* i1 = (LAS int*)(qs + 272); LAS float* v2 = qs + 288; LAS int* i2 = (LAS int*)(qs + 304);
    for (int task = c.gw; task < NTOK * 8; task += c.ngw) { const int hh = task & 7, tok = task >> 3; const float* q = PQ + (size_t)tok * D + hh * 256;
#pragma unroll
        for (int i = 0; i < 4; ++i) qs[lane + 64 * i] = q[lane + 64 * i];
        LDS_WAIT();
        const float a0 = dot_f32<128>(qs, keys + (size_t)lane * 128), a1 = dot_f32<128>(qs, keys + (size_t)(lane + 64) * 128);
        const float b0 = dot_f32<128>(qs + 128, keys + (size_t)(128 + lane) * 128), b1 = dot_f32<128>(qs + 128, keys + (size_t)(128 + lane + 64) * 128);
        top16_of128(a0, a1, v1, i1, lane); top16_of128(b0, b1, v2, i2, lane); LDS_WAIT();
        float cv[4];
#pragma unroll
        for (int k = 0; k < 4; ++k) { const int f = 4 * lane + k; cv[k] = v1[f >> 4] + v2[f & 15]; }
        float top_s = 0.f; int flat = 0;
        for (int r = 0; r < 16; ++r) { const float m = wave_max(fmaxf(fmaxf(cv[0], cv[1]), fmaxf(cv[2], cv[3])));
            int cand = 1 << 20;
#pragma unroll
            for (int k = 3; k >= 0; --k) if (cv[k] == m) cand = 4 * lane + k;
            const int idx = wave_min_i(cand);
            if (lane == r) { top_s = m; flat = idx; }
#pragma unroll
            for (int k = 0; k < 4; ++k) if (idx == 4 * lane + k) cv[k] = -__builtin_inff(); }
        const float mx = __shfl(top_s, 0); const float e = lane < 16 ? expf(top_s - mx) : 0.f; const float l = wave_sum(e);
        if (lane < 16) { PIDX[(size_t)tok * 128 + hh * 16 + lane] = i1[flat >> 4] * 128 + i2[flat & 15]; PGATE[(size_t)tok * 128 + hh * 16 + lane] = e / l; }
        LDS_WAIT(); }
}

__device__ const unsigned char PEER_CAND[64] = {0,1,2,3,4,5,6,7,8,9,10,11,12,13,14,15,16,17,18,19,20,21,22,23,32,33,34,35,36,48,49,50,51,64,65,66,80,81,96,97,112,113,128,144,160,176,192,208,224,240,
                                                255,255,255,255,255,255,255,255,255,255,255,255,255,255};
__device__ __forceinline__ unsigned top16_of_row8(unsigned (&k)[8], int l16) {
    PEER_CE(k[0], k[1]); PEER_CE(k[2], k[3]); PEER_CE(k[4], k[5]); PEER_CE(k[6], k[7]); PEER_CE(k[0], k[2]); PEER_CE(k[1], k[3]); PEER_CE(k[4], k[6]); PEER_CE(k[5], k[7]);
    PEER_CE(k[1], k[2]); PEER_CE(k[5], k[6]); PEER_CE(k[0], k[4]); PEER_CE(k[1], k[5]); PEER_CE(k[2], k[6]); PEER_CE(k[3], k[7]); PEER_CE(k[2], k[4]); PEER_CE(k[3], k[5]);
    PEER_CE(k[1], k[2]); PEER_CE(k[3], k[4]); PEER_CE(k[5], k[6]);
    unsigned res = 0u;
    for (int t = 0; t < 16; ++t) { const unsigned m = row16_max_u(k[0]); res = l16 == t ? m : res; const bool pop = k[0] == m;
        k[0] = pop ? k[1] : k[0]; k[1] = pop ? k[2] : k[1]; k[2] = pop ? k[3] : k[2]; k[3] = pop ? k[4] : k[3]; k[4] = pop ? k[5] : k[4]; k[5] = pop ? k[6] : k[5]; k[6] = pop ? k[7] : k[6]; k[7] = pop ? 0u : k[7]; }
    return res;
}
__device__ __forceinline__ void ph_peer_select2(const Args& a, const Ctx& c) {
    unsigned char* ws = a.ws; const float* S = (const float*)(ws + WS_S); int* PIDX = (int*)(ws + WS_PIDX); float* PGATE = (float*)(ws + WS_PGATE);
    const int lane = c.lane, l16 = lane & 15, rq = lane >> 4, rowbase = lane & 48;
    for (int it = c.gw; it < NTOK * 2; it += c.ngw) { const int R = 4 * it + rq; const float* s = S + (size_t)R * 256 + 8 * l16;
        const f32x4 x0 = *(const f32x4*)s, x1 = *(const f32x4*)(s + 4), y0 = *(const f32x4*)(s + 128), y1 = *(const f32x4*)(s + 132);
        unsigned k[8]; const unsigned ib = 127u - 8u * (unsigned)l16;
        k[0] = (fkey(x0.x) & ~127u) | ib; k[1] = (fkey(x0.y) & ~127u) | (ib - 1); k[2] = (fkey(x0.z) & ~127u) | (ib - 2); k[3] = (fkey(x0.w) & ~127u) | (ib - 3);
        k[4] = (fkey(x1.x) & ~127u) | (ib - 4); k[5] = (fkey(x1.y) & ~127u) | (ib - 5); k[6] = (fkey(x1.z) & ~127u) | (ib - 6); k[7] = (fkey(x1.w) & ~127u) | (ib - 7);
        const unsigned r1 = top16_of_row8(k, l16);
        k[0] = (fkey(y0.x) & ~127u) | ib; k[1] = (fkey(y0.y) & ~127u) | (ib - 1); k[2] = (fkey(y0.z) & ~127u) | (ib - 2); k[3] = (fkey(y0.w) & ~127u) | (ib - 3);
        k[4] = (fkey(y1.x) & ~127u) | (ib - 4); k[5] = (fkey(y1.y) & ~127u) | (ib - 5); k[6] = (fkey(y1.z) & ~127u) | (ib - 6); k[7] = (fkey(y1.w) & ~127u) | (ib - 7);
        const unsigned r2 = top16_of_row8(k, l16);
        unsigned ck[4];
#pragma unroll
        for (int si = 0; si < 4; ++si) { const int ci = 4 * l16 + si; const unsigned flat = PEER_CAND[ci];
            const unsigned ka = (unsigned)__builtin_amdgcn_ds_bpermute((rowbase + (int)(flat >> 4)) << 2, (int)r1), kb = (unsigned)__builtin_amdgcn_ds_bpermute((rowbase + (int)(flat & 15u)) << 2, (int)r2);
            const float sum = funkey(ka & ~127u) + funkey(kb & ~127u);
            ck[si] = ci < 50 ? ((fkey(sum) & ~255u) | (255u - flat)) : 0u; }
        PEER_CE(ck[0], ck[1]); PEER_CE(ck[2], ck[3]); PEER_CE(ck[0], ck[2]); PEER_CE(ck[1], ck[3]); PEER_CE(ck[1], ck[2]);
        unsigned rf = 0u;
        for (int t = 0; t < 16; ++t) { const unsigned m = row16_max_u(ck[0]); rf = l16 == t ? m : rf; const bool pop = ck[0] == m;
            ck[0] = pop ? ck[1] : ck[0]; ck[1] = pop ? ck[2] : ck[1]; ck[2] = pop ? ck[3] : ck[2]; ck[3] = pop ? 0u : ck[3]; }
        const unsigned flat = 255u - (rf & 255u); const float ts = funkey(rf & ~255u), mx = funkey(row16_max_u(rf) & ~255u);
        const unsigned ka = (unsigned)__builtin_amdgcn_ds_bpermute((rowbase + (int)(flat >> 4)) << 2, (int)r1), kb = (unsigned)__builtin_amdgcn_ds_bpermute((rowbase + (int)(flat & 15u)) << 2, (int)r2);
        const float ex = expf(ts - mx), den = row16_sum_f(ex);
        PIDX[(size_t)R * 16 + l16] = (int)((127u - (ka & 127u)) * 128u + (127u - (kb & 127u))); PGATE[(size_t)R * 16 + l16] = ex / den; }
}

constexpr size_t WS_U8 = 1 * MiB, WS_USC = 33 * MiB, WS_V8 = 478 * MiB;
__device__ __forceinline__ void peer_convert(const Args& a, int gw, int ngw, int lane) {
    unsigned char* ws = a.ws; float* SC = (float*)(ws + WS_USC);
    for (int r = gw; r < 2 * 16384; r += ngw) { const int which = r >> 14, e = r & 16383; const float* src = a.in[which ? I_PV : I_PU] + (size_t)e * D;
        f32x4 v[8]; float am = 0.f;
#pragma unroll
        for (int j = 0; j < 8; ++j) { v[j] = __builtin_nontemporal_load((const f32x4*)(src + 4 * lane + 256 * j)); am = fmaxf(am, fmaxf(fmaxf(fabsf(v[j].x), fabsf(v[j].y)), fmaxf(fabsf(v[j].z), fabsf(v[j].w)))); }
        am = wave_max(am); const float s = am > 0.f ? am * (1.f / 127.f) : 1.f, is = 1.f / s;
        unsigned* dst = (unsigned*)(ws + (which ? WS_V8 : WS_U8) + (size_t)e * D); int bs = 0;
#pragma unroll
        for (int j = 0; j < 8; ++j) { const int q0 = (int)rintf(v[j].x * is) + 128, q1 = (int)rintf(v[j].y * is) + 128, q2 = (int)rintf(v[j].z * is) + 128, q3 = (int)rintf(v[j].w * is) + 128;
            dst[lane + 64 * j] = (unsigned)q0 | ((unsigned)q1 << 8) | ((unsigned)q2 << 16) | ((unsigned)q3 << 24); bs += (q0 + q1) + (q2 + q3); }
        bs = wave_sum_i(bs);
        if (lane == 0) { SC[r] = s; ((int*)(SC + 32768))[r] = bs; } }
}
#define PEER_DOT4(bw_, xj) (((float)((bw_) & 0xffu) * lo_bf((xj).x) + (float)(((bw_) >> 8) & 0xffu) * hi_bf((xj).x)) + ((float)(((bw_) >> 16) & 0xffu) * lo_bf((xj).y) + (float)((bw_) >> 24) * hi_bf((xj).y)))
struct PeerStream { int e0, e1; float g0, g1; int ch; unsigned long long m0, m1; };
__device__ __forceinline__ void peer_take(PeerStream& S, int& e, float& g) {
    while (!(S.m0 | S.m1)) { ++S.ch; S.m0 = __ballot((S.e0 >> 9) == S.ch); S.m1 = __ballot((S.e1 >> 9) == S.ch); }
    if (S.m0) { const int bt = __builtin_ctzll(S.m0); S.m0 &= S.m0 - 1; e = __builtin_amdgcn_readlane(S.e0, bt); g = __builtin_bit_cast(float, __builtin_amdgcn_readlane(__builtin_bit_cast(int, S.g0), bt)); }
    else { const int bt = __builtin_ctzll(S.m1); S.m1 &= S.m1 - 1; e = __builtin_amdgcn_readlane(S.e1, bt); g = __builtin_bit_cast(float, __builtin_amdgcn_readlane(__builtin_bit_cast(int, S.g1), bt)); }
}
__device__ __forceinline__ void peer_batch(const unsigned* U8, const unsigned* V8, const float* SC, const unsigned (&xq)[8], f32x4 (&acc)[8], float& csum, int xoff, float sxq, PeerStream& S, int lane) {
    int e[4]; float g[4], d[4]; unsigned ub[4][8]; unsigned di[4];
#pragma unroll
    for (int i = 0; i < 4; ++i) { peer_take(S, e[i], g[i]);
#pragma unroll
        for (int j = 0; j < 8; ++j) ub[i][j] = U8[(size_t)e[i] * 512 + lane + 64 * j]; }
#pragma unroll
    for (int i = 0; i < 4; ++i) { unsigned s = 0u;
#pragma unroll
        for (int j = 0; j < 8; ++j) s = __builtin_amdgcn_udot4(ub[i][j], xq[j], s, false);
        di[i] = s; }
#pragma unroll
    for (int i = 0; i < 4; ++i) { const int tot = wave_sum_i((int)di[i]) - 128 * ((const int*)(SC + 32768))[e[i]] + xoff;
        const float h = (float)tot * (SC[e[i]] * sxq); d[i] = g[i] * gelu_tanh(h) * SC[16384 + e[i]]; csum += d[i];
#pragma unroll
        for (int j = 0; j < 8; ++j) ub[i][j] = V8[(size_t)e[i] * 512 + lane + 64 * j]; }
#pragma unroll
    for (int i = 0; i < 4; ++i)
#pragma unroll
        for (int j = 0; j < 8; ++j) { const unsigned w = ub[i][j];
            acc[j].x += d[i] * (float)(w & 0xffu); acc[j].y += d[i] * (float)((w >> 8) & 0xffu); acc[j].z += d[i] * (float)((w >> 16) & 0xffu); acc[j].w += d[i] * (float)(w >> 24); }
}
__device__ __forceinline__ void ph_peer_ffn(const Args& a, const Ctx& c) {
    unsigned char* ws = a.ws; const bf16* X2 = (const bf16*)(ws + WS_X2B); const int* PIDX = (const int*)(ws + WS_PIDX); const float* PGATE = (const float*)(ws + WS_PGATE);
    const unsigned* U8 = (const unsigned*)(ws + WS_U8); const unsigned* V8 = (const unsigned*)(ws + WS_V8); const float* SC = (const float*)(ws + WS_USC);
    for (int ta = c.gw; ta < NTOK; ta += c.ngw) { const int lane = opaque_i(c.lane); unsigned xq[8]; f32x4 aa[8]; float ca = 0.f, am = 0.f; int xs = 0;
        { f32x4 xv[8];
#pragma unroll
          for (int j = 0; j < 8; ++j) { const uint2 xw = *(const uint2*)(X2 + (size_t)ta * D + 4 * lane + 256 * j); xv[j] = (f32x4){lo_bf(xw.x), hi_bf(xw.x), lo_bf(xw.y), hi_bf(xw.y)}; am = fmaxf(am, fmaxf(fmaxf(fabsf(xv[j].x), fabsf(xv[j].y)), fmaxf(fabsf(xv[j].z), fabsf(xv[j].w)))); }
          am = wave_max_u(am); const float isx = am > 0.f ? 127.f / am : 0.f;
#pragma unroll
          for (int j = 0; j < 8; ++j) { const int q0 = (int)rintf(xv[j].x * isx) + 128, q1 = (int)rintf(xv[j].y * isx) + 128, q2 = (int)rintf(xv[j].z * isx) + 128, q3 = (int)rintf(xv[j].w * isx) + 128;
              xq[j] = (unsigned)q0 | ((unsigned)q1 << 8) | ((unsigned)q2 << 16) | ((unsigned)q3 << 24); xs += (q0 + q1) + (q2 + q3); aa[j] = (f32x4){0.f, 0.f, 0.f, 0.f}; } }
        const float sxq = am * (1.f / 127.f); const int xoff = 128 * 128 * 2048 - 128 * wave_sum_i(xs);
        PeerStream sa; sa.e0 = PIDX[(size_t)ta * 128 + lane]; sa.e1 = PIDX[(size_t)ta * 128 + 64 + lane]; sa.g0 = PGATE[(size_t)ta * 128 + lane]; sa.g1 = PGATE[(size_t)ta * 128 + 64 + lane];
        sa.ch = -1; sa.m0 = 0ull; sa.m1 = 0ull;
        for (int st = 0; st < 32; ++st) peer_batch(U8, V8, SC, xq, aa, ca, xoff, sxq, sa, lane);
        const float offa = ca * 128.f;
#pragma unroll
        for (int j = 0; j < 8; ++j) { const uint2 xw = *(const uint2*)(X2 + (size_t)ta * D + 4 * lane + 256 * j); aa[j] = aa[j] - offa + (f32x4){lo_bf(xw.x), hi_bf(xw.x), lo_bf(xw.y), hi_bf(xw.y)} * ALPHA; }
        ln_rows_store(aa, a.in[I_LN3G], a.in[I_LN3B], a.out + (size_t)ta * D, nullptr, lane); }
}

struct PairOrder { pg8::StaticOrder so;
    __device__ bool next(int i, pg8::Unit& u) const { pg8::Unit t; if (!so.next(i >> 1, t)) return false; const int w = i & 1; u.pm = t.pm + 32 * w; u.pn = t.pn + 8 * w; return true; }
    __device__ __forceinline__ void a_ready(const pg8::Unit&) const {}
    __device__ __forceinline__ void done(const pg8::Unit&) const {} };
struct EpiMerge {
    static constexpr bool PERM = true, AFTER_DRAIN = false;
    bf16* O; const bf16* PROJ;
    __device__ __forceinline__ void operator()(const pg8::f32x4 (&acc)[2][2][4][2], const pg8::Unit& u, int wr, int wc, int fr, int fq) const {
        const int w = u.pm >> 5, row0 = (u.pm & 31) * 256 + wr * 64 + fr, col0 = (u.pn & 7) * 256 + wc * 32 + 8 * fq;
#pragma unroll
        for (int ai = 0; ai < 2; ++ai)
#pragma unroll
            for (int m = 0; m < 4; ++m) { const size_t row = (size_t)(row0 + ai * 128 + m * 16); bf16* rowp = O + row * D + col0; const bf16* gp = PROJ + row * NCOMBP + OFF_MERGE + w * D + col0;
#pragma unroll
                for (int bj = 0; bj < 2; ++bj) { const v4u gw = *(const v4u*)(gp + bj * 128); const pg8::f32x4 a0 = acc[ai][bj][m][0], a1 = acc[ai][bj][m][1];
                    float v[8] = {sigmoid_fast(lo_bf(gw.x)) * a0[0], sigmoid_fast(hi_bf(gw.x)) * a0[1], sigmoid_fast(lo_bf(gw.y)) * a0[2], sigmoid_fast(hi_bf(gw.y)) * a0[3],
                                  sigmoid_fast(lo_bf(gw.z)) * a1[0], sigmoid_fast(hi_bf(gw.z)) * a1[1], sigmoid_fast(lo_bf(gw.w)) * a1[2], sigmoid_fast(hi_bf(gw.w)) * a1[3]};
                    if (w) { const v4u pw = *(const v4u*)(rowp + bj * 128); v[0] += lo_bf(pw.x); v[1] += hi_bf(pw.x); v[2] += lo_bf(pw.y); v[3] += hi_bf(pw.y); v[4] += lo_bf(pw.z); v[5] += hi_bf(pw.z); v[6] += lo_bf(pw.w); v[7] += hi_bf(pw.w); }
                    v4u o; o.x = pg8::cvt_pk_bf16(v[0], v[1]); o.y = pg8::cvt_pk_bf16(v[2], v[3]); o.z = pg8::cvt_pk_bf16(v[4], v[5]); o.w = pg8::cvt_pk_bf16(v[6], v[7]);
                    *(v4u*)(rowp + bj * 128) = o; } }
    }
};

struct OneUnit { int pm, pn; bool has;
    __device__ bool next(int i, pg8::Unit& u) const { if (i != 0 || !has) return false; u.pm = pm; u.pn = pn; return true; }
    __device__ __forceinline__ void a_ready(const pg8::Unit&) const {}
    __device__ __forceinline__ void done(const pg8::Unit&) const {} };

constexpr int N_PHASES = 19;
__global__ void __launch_bounds__(NTHREADS, 2) fwd(Args args) {
    extern __shared__ __attribute__((aligned(16))) unsigned char lds_raw[];
    Ctx c; c.lds = (LAS unsigned char*)lds_raw; c.tid = threadIdx.x; c.lane = c.tid & 63; c.wave = __builtin_amdgcn_readfirstlane(c.tid >> 6);
    c.G = gridDim.x; c.gw = blockIdx.x * NWAVES + c.wave; c.ngw = c.G * NWAVES;
    volatile LAS unsigned* MISC = (volatile LAS unsigned*)(c.lds + MISC_OFF);
    unsigned char* ws = args.ws; unsigned* ctl = (unsigned*)(ws + WS_CTL);
    for (int u = c.tid; u < (LDS_BYTES - LDSCTL_OFF) / 4; u += NTHREADS) ((LAS unsigned*)(c.lds + LDSCTL_OFF))[u] = 0u;
    __syncthreads();
    XcdBarrier bar; bar.bar = ctl + CW_BAR; bar.x = 0; bar.st = nullptr;
    if (N_LAUNCHES == 1) bar = xcd_barrier_post(ctl + CW_BAR, MISC + 8);
    const int lo = args.ph_lo, hi = args.ph_hi;
#define IN(k) (lo <= (k) && (k) < hi)
#define SEAM(k) do { if (N_LAUNCHES == 1 && IN(k) && IN((k) + 1)) xcd_barrier(bar); } while (0)
    LAS unsigned char* ring = c.lds;
    const int bx = (int)blockIdx.x;

    if (IN(0)) { ph_prologue(args, c); } SEAM(0);
    if (IN(1)) {
        { pg8::Gemm g{(const bf16*)(ws + WS_XB), (const bf16*)(ws + WS_W_IN), NTOK, NCOMBP, D, D, D}; pg8::StaticOrder S; S.init(NTOK, NCOMBP, c.G, bx);
          pg8::EpiBf16<0> E{(bf16*)(ws + WS_PROJ), NCOMBP, nullptr, 0, 0, 1.f}; pg8::gemm_phase<pg8::EpiBf16<0>, pg8::StaticOrder, true, true>(ring, g, S, E); }
        { pg8::Gemm g{(const bf16*)(ws + WS_MEMB), (const bf16*)(ws + WS_W_MKV), BATCH * NMEM, 1024, D, D, D}; pg8::StaticOrder S; S.init(BATCH * NMEM, 1024, c.G, bx);
          pg8::EpiBf16<0> E{(bf16*)(ws + WS_KVMEM), 1024, nullptr, 0, 0, 1.f}; pg8::gemm_phase<pg8::EpiBf16<0>, pg8::StaticOrder, true, true>(ring, g, S, E); }
    } SEAM(1);
    if (IN(2)) { ph_rowprep(args, c); } SEAM(2);
    if (IN(3)) {
        { pg8::Gemm g{(const bf16*)(ws + WS_CKVN), (const bf16*)(ws + WS_W_UKV), NTOK, 4096, 512, 512, 512}; pg8::StaticOrder S; S.init(NTOK, 4096, c.G, bx);
          pg8::EpiBf16<0> E{(bf16*)(ws + WS_KVUP), 4096, nullptr, 0, 0, 1.f}; pg8::gemm_phase<pg8::EpiBf16<0>, pg8::StaticOrder, true, true>(ring, g, S, E); }
        { const int kv = (bx >> 5) & 1, ks = (bx >> 2) & 7; OneUnit S{bx & 3, 0, bx < 64};
          pg8::Gemm g{(const bf16*)(ws + (kv ? WS_CMPA_V : WS_CMPA_K)) + ks * 512, (const bf16*)(ws + (kv ? WS_W_C1V : WS_W_C1K)) + ks * 512, 1024, 256, 512, 2048, 4096};
          pg8::EpiF32 E{(float*)(ws + WS_H1P) + (size_t)(ks * 2 + kv) * 1024 * 256, 256, nullptr}; pg8::gemm_phase<pg8::EpiF32, OneUnit, false, true>(ring, g, S, E); }
    } SEAM(3);
    if (IN(4)) { ph_cmp2(args, c); } SEAM(4);
    if (IN(5)) { ph_nsa_fa(args, c); }
    if (IN(6)) { ph_mla_fa(args, c); } SEAM(6);
    if (IN(7)) {
        static_assert(WS_OMLA == WS_ONSA + (size_t)NTOK * D * 2 && WS_W_BM == WS_W_BN + (size_t)D * D * 2, "stacked operands of the fused branch projection");
        pg8::Gemm g{(const bf16*)(ws + WS_ONSA), (const bf16*)(ws + WS_W_BN), 2 * NTOK, 2 * D, D, D, D}; PairOrder S; S.so.init(NTOK, D, c.G, bx);
        EpiMerge E{(bf16*)(ws + WS_MERGED), (const bf16*)(ws + WS_PROJ)}; pg8::gemm_phase<EpiMerge, PairOrder, true, true>(ring, g, S, E);
    }
    if (IN(8)) { } SEAM(8);
    if (IN(9)) { pg8::Gemm g{(const bf16*)(ws + WS_MERGED), (const bf16*)(ws + WS_W_MO), NTOK, D, D, D, D}; pg8::StaticOrder S; S.init(NTOK, D, c.G, bx);
        pg8::EpiBf16<0> E{(bf16*)(ws + WS_Z), D, nullptr, 0, 0, 1.f}; pg8::gemm_phase<pg8::EpiBf16<0>, pg8::StaticOrder, true, true>(ring, g, S, E); } SEAM(9);
    if (IN(10)) { ph_ln<float>(c, args.in[I_X], (const bf16*)(ws + WS_Z), args.in[I_LN1G], args.in[I_LN1B], (bf16*)(ws + WS_X1B)); } SEAM(10);
    if (IN(11)) { pg8::Gemm g{(const bf16*)(ws + WS_X1B), (const bf16*)(ws + WS_W_MQ), NTOK, 512, D, D, D}; pg8::StaticOrder S; S.init(NTOK, 512, c.G, bx);
        pg8::EpiBf16<0> E{(bf16*)(ws + WS_QMEM), 512, nullptr, 0, 0, 1.f}; pg8::gemm_phase<pg8::EpiBf16<0>, pg8::StaticOrder, true, true>(ring, g, S, E);
        if (c.G > 64) { if (bx >= 64) peer_convert(args, (bx - 64) * NWAVES + c.wave, (c.G - 64) * NWAVES, c.lane); } else peer_convert(args, c.gw, c.ngw, c.lane); } SEAM(11);
    if (IN(12)) { ph_memattn_fa(args, c); } SEAM(12);
    if (IN(13)) { pg8::Gemm g{(const bf16*)(ws + WS_OMEM), (const bf16*)(ws + WS_W_MO2), NTOK, D, 512, 512, 512}; pg8::StaticOrder S; S.init(NTOK, D, c.G, bx);
        pg8::EpiBf16<0> E{(bf16*)(ws + WS_Z), D, nullptr, 0, 0, 1.f}; pg8::gemm_phase<pg8::EpiBf16<0>, pg8::StaticOrder, true, true>(ring, g, S, E); } SEAM(13);
    if (IN(14)) { ph_ln<bf16>(c, (const bf16*)(ws + WS_X1B), (const bf16*)(ws + WS_Z), args.in[I_LN2G], args.in[I_LN2B], (bf16*)(ws + WS_X2B)); } SEAM(14);
    if (IN(15)) { pg8::Gemm g{(const bf16*)(ws + WS_X2B), (const bf16*)(ws + WS_W_PQ), NTOK, D, D, D, D}; pg8::StaticOrder S; S.init(NTOK, D, c.G, bx);
        pg8::EpiBf16<0> E{(bf16*)(ws + WS_PQB), D, nullptr, 0, 0, 1.f}; pg8::gemm_phase<pg8::EpiBf16<0>, pg8::StaticOrder, true, true>(ring, g, S, E); } SEAM(15);
    if (IN(16)) {
        pg8::Gemm g{(const bf16*)(ws + WS_PQB), (const bf16*)(ws + WS_KEYB), NTOK * 8, 256, 256, 256, 256}; pg8::StaticOrder S; S.init(NTOK * 8, 256, c.G, bx);
        pg8::EpiF32 E{(float*)(ws + WS_S), 256, nullptr}; pg8::gemm_phase<pg8::EpiF32, pg8::StaticOrder, true, true>(ring, g, S, E); } SEAM(16);
    if (IN(17)) { ph_peer_select2(args, c); } SEAM(17);
    if (IN(18)) { ph_peer_ffn(args, c); }
#undef IN
#undef SEAM
}

extern "C" void kernel_launch(void* const* d_in, const int* in_sizes, int n_in, void* d_out, int out_size, void* d_ws, size_t ws_size, hipStream_t stream) {
    static int grid = 0;
    if (grid == 0) {
        if (n_in != N_IN || in_sizes[0] != NTOK * D || out_size != NTOK * D || ws_size < WS_END) { fprintf(stderr, "kernel_launch: unexpected shapes (n_in %d, in0 %d, out %d, ws %zu)\n", n_in, n_in > 0 ? in_sizes[0] : -1, out_size, ws_size); grid = -1; return; }
        int dev = 0, cus = 0, per_cu = 0;
        if (hipGetDevice(&dev) != hipSuccess || hipDeviceGetAttribute(&cus, hipDeviceAttributeMultiprocessorCount, dev) != hipSuccess) { grid = -1; return; }
        if (hipFuncSetAttribute((const void*)fwd, hipFuncAttributeMaxDynamicSharedMemorySize, LDS_BYTES) != hipSuccess) { fprintf(stderr, "kernel_launch: hipFuncSetAttribute failed\n"); grid = -1; return; }
        if (hipOccupancyMaxActiveBlocksPerMultiprocessor(&per_cu, (const void*)fwd, NTHREADS, LDS_BYTES) != hipSuccess || per_cu < 1) fprintf(stderr, "kernel_launch: occupancy query reports %d\n", per_cu);
        (void)hipGetLastError();
        grid = cus;
    }
    if (grid < 0) return;
    (void)hipMemsetAsync((char*)d_ws + WS_CTL, 0, CTL_ZERO_BYTES, stream);
    Args a{};
    for (int i = 0; i < N_IN; ++i) a.in[i] = (const float*)d_in[i];
    a.out = (float*)d_out; a.ws = (unsigned char*)d_ws;
    if (N_LAUNCHES == 1) { a.ph_lo = 0; a.ph_hi = N_PHASES; hipLaunchKernelGGL(fwd, dim3(grid), dim3(NTHREADS), LDS_BYTES, stream, a); }
    else for (int p = 0; p < N_PHASES; ++p) { a.ph_lo = p; a.ph_hi = p + 1; hipLaunchKernelGGL(fwd, dim3(grid), dim3(NTHREADS), LDS_BYTES, stream, a); }
    const hipError_t le = hipPeekAtLastError();
    if (le != hipSuccess) fprintf(stderr, "kernel_launch: launch failed: %s\n", hipGetErrorName(le));
}
```
